# Optimizing an MI355X kernel written in HIP

```python
import math
import jax, jax.numpy as jnp
from jax import lax
import numpy as np

D_MODEL = 1024
BATCH = 16
SEQ = 4096
DEPTH = 1

D_RNN = 1024
RNN_HEADS = 16
RNN_HEAD_DIM = D_RNN // RNN_HEADS
CONV_WIDTH = 4
LRU_C = 8.0
D_SG = 1024
SG_GROUPS = 8
SG_GROUP_DIM = D_SG // SG_GROUPS
SG_CHUNK = 128
N_EXPERTS = 32
TOP_K = 4
D_EXPERT = 1024
SWIGLU_LIMIT = 7.0
SWIGLU_ALPHA = 1.702
MOE_BLOCK = 256
EPS = 1e-6
N_MOD = 6
IN_SPLITS = (D_RNN, 2 * D_RNN, 2 * D_RNN + D_SG, 2 * D_RNN + 2 * D_SG, 2 * D_RNN + 2 * D_SG + D_MODEL)
D_IN = 2 * D_RNN + 2 * D_SG + 2 * D_MODEL

kernel_name = "hybrid_rglru_gmlp_moe_adaln"


def rmsnorm(x, g):
    x32 = x.astype(jnp.float32)
    y = x32 * lax.rsqrt(jnp.mean(x32 * x32, axis=-1, keepdims=True) + EPS)
    return (y * g.astype(jnp.float32)).astype(x.dtype)


def modulate(h, shift, scale):
    return h * (1.0 + scale[:, None, :]) + shift[:, None, :]


def causal_depthwise_conv(x, w, b):
    C = x.shape[-1]
    y = lax.conv_general_dilated(x, w[:, None, :].astype(x.dtype), window_strides=(1,),
                                 padding=[(CONV_WIDTH - 1, 0)],
                                 dimension_numbers=('NWC', 'WIO', 'NWC'),
                                 feature_group_count=C)
    return y + b


def rg_lru(x, w_a, b_a, w_x, b_x, lam):
    B, S, _ = x.shape
    x32 = x.astype(jnp.float32)
    xh = x32.reshape(B, S, RNN_HEADS, RNN_HEAD_DIM)
    r = jax.nn.sigmoid(jnp.einsum('bshi,hij->bshj', xh, w_a.astype(jnp.float32)).reshape(B, S, D_RNN)
                       + b_a.astype(jnp.float32))
    i = jax.nn.sigmoid(jnp.einsum('bshi,hij->bshj', xh, w_x.astype(jnp.float32)).reshape(B, S, D_RNN)
                       + b_x.astype(jnp.float32))
    log_a = -LRU_C * r * jax.nn.softplus(-lam.astype(jnp.float32))
    a = jnp.exp(log_a)
    mult = jnp.sqrt(-jnp.expm1(2.0 * log_a))
    u = mult * (i * x32)

    def combine(left, right):
        a_l, h_l = left
        a_r, h_r = right
        return a_l * a_r, a_r * h_l + h_r

    _, h = lax.associative_scan(combine, (a, u), axis=1)
    return h.astype(x.dtype)


def spatial_gating(u, v, ln_g, ln_b, w_s, b_s):
    B, S, _ = v.shape
    v32 = v.astype(jnp.float32)
    mu = jnp.mean(v32, axis=-1, keepdims=True)
    var = jnp.mean(jnp.square(v32 - mu), axis=-1, keepdims=True)
    vn = ((v32 - mu) * lax.rsqrt(var + EPS) * ln_g.astype(jnp.float32) + ln_b.astype(jnp.float32)).astype(v.dtype)
    vc = vn.reshape(B, S // SG_CHUNK, SG_CHUNK, SG_GROUPS, SG_GROUP_DIM)
    causal = jnp.tril(jnp.ones((SG_CHUNK, SG_CHUNK), dtype=bool))
    w = jnp.where(causal[None], w_s, jnp.zeros((), w_s.dtype))
    sv = jnp.einsum('gts,bnsgc->bntgc', w, vc) + b_s.T[None, None, :, :, None]
    return u * sv.reshape(B, S, D_SG)


def hybrid_mixer(h, w_in, conv_w, conv_b, lru_wa, lru_ba, lru_wx, lru_bx, lru_lam,
                 sg_ln_g, sg_ln_b, sg_ws, sg_bs, w_br_rnn, w_br_sg, w_out):
    z = h @ w_in
    rnn_x, rnn_gate, sg_u, sg_v, g_rnn, g_sg = jnp.split(z, IN_SPLITS, axis=-1)
    y_rnn = rg_lru(causal_depthwise_conv(rnn_x, conv_w, conv_b), lru_wa, lru_ba, lru_wx, lru_bx, lru_lam)
    y_rnn = y_rnn * jax.nn.gelu(rnn_gate)
    y_sg = spatial_gating(jax.nn.gelu(sg_u), jax.nn.gelu(sg_v), sg_ln_g, sg_ln_b, sg_ws, sg_bs)
    m = jax.nn.sigmoid(g_rnn) * (y_rnn @ w_br_rnn) + jax.nn.sigmoid(g_sg) * (y_sg @ w_br_sg)
    return m @ w_out


def moe_ffn(h, w_router, b_router, w_gu, b_gu, w_down, b_down):
    B, S, D = h.shape
    N = B * S
    t = h.reshape(N, D)
    logits = (t @ w_router + b_router).astype(jnp.float32)
    top_val, top_idx = lax.top_k(logits, TOP_K)
    top_w = jax.nn.softmax(top_val, axis=-1)
    A = N * TOP_K
    cap = A + N_EXPERTS * MOE_BLOCK
    n_blocks = cap // MOE_BLOCK
    flat_e = top_idx.reshape(A).astype(jnp.int32)
    flat_tok = (jnp.arange(A, dtype=jnp.int32) // TOP_K)
    flat_w = top_w.reshape(A)
    order = jnp.argsort(flat_e)
    sorted_e = flat_e[order]
    counts = jnp.bincount(flat_e, length=N_EXPERTS).astype(jnp.int32)
    padded = ((counts + MOE_BLOCK - 1) // MOE_BLOCK) * MOE_BLOCK
    start = jnp.cumsum(counts) - counts
    padded_end = jnp.cumsum(padded)
    padded_start = padded_end - padded
    dest = padded_start[sorted_e] + jnp.arange(A, dtype=jnp.int32) - start[sorted_e]
    slot_tok = jnp.zeros((cap,), jnp.int32).at[dest].set(flat_tok[order])
    slot_w = jnp.zeros((cap,), t.dtype).at[dest].set(flat_w[order].astype(t.dtype))
    block_e = jnp.searchsorted(padded_end, jnp.arange(n_blocks, dtype=jnp.int32) * MOE_BLOCK, side='right')
    block_e = jnp.minimum(block_e, N_EXPERTS - 1).astype(jnp.int32)

    def expert_block(args):
        tok, w, e = args
        xb = t[tok]
        gu = xb @ w_gu[e] + b_gu[e]
        gate, up = gu[:, :D_EXPERT], gu[:, D_EXPERT:]
        gate = jnp.minimum(gate, SWIGLU_LIMIT)
        up = jnp.clip(up, -SWIGLU_LIMIT, SWIGLU_LIMIT)
        act = (up + 1.0) * (gate * jax.nn.sigmoid(SWIGLU_ALPHA * gate))
        return (act @ w_down[e] + b_down[e]) * w[:, None]

    ys = lax.map(expert_block, (slot_tok.reshape(n_blocks, MOE_BLOCK),
                                slot_w.reshape(n_blocks, MOE_BLOCK), block_e))
    out = jax.ops.segment_sum(ys.reshape(cap, D), slot_tok, num_segments=N)
    return out.reshape(B, S, D)


def setup_inputs(seed: int = 0) -> dict:
    key = jax.random.key(seed)
    ks = jax.random.split(key, 32)
    f32 = jnp.float32
    L = DEPTH
    nrm = lambda k, shape, s: jax.random.normal(k, shape, f32) * s
    a0 = jax.random.uniform(ks[10], (L, D_RNN), f32, 0.9, 0.999)
    s0 = a0 ** (1.0 / LRU_C)
    lam = jnp.log(s0) - jnp.log1p(-s0)
    return {
        "x": nrm(ks[0], (BATCH, SEQ, D_MODEL), 1.0),
        "c": nrm(ks[1], (BATCH, D_MODEL), 1.0),
        "ada_w": nrm(ks[2], (L, D_MODEL, N_MOD * D_MODEL), 0.5 * D_MODEL ** -0.5),
        "ada_b": nrm(ks[3], (L, N_MOD * D_MODEL), 0.02),
        "norm1_g": 1.0 + nrm(ks[4], (L, D_MODEL), 0.02),
        "w_in": nrm(ks[5], (L, D_MODEL, D_IN), D_MODEL ** -0.5),
        "conv_w": nrm(ks[6], (L, CONV_WIDTH, D_RNN), CONV_WIDTH ** -0.5),
        "conv_b": nrm(ks[7], (L, D_RNN), 0.02),
        "lru_wa": nrm(ks[8], (L, RNN_HEADS, RNN_HEAD_DIM, RNN_HEAD_DIM), RNN_HEAD_DIM ** -0.5),
        "lru_ba": nrm(ks[9], (L, D_RNN), 0.1),
        "lru_wx": nrm(ks[11], (L, RNN_HEADS, RNN_HEAD_DIM, RNN_HEAD_DIM), RNN_HEAD_DIM ** -0.5),
        "lru_bx": nrm(ks[12], (L, D_RNN), 0.1),
        "lru_lam": lam,
        "sg_ln_g": 1.0 + nrm(ks[13], (L, D_SG), 0.02),
        "sg_ln_b": nrm(ks[14], (L, D_SG), 0.02),
        "sg_ws": nrm(ks[15], (L, SG_GROUPS, SG_CHUNK, SG_CHUNK), SG_CHUNK ** -0.5),
        "sg_bs": 1.0 + nrm(ks[16], (L, SG_GROUPS, SG_CHUNK), 0.02),
        "w_br_rnn": nrm(ks[17], (L, D_RNN, D_MODEL), D_RNN ** -0.5),
        "w_br_sg": nrm(ks[18], (L, D_SG, D_MODEL), D_SG ** -0.5),
        "w_out": nrm(ks[19], (L, D_MODEL, D_MODEL), D_MODEL ** -0.5),
        "norm2_g": 1.0 + nrm(ks[20], (L, D_MODEL), 0.02),
        "w_router": nrm(ks[21], (L, D_MODEL, N_EXPERTS), D_MODEL ** -0.5),
        "b_router": nrm(ks[22], (L, N_EXPERTS), 0.01),
        "w_gu": nrm(ks[23], (L, N_EXPERTS, D_MODEL, 2 * D_EXPERT), D_MODEL ** -0.5),
        "b_gu": nrm(ks[24], (L, N_EXPERTS, 2 * D_EXPERT), 0.02),
        "w_down": nrm(ks[25], (L, N_EXPERTS, D_EXPERT, D_MODEL), D_EXPERT ** -0.5),
        "b_down": nrm(ks[26], (L, N_EXPERTS, D_MODEL), 0.02),
        "final_g": 1.0 + nrm(ks[27], (D_MODEL,), 0.02),
    }


def reference(x, c, ada_w, ada_b, norm1_g, w_in, conv_w, conv_b, lru_wa, lru_ba, lru_wx, lru_bx,
              lru_lam, sg_ln_g, sg_ln_b, sg_ws, sg_bs, w_br_rnn, w_br_sg, w_out, norm2_g,
              w_router, b_router, w_gu, b_gu, w_down, b_down, final_g):
    for l in range(DEPTH):
        mod = jax.nn.silu(c) @ ada_w[l] + ada_b[l]
        sh1, sc1, gt1, sh2, sc2, gt2 = jnp.split(mod, N_MOD, axis=-1)
        h = modulate(rmsnorm(x, norm1_g[l]), sh1, sc1)
        x = x + gt1[:, None, :] * hybrid_mixer(
            h, w_in[l], conv_w[l], conv_b[l], lru_wa[l], lru_ba[l], lru_wx[l], lru_bx[l], lru_lam[l],
            sg_ln_g[l], sg_ln_b[l], sg_ws[l], sg_bs[l], w_br_rnn[l], w_br_sg[l], w_out[l])
        h = modulate(rmsnorm(x, norm2_g[l]), sh2, sc2)
        x = x + gt2[:, None, :] * moe_ffn(h, w_router[l], b_router[l], w_gu[l], b_gu[l], w_down[l], b_down[l])
    return rmsnorm(x, final_g)
```

```cpp
#include <hip/hip_runtime.h>
#include <cstdio>
#include <cstdint>

#ifndef MK_PER_PHASE
#define MK_PER_PHASE 1
#endif

namespace pg8 {
#define PG8_LAS __attribute__((address_space(3)))
typedef unsigned short bf16_t;
typedef short bf16x8 __attribute__((ext_vector_type(8)));
typedef float f32x4 __attribute__((ext_vector_type(4)));
typedef float f32x2 __attribute__((ext_vector_type(2)));
typedef unsigned u32x4 __attribute__((ext_vector_type(4)));
typedef unsigned u32x2 __attribute__((ext_vector_type(2)));
constexpr int BM = 256, BK = 64, HALF = 128, HTB = HALF * BK * 2, STAGE_BYTES = 8 * HTB, NXCD = 8, WGM = 8, KD = 1024;

__host__ __device__ __forceinline__ int lds_byte(int r, int c) { const int st = (r >> 4) * 2 + (c >> 5), rr = r & 15, cc = c & 31, ob = rr * 64 + cc * 2; return st * 1024 + (ob ^ (((ob >> 9) & 1) << 5)); }
__host__ __device__ __forceinline__ void stage_rc(int b, int& R, int& C) { const int st = b / 1024, sb = b % 1024, swz = sb ^ (((sb >> 9) & 1) << 5); R = (st >> 1) * 16 + swz / 64; C = (st & 1) * 32 + (swz % 64) / 2; }
__host__ __device__ __forceinline__ int perm32(int rho) { const int n = rho >> 4, i = rho & 15; return 8 * (i >> 2) + 4 * n + (i & 3); }

struct Unit { int pm, pn, e; };

struct PlainOrder {
    static constexpr bool GATHER = false;
    const bf16_t* A; const bf16_t* Bt; int nM, nN, nwg, G, c;
    __device__ void init(const bf16_t* A_, const bf16_t* Bt_, int M, int N, int G_, int c_) { A = A_; Bt = Bt_; nM = M / BM; nN = N / BM; nwg = nM * nN; G = G_; c = c_; }
    __device__ __forceinline__ bool next(int i, Unit& u) const {
        const long L = (long)i * G + c; if (L >= nwg) return false;
        int wgid = (int)L; { const int q = nwg / NXCD, r = nwg % NXCD, xcd = wgid % NXCD, off = wgid / NXCD; wgid = (xcd < r ? xcd * (q + 1) : r * (q + 1) + (xcd - r) * q) + off; }
        const int nig = WGM * nN, gid = wgid / nig, fm = gid * WGM, gsz = (nM - fm) < WGM ? (nM - fm) : WGM;
        u.pm = fm + ((wgid % nig) % gsz); u.pn = (wgid % nig) / gsz; u.e = 0; return true;
    }
    __device__ __forceinline__ const char* a_base(const Unit& u) const { return (const char*)A + (size_t)u.pm * ((size_t)BM * KD * 2); }
    __device__ __forceinline__ const char* b_base(const Unit& u) const { return (const char*)Bt + (size_t)u.pn * ((size_t)BM * KD * 2); }
    __device__ __forceinline__ void load_rows(const Unit&, unsigned (&)[2][2]) const {}
};
template <bool GATHER_> struct MoeOrder {
    static constexpr bool GATHER = GATHER_;
    const bf16_t* A; const bf16_t* Bt; const int* tile_exp; const int* slot_tok; int tile0, ntile, nN, G, c;
    __device__ __forceinline__ bool next(int i, Unit& u) const {
        const long L = (long)i * G + c; if (L >= (long)ntile * nN) return false;
        const int pl = (int)(L / nN); u.pn = (int)(L % nN); u.pm = tile0 + pl; u.e = tile_exp[u.pm]; return true;
    }
    __device__ __forceinline__ const char* a_base(const Unit& u) const { return GATHER ? (const char*)A : (const char*)A + (size_t)(u.pm - tile0) * ((size_t)BM * KD * 2); }
    __device__ __forceinline__ const char* b_base(const Unit& u) const { return (const char*)Bt + ((size_t)u.e * nN + u.pn) * ((size_t)BM * KD * 2); }
    __device__ __forceinline__ void load_rows(const Unit& u, unsigned (&out)[2][2]) const {
#pragma unroll
        for (int i = 0; i < 2; ++i) { int R, C; stage_rc((int)threadIdx.x * 16 + i * 8192, R, C);
#pragma unroll
            for (int h = 0; h < 2; ++h) out[h][i] = (unsigned)slot_tok[u.pm * BM + h * HALF + R] * (unsigned)(KD * 2) + (unsigned)C * 2u; }
    }
};

__device__ __forceinline__ unsigned cvt_pk_bf16(float lo, float hi) { unsigned r; asm volatile("v_cvt_pk_bf16_f32 %0, %1, %2" : "=v"(r) : "v"(lo), "v"(hi)); return r; }
__device__ __forceinline__ float bf_lo(unsigned w) { return __uint_as_float(w << 16); }
__device__ __forceinline__ float bf_hi(unsigned w) { return __uint_as_float(w & 0xffff0000u); }

template <class Epi, class Sched, bool ALIGN_EPI>
__device__ __forceinline__ void gemm_phase(PG8_LAS unsigned char* lds, const Sched& S, const Epi& E) {
    const int tid = threadIdx.x, wid = __builtin_amdgcn_readfirstlane(tid >> 6), lane = tid & 63, wr = wid >> 2, wc = wid & 3, fr = lane & 15, fq = lane >> 4;
    constexpr int K = KD, nt = K / BK;
    unsigned voffA[2], voffB[2];
#pragma unroll
    for (int i = 0; i < 2; ++i) { int R, C; stage_rc(tid * 16 + i * 8192, R, C); const int Rb = Epi::PERM ? ((R & ~31) + perm32(R & 31)) : R;
        voffA[i] = (unsigned)(R * K + C) * 2u; voffB[i] = (unsigned)(Rb * K + C) * 2u; }
    constexpr size_t kstep = (size_t)(BK * 2);
    constexpr size_t hstep = (size_t)HALF * K * 2;
    const unsigned ldsw = (unsigned)wid * 1024u;
    const int aoff = lds_byte(wr * 64 + fr, fq * 8), boff = lds_byte(wc * 32 + fr, fq * 8);
#define PG8_SA(b, h) (((b) * 2 + (h)) * HTB)
#define PG8_SB(b, h) ((4 + (b) * 2 + (h)) * HTB)
#define PG8_STAGE(bufoff, gbase, voff) do { _Pragma("unroll") for (int _i = 0; _i < 2; ++_i) \
        __builtin_amdgcn_global_load_lds((const unsigned*)((const char*)(gbase) + (voff)[_i]), (PG8_LAS unsigned*)(lds + (bufoff) + ldsw + _i * 8192), 16, 0, 0); } while (0)
#define PG8_STAGE_B(b, h, base) PG8_STAGE(PG8_SB(b, h), (base) + (h) * hstep, voffB)
#define PG8_STAGE_A(b, h, base, GO) do { if constexpr (Sched::GATHER) { PG8_STAGE(PG8_SA(b, h), (base), GO[h]); } else { PG8_STAGE(PG8_SA(b, h), (base) + (h) * hstep, voffA); } } while (0)
#define PG8_LDA(dst, b, h) do { _Pragma("unroll") for (int m = 0; m < 4; ++m) _Pragma("unroll") for (int k = 0; k < 2; ++k) dst[m][k] = *(const PG8_LAS bf16x8*)(lds + PG8_SA(b, h) + aoff + m * 2048 + k * 1024); } while (0)
#define PG8_LDB(dst, b, h) do { _Pragma("unroll") for (int n = 0; n < 2; ++n) _Pragma("unroll") for (int k = 0; k < 2; ++k) dst[n][k] = *(const PG8_LAS bf16x8*)(lds + PG8_SB(b, h) + boff + n * 2048 + k * 1024); } while (0)
#define PG8_MMA(ai, bj, At, Bt) do { __builtin_amdgcn_s_setprio(1); _Pragma("unroll") for (int m = 0; m < 4; ++m) _Pragma("unroll") for (int n = 0; n < 2; ++n) _Pragma("unroll") for (int k = 0; k < 2; ++k) \
        acc[ai][bj][m][n] = __builtin_amdgcn_mfma_f32_16x16x32_bf16(Bt[n][k], At[m][k], acc[ai][bj][m][n], 0, 0, 0); __builtin_amdgcn_s_setprio(0); } while (0)
#define PG8_WAIT_V(n) asm volatile("s_waitcnt vmcnt(" #n ")" ::: "memory")
#define PG8_WAIT_L(n) asm volatile("s_waitcnt lgkmcnt(" #n ")" ::: "memory")
#define PG8_BAR __builtin_amdgcn_s_barrier()
#define PG8_SCHED __builtin_amdgcn_sched_barrier(0)
    Unit cur, nxt; int ui = 0;
    if (!S.next(0, cur)) return;
    f32x4 acc[2][2][4][2];
#pragma unroll
    for (int a = 0; a < 2; ++a)
#pragma unroll
        for (int b = 0; b < 2; ++b)
#pragma unroll
            for (int m = 0; m < 4; ++m)
#pragma unroll
                for (int n = 0; n < 2; ++n) acc[a][b][m][n] = (f32x4){0.f, 0.f, 0.f, 0.f};
    bf16x8 At[4][2], B0[2][2], B1[2][2];
    unsigned gA[2][2] = {{0u, 0u}, {0u, 0u}};
    const char* cA = S.a_base(cur); const char* cB = S.b_base(cur);
    if constexpr (Sched::GATHER) S.load_rows(cur, gA);
    PG8_STAGE_B(0, 0, cB); PG8_STAGE_B(0, 1, cB); PG8_STAGE_A(0, 0, cA, gA); PG8_STAGE_A(0, 1, cA, gA);
    if (wr == 1) PG8_BAR;
    PG8_WAIT_V(2); PG8_BAR;
    PG8_STAGE_B(1, 0, cB + kstep); PG8_STAGE_A(1, 0, cA + kstep, gA); PG8_STAGE_B(1, 1, cB + kstep);
    PG8_WAIT_V(6); PG8_BAR;
    for (;;) {
        const bool has_next = S.next(ui + 1, nxt);
        const char* nA = has_next ? S.a_base(nxt) : cA; const char* nB = has_next ? S.b_base(nxt) : cB;
        for (int t = 0; t < nt; t += 2) {
            const bool last = (t == nt - 2);
            const char* a1 = cA + (size_t)(t + 1) * kstep;
            const char* a2 = last ? nA : cA + (size_t)(t + 2) * kstep; const char* b2 = last ? nB : cB + (size_t)(t + 2) * kstep;
            const char* a3 = a2 + kstep; const char* b3 = b2 + kstep;
            PG8_LDB(B0, 0, 0); PG8_LDB(B1, 0, 1); PG8_SCHED; PG8_LDA(At, 0, 0); PG8_STAGE_A(1, 1, a1, gA);
            if constexpr (Sched::GATHER) { if (last && has_next) S.load_rows(nxt, gA); }
            PG8_WAIT_V(8); PG8_WAIT_L(0); PG8_BAR; PG8_MMA(0, 0, At, B0); PG8_MMA(0, 1, At, B1); PG8_BAR; PG8_SCHED;
            PG8_LDA(At, 0, 1); PG8_STAGE_B(0, 0, b2); PG8_STAGE_B(0, 1, b2); PG8_STAGE_A(0, 0, a2, gA);
            PG8_WAIT_V(8); PG8_WAIT_L(0); PG8_BAR; PG8_MMA(1, 0, At, B0); PG8_MMA(1, 1, At, B1); PG8_BAR; PG8_SCHED;
            PG8_LDB(B0, 1, 0); PG8_LDB(B1, 1, 1); PG8_SCHED; PG8_LDA(At, 1, 0); PG8_STAGE_A(0, 1, a2, gA);
            PG8_WAIT_V(8); PG8_WAIT_L(0); PG8_BAR; PG8_MMA(0, 0, At, B0); PG8_MMA(0, 1, At, B1); PG8_BAR; PG8_SCHED;
            PG8_LDA(At, 1, 1); PG8_STAGE_B(1, 0, b3); PG8_STAGE_B(1, 1, b3); PG8_STAGE_A(1, 0, a3, gA);
            PG8_WAIT_V(8); PG8_WAIT_L(0); PG8_BAR; PG8_MMA(1, 0, At, B0); PG8_MMA(1, 1, At, B1); PG8_BAR; PG8_SCHED;
        }
        if constexpr (ALIGN_EPI) { if (wr == 0) PG8_BAR; }
        E(acc, cur, wr, wc, fr, fq);
        if (!has_next) break;
#pragma unroll
        for (int a = 0; a < 2; ++a)
#pragma unroll
            for (int b = 0; b < 2; ++b)
#pragma unroll
                for (int m = 0; m < 4; ++m)
#pragma unroll
                    for (int n = 0; n < 2; ++n) acc[a][b][m][n] = (f32x4){0.f, 0.f, 0.f, 0.f};
        cur = nxt; cA = nA; cB = nB; ++ui;
        if constexpr (ALIGN_EPI) { if (wr == 1) PG8_BAR; }
    }
    PG8_WAIT_V(0);
    if constexpr (!ALIGN_EPI) { if (wr == 0) PG8_BAR; }
    PG8_BAR;
#undef PG8_SA
#undef PG8_SB
#undef PG8_STAGE
#undef PG8_STAGE_A
#undef PG8_STAGE_B
#undef PG8_LDA
#undef PG8_LDB
#undef PG8_MMA
#undef PG8_WAIT_V
#undef PG8_WAIT_L
#undef PG8_BAR
#undef PG8_SCHED
}
}

constexpr int NWAVES = 8;
constexpr int BATCH = 16, SEQ = 4096, D = 1024, NTOK = BATCH * SEQ, DIN = 6144, NE = 32, TOPK = 4;
constexpr int CAPROWS = NTOK * TOPK + NE * 256, NTILE_MAX = CAPROWS / 256;
constexpr int TILES_A = 512, TILES_B_MAX = NTILE_MAX - TILES_A;
constexpr float EPS = 1e-6f;
constexpr int N_PHASES = 14;

constexpr size_t MiB = 1u << 20;
constexpr size_t WS_CTL = 0, CTL_ZERO_BYTES = 1 * MiB;
constexpr size_t WS_MOD = 1 * MiB;
constexpr size_t WS_WIN = 2 * MiB;
constexpr size_t WS_WBRR = 14 * MiB, WS_WBRS = 16 * MiB, WS_WOUT = 18 * MiB;
constexpr size_t WS_TOPI = 21 * MiB, WS_TOPW = 22 * MiB, WS_TSLOT = 23 * MiB;
constexpr size_t WS_SLOTTOK = 24 * MiB;
constexpr size_t WS_SLOTW = 26 * MiB;
constexpr size_t WS_BLKCNT = 28 * MiB;
constexpr size_t WS_TILEEXP = 28 * MiB + 65536;
constexpr size_t WS_H = 32 * MiB;
constexpr size_t WS_Z = 160 * MiB;
constexpr size_t ZREG = (size_t)NTOK * D * 2;
constexpr size_t WS_WGU = 160 * MiB;
constexpr size_t WS_YHI = 32 * MiB;
constexpr size_t WS_WDN = 304 * MiB;
constexpr size_t WS_ACT = 368 * MiB;
constexpr size_t WS_YLO = 640 * MiB;
constexpr size_t WS_END = 896 * MiB;
static_assert(WS_Z + 6 * ZREG <= 1024 * MiB, "z fits");
static_assert(WS_YHI + (size_t)TILES_B_MAX * 256 * D * 2 <= WS_WDN && WS_WDN + (size_t)NE * D * D * 2 <= WS_ACT && WS_ACT + (size_t)TILES_B_MAX * 256 * D * 2 <= WS_YLO && WS_YLO + (size_t)TILES_A * 256 * D * 2 <= WS_END, "moe map");
constexpr int CW_TMO = 0;
constexpr int CW_BAR = 4096;

constexpr int RING_BYTES = 131072;
constexpr int MISC_OFF = RING_BYTES + 320;
constexpr int AUX_OFF = RING_BYTES + 1024;
constexpr int LDS_BYTES = 147456;

#define GAS __attribute__((address_space(1)))
#define LAS __attribute__((address_space(3)))
typedef unsigned short bf16;
typedef unsigned v4u __attribute__((ext_vector_type(4)));
typedef unsigned v2u __attribute__((ext_vector_type(2)));
typedef float f32x4 __attribute__((ext_vector_type(4)));
typedef GAS unsigned gu32;
#define RLX_AGENT __ATOMIC_RELAXED, __HIP_MEMORY_SCOPE_AGENT
#define LDS_WAIT() asm volatile("s_waitcnt lgkmcnt(0)" ::: "memory")
#define VM_WAIT() asm volatile("s_waitcnt vmcnt(0)" ::: "memory")
__device__ __forceinline__ unsigned f2bf(float f) { unsigned u = __builtin_bit_cast(unsigned, f); return (u + 0x7fffu + ((u >> 16) & 1u)) >> 16; }
__device__ __forceinline__ unsigned pk2(float lo, float hi) { return f2bf(lo) | (f2bf(hi) << 16); }
__device__ __forceinline__ float bf2f(bf16 b) { return __uint_as_float(((unsigned)b) << 16); }

#define XB_TMO      128
#define XB_XCNT(j)  (256  + 64 * (j))
#define XB_XSUB(j)  (1280 + 64 * (j))
#define XB_XGEN(j)  (2304 + 64 * (j))
#define XB_TOP      3328
#define XB_TOPGEN   3392
#define XCD_BAR_WORDS 3456
#define XB_SPIN_CAP (1u << 18)
__device__ __forceinline__ unsigned xb_ld(unsigned* p)              { return __hip_atomic_load(p, __ATOMIC_RELAXED, __HIP_MEMORY_SCOPE_AGENT); }
__device__ __forceinline__ unsigned xb_add(unsigned* p, unsigned v) { return __hip_atomic_fetch_add(p, v, __ATOMIC_RELAXED, __HIP_MEMORY_SCOPE_AGENT); }
__device__ __forceinline__ unsigned xb_xcc_id() { return (unsigned)__builtin_amdgcn_s_getreg((3 << 11) | 20) & 0xFu; }
#define XB_SPIN(cond, bar) do { unsigned _sp = 0; while (cond) { __builtin_amdgcn_s_sleep(1); \
    if ((++_sp & 255u) == 0u) { if (xb_ld(&(bar)[XB_TMO])) break; if (_sp > XB_SPIN_CAP) { atomicAdd(&(bar)[XB_TMO], 1u); break; } } } } while (0)
struct XcdBarrier { unsigned* bar; unsigned x; volatile LAS unsigned* st; };
__device__ __forceinline__ XcdBarrier xcd_barrier_post(unsigned* bar, volatile LAS unsigned* st) {
    XcdBarrier b; b.bar = bar; b.x = xb_xcc_id(); b.st = st;
    if (threadIdx.x == 0) (void)xb_add(&bar[XB_XCNT(b.x)], 1u);
    return b;
}
__device__ __forceinline__ void xcd_barrier_complete(unsigned* bar, unsigned x, unsigned& nloc, unsigned& nx) {
    const unsigned G = gridDim.x * gridDim.y * gridDim.z;
    unsigned sum, cnt, mine, sp = 0u;
    for (;;) {
        sum = 0u; cnt = 0u; mine = 0u;
#pragma unroll
        for (unsigned j = 0; j < 16; ++j) { const unsigned c = xb_ld(&bar[XB_XCNT(j)]); sum += c; cnt += (c > 0u) ? 1u : 0u; mine = (j == x) ? c : mine; }
        if (sum == G) break;
        __builtin_amdgcn_s_sleep(1);
        if ((++sp & 255u) == 0u) { if (xb_ld(&bar[XB_TMO])) break; if (sp > XB_SPIN_CAP) { atomicAdd(&bar[XB_TMO], 1u); break; } }
    }
    nloc = mine > 0u ? mine : 1u; nx = cnt > 0u ? cnt : 1u;
}
__device__ __forceinline__ void xcd_barrier(const XcdBarrier& b) {
    asm volatile("s_waitcnt vmcnt(0)" ::: "memory");
    __syncthreads();
    if (threadIdx.x == 0) {
        unsigned* bar = b.bar;
        __builtin_amdgcn_s_waitcnt(0);
        unsigned nloc = b.st[0], nx = b.st[1];
        if (nloc == 0u) { xcd_barrier_complete(bar, b.x, nloc, nx); b.st[0] = nloc; b.st[1] = nx; }
        const unsigned old = xb_add(&bar[XB_XSUB(b.x)], 1u);
        const unsigned gen = old / nloc;
        if (old + 1u == (gen + 1u) * nloc) {
            __builtin_amdgcn_fence(__ATOMIC_RELEASE, "agent");
            asm volatile("s_waitcnt vmcnt(0)" ::: "memory");
            const unsigned og = xb_add(&bar[XB_TOP], 1u);
            const unsigned tg = og / nx;
            if (og + 1u == (tg + 1u) * nx) xb_add(&bar[XB_TOPGEN], 1u);
            else XB_SPIN(xb_ld(&bar[XB_TOPGEN]) == tg, bar);
            __builtin_amdgcn_fence(__ATOMIC_ACQUIRE, "agent");
            xb_add(&bar[XB_XGEN(b.x)], 1u);
            asm volatile("s_waitcnt vmcnt(0)" ::: "memory");
        } else {
            XB_SPIN(xb_ld(&bar[XB_XGEN(b.x)]) == gen, bar);
            __builtin_amdgcn_fence(__ATOMIC_ACQUIRE, "agent");
            asm volatile("s_waitcnt vmcnt(0)" ::: "memory");
        }
    }
    __syncthreads();
}

__device__ __forceinline__ float wave_sum(float v) {
#pragma unroll
    for (int o = 1; o < 64; o <<= 1) v += __shfl_xor(v, o);
    return v;
}
__device__ __forceinline__ float fast_sigmoid(float x) { return __builtin_amdgcn_rcpf(1.0f + __builtin_amdgcn_exp2f(-1.4426950409f * x)); }
__device__ __forceinline__ float gelu_tanh(float x) { const float a = x * (1.5957691216f + 0.0713548163f * x * x); return x * fast_sigmoid(a); }

struct EpiZ {
    static constexpr bool PERM = true;
    bf16* Z;
    __device__ __forceinline__ void operator()(const pg8::f32x4 (&acc)[2][2][4][2], const pg8::Unit& u, int wr, int wc, int fr, int fq) const {
        const int region = u.pn >> 2; const int row0 = u.pm * 256 + wr * 64 + fr, col0 = (u.pn & 3) * 256 + wc * 32 + 8 * fq;
        bf16* base = Z + (size_t)region * ((size_t)NTOK * D);
        const bool isg = (region >= 1 && region <= 3), iss = (region >= 4);
#pragma unroll
        for (int ai = 0; ai < 2; ++ai)
#pragma unroll
            for (int m = 0; m < 4; ++m) { bf16* rowp = base + (size_t)(row0 + ai * 128 + m * 16) * D + col0;
#pragma unroll
                for (int bj = 0; bj < 2; ++bj) { float v[8];
#pragma unroll
                    for (int j = 0; j < 4; ++j) { v[j] = acc[ai][bj][m][0][j]; v[4 + j] = acc[ai][bj][m][1][j]; }
#pragma unroll
                    for (int j = 0; j < 8; ++j) { const float x = v[j]; const float a = isg ? x * (1.5957691216f + 0.0713548163f * x * x) : x; const float s = fast_sigmoid(a);
                        v[j] = isg ? x * s : (iss ? s : x); }
                    pg8::u32x4 w; w.x = pg8::cvt_pk_bf16(v[0], v[1]); w.y = pg8::cvt_pk_bf16(v[2], v[3]); w.z = pg8::cvt_pk_bf16(v[4], v[5]); w.w = pg8::cvt_pk_bf16(v[6], v[7]);
                    *(pg8::u32x4*)(rowp + bj * 128) = w; } }
    }
};
struct EpiMerge {
    static constexpr bool PERM = true;
    const bf16* gate; const bf16* addend; bf16* out;
    __device__ __forceinline__ void operator()(const pg8::f32x4 (&acc)[2][2][4][2], const pg8::Unit& u, int wr, int wc, int fr, int fq) const {
        const int row0 = u.pm * 256 + wr * 64 + fr, col0 = u.pn * 256 + wc * 32 + 8 * fq;
#pragma unroll
        for (int ai = 0; ai < 2; ++ai)
#pragma unroll
            for (int m = 0; m < 4; ++m) { const size_t off = (size_t)(row0 + ai * 128 + m * 16) * D + col0;
#pragma unroll
                for (int bj = 0; bj < 2; ++bj) {
                    const pg8::u32x4 g = *(const pg8::u32x4*)(gate + off + bj * 128);
                    pg8::u32x4 ad = (pg8::u32x4){0u, 0u, 0u, 0u}; if (addend) ad = *(const pg8::u32x4*)(addend + off + bj * 128);
                    const pg8::f32x4 a0 = acc[ai][bj][m][0], a1 = acc[ai][bj][m][1];
                    pg8::u32x4 w;
                    w.x = pg8::cvt_pk_bf16(pg8::bf_lo(ad.x) + pg8::bf_lo(g.x) * a0[0], pg8::bf_hi(ad.x) + pg8::bf_hi(g.x) * a0[1]);
                    w.y = pg8::cvt_pk_bf16(pg8::bf_lo(ad.y) + pg8::bf_lo(g.y) * a0[2], pg8::bf_hi(ad.y) + pg8::bf_hi(g.y) * a0[3]);
                    w.z = pg8::cvt_pk_bf16(pg8::bf_lo(ad.z) + pg8::bf_lo(g.z) * a1[0], pg8::bf_hi(ad.z) + pg8::bf_hi(g.z) * a1[1]);
                    w.w = pg8::cvt_pk_bf16(pg8::bf_lo(ad.w) + pg8::bf_lo(g.w) * a1[2], pg8::bf_hi(ad.w) + pg8::bf_hi(g.w) * a1[3]);
                    *(pg8::u32x4*)(out + off + bj * 128) = w; } }
    }
};
struct EpiResid {
    static constexpr bool PERM = false;
    const float* x; const float* gt; float* out;
    __device__ __forceinline__ void operator()(const pg8::f32x4 (&acc)[2][2][4][2], const pg8::Unit& u, int wr, int wc, int fr, int fq) const {
        const int row0 = u.pm * 256 + wr * 64 + fr, col0 = u.pn * 256 + wc * 32 + 4 * fq; const int b = u.pm >> 4;
        pg8::f32x4 gv[2][2];
#pragma unroll
        for (int bj = 0; bj < 2; ++bj)
#pragma unroll
            for (int n = 0; n < 2; ++n) gv[bj][n] = *(const pg8::f32x4*)(gt + (size_t)b * DIN + col0 + bj * 128 + n * 16);
#pragma unroll
        for (int ai = 0; ai < 2; ++ai)
#pragma unroll
            for (int m = 0; m < 4; ++m) { const size_t off = (size_t)(row0 + ai * 128 + m * 16) * D + col0;
#pragma unroll
                for (int bj = 0; bj < 2; ++bj)
#pragma unroll
                    for (int n = 0; n < 2; ++n) { const pg8::f32x4 xv = *(const pg8::f32x4*)(x + off + bj * 128 + n * 16);
                        *(pg8::f32x4*)(out + off + bj * 128 + n * 16) = xv + gv[bj][n] * acc[ai][bj][m][n]; } }
    }
};
struct EpiGu {
    static constexpr bool PERM = true;
    bf16* act; const float* bgu; int tile0;
    __device__ __forceinline__ void operator()(const pg8::f32x4 (&acc)[2][2][4][2], const pg8::Unit& u, int wr, int wc, int fr, int fq) const {
        const int row0 = (u.pm - tile0) * 256 + wr * 64 + fr, cc = u.pn * 128 + wc * 32 + 8 * fq;
        const float* bg = bgu + (size_t)u.e * 2048 + cc;
        const pg8::f32x4 bg0 = *(const pg8::f32x4*)(bg), bg1 = *(const pg8::f32x4*)(bg + 4), bu0 = *(const pg8::f32x4*)(bg + 1024), bu1 = *(const pg8::f32x4*)(bg + 1028);
#pragma unroll
        for (int ai = 0; ai < 2; ++ai)
#pragma unroll
            for (int m = 0; m < 4; ++m) { float o[8];
#pragma unroll
                for (int j = 0; j < 8; ++j) {
                    float g = (j < 4 ? acc[ai][0][m][0][j & 3] + bg0[j & 3] : acc[ai][0][m][1][j & 3] + bg1[j & 3]);
                    float up = (j < 4 ? acc[ai][1][m][0][j & 3] + bu0[j & 3] : acc[ai][1][m][1][j & 3] + bu1[j & 3]);
                    g = fminf(g, 7.0f); up = fminf(fmaxf(up, -7.0f), 7.0f);
                    o[j] = (up + 1.0f) * (g * fast_sigmoid(1.702f * g)); }
                pg8::u32x4 w; w.x = pg8::cvt_pk_bf16(o[0], o[1]); w.y = pg8::cvt_pk_bf16(o[2], o[3]); w.z = pg8::cvt_pk_bf16(o[4], o[5]); w.w = pg8::cvt_pk_bf16(o[6], o[7]);
                *(pg8::u32x4*)(act + (size_t)(row0 + ai * 128 + m * 16) * D + cc) = w; }
    }
};
struct EpiDown {
    static constexpr bool PERM = true;
    bf16* y; const float* bd; const float* slot_w; int tile0;
    __device__ __forceinline__ void operator()(const pg8::f32x4 (&acc)[2][2][4][2], const pg8::Unit& u, int wr, int wc, int fr, int fq) const {
        const int rl0 = (u.pm - tile0) * 256 + wr * 64 + fr, rg0 = u.pm * 256 + wr * 64 + fr, col0 = u.pn * 256 + wc * 32 + 8 * fq;
        const float* bp = bd + (size_t)u.e * D + col0;
        pg8::f32x4 bv[2][2];
#pragma unroll
        for (int bj = 0; bj < 2; ++bj) { bv[bj][0] = *(const pg8::f32x4*)(bp + bj * 128); bv[bj][1] = *(const pg8::f32x4*)(bp + bj * 128 + 4); }
#pragma unroll
        for (int ai = 0; ai < 2; ++ai)
#pragma unroll
            for (int m = 0; m < 4; ++m) { const float sw = slot_w[rg0 + ai * 128 + m * 16]; bf16* rowp = y + (size_t)(rl0 + ai * 128 + m * 16) * D + col0;
#pragma unroll
                for (int bj = 0; bj < 2; ++bj) { const pg8::f32x4 v0 = (acc[ai][bj][m][0] + bv[bj][0]) * sw, v1 = (acc[ai][bj][m][1] + bv[bj][1]) * sw;
                    pg8::u32x4 w; w.x = pg8::cvt_pk_bf16(v0[0], v0[1]); w.y = pg8::cvt_pk_bf16(v0[2], v0[3]); w.z = pg8::cvt_pk_bf16(v1[0], v1[1]); w.w = pg8::cvt_pk_bf16(v1[2], v1[3]);
                    *(pg8::u32x4*)(rowp + bj * 128) = w; } }
    }
};

__device__ __forceinline__ void transpose_item(const float* W, int ldn, int K, int k0, int n0, bf16* WT, int drow0, LAS float* scr, int lane) {
#pragma unroll 8
    for (int i = 0; i < 32; ++i) { const int kk = 2 * i + (lane >> 5); scr[kk * 33 + (lane & 31)] = W[(size_t)(k0 + kk) * ldn + n0 + (lane & 31)]; }
    LDS_WAIT(); asm volatile("" ::: "memory");
    const int c = lane & 7;
#pragma unroll
    for (int j = 0; j < 4; ++j) { const int n = (lane >> 3) + 8 * j; const LAS float* s = scr + (8 * c) * 33 + n;
        v4u o; o.x = pk2(s[0 * 33], s[1 * 33]); o.y = pk2(s[2 * 33], s[3 * 33]); o.z = pk2(s[4 * 33], s[5 * 33]); o.w = pk2(s[6 * 33], s[7 * 33]);
        *(GAS v4u*)(WT + (size_t)(drow0 + n) * K + k0 + 8 * c) = o; }
    LDS_WAIT(); asm volatile("" ::: "memory");
}

struct Args {
    const float* in[28]; float* out; unsigned char* ws; int ph_lo, ph_hi, li, pad;
};
enum { I_X = 0, I_C, I_ADAW, I_ADAB, I_N1G, I_WIN, I_CONVW, I_CONVB, I_LWA, I_LBA, I_LWX, I_LBX, I_LAM, I_SGLNG, I_SGLNB, I_SGWS, I_SGBS, I_WBRR, I_WBRS, I_WOUT, I_N2G, I_WR, I_BR, I_WGU, I_BGU, I_WDN, I_BDN, I_FG };

__global__ void __launch_bounds__(NWAVES * 64, 2) mega_fwd(Args args) {
    extern __shared__ __attribute__((aligned(16))) unsigned char lds_raw[];
    LAS unsigned char* lds = (LAS unsigned char*)lds_raw;
    volatile LAS unsigned* MISC = (volatile LAS unsigned*)(lds + MISC_OFF);
    const int tid = threadIdx.x, lane = tid & 63, wave = __builtin_amdgcn_readfirstlane(tid >> 6);
    const int G = gridDim.x; const int bx = blockIdx.x;
    const int vcu = (G % 8 == 0) ? (bx % 8) * (G / 8) + bx / 8 : bx;
    unsigned char* ws = args.ws;
    gu32* ctl = (gu32*)(ws + WS_CTL);
    for (int u = tid; u < (LDS_BYTES - RING_BYTES) / 4; u += NWAVES * 64) ((LAS unsigned*)(lds + RING_BYTES))[u] = 0u;
    __syncthreads();
#if MK_PER_PHASE
    XcdBarrier bar; bar.bar = (unsigned*)(ctl + CW_BAR); bar.x = 0; bar.st = nullptr;
#define GRID_BAR() do { if (tid == 0) __hip_atomic_store(ctl + CW_TMO, 0xBADBA0u, RLX_AGENT); } while (0)
#else
    XcdBarrier bar = xcd_barrier_post((unsigned*)(ctl + CW_BAR), MISC + 8);
#define GRID_BAR() xcd_barrier(bar)
#endif
    const int lo = args.ph_lo, hi = args.ph_hi;
#define IN(k) (lo <= (k) && (k) < hi)
#define BOTH(k) (IN(k) && IN((k) + 1))

    const float* x_in = args.in[I_X];
    float* modv = (float*)(ws + WS_MOD);
    bf16* Hb = (bf16*)(ws + WS_H);
    bf16* Zb = (bf16*)(ws + WS_Z);
    bf16* Z0 = Zb, *Z1 = Zb + (size_t)NTOK * D, *Z2 = Zb + 2 * (size_t)NTOK * D, *Z3 = Zb + 3 * (size_t)NTOK * D, *Z4 = Zb + 4 * (size_t)NTOK * D, *Z5 = Zb + 5 * (size_t)NTOK * D;
    int* top_idx = (int*)(ws + WS_TOPI); float* top_w = (float*)(ws + WS_TOPW); int* tok_slot = (int*)(ws + WS_TSLOT);
    int* slot_tok = (int*)(ws + WS_SLOTTOK); float* slot_w = (float*)(ws + WS_SLOTW); int* blkcnt = (int*)(ws + WS_BLKCNT); int* tile_exp = (int*)(ws + WS_TILEEXP);
    const int gw = vcu * NWAVES + wave, NGW = G * NWAVES;

    if (IN(0)) {
        if (bx < 96) {
            LAS float* sc = (LAS float*)lds;
            LAS float* part = (LAS float*)(lds + 65536);
            const float* cin = args.in[I_C];
            for (int q = 0; q < 32; ++q) { const int idx = tid + 512 * q, k = idx >> 4, b = idx & 15; const float v = cin[b * D + k]; sc[idx] = v * fast_sigmoid(v); }
            __syncthreads();
            for (int task = bx; task < 96; task += G) {
                const int j0 = task * 64; const float* aw = args.in[I_ADAW];
                float a16[16];
#pragma unroll
                for (int b = 0; b < 16; ++b) a16[b] = 0.f;
                for (int kk = 0; kk < 128; ++kk) { const int k = wave * 128 + kk; const float wv = aw[(size_t)k * DIN + j0 + lane];
#pragma unroll
                    for (int b4 = 0; b4 < 4; ++b4) { const f32x4 s4 = *(const LAS f32x4*)(sc + k * 16 + b4 * 4);
                        a16[b4 * 4 + 0] += s4[0] * wv; a16[b4 * 4 + 1] += s4[1] * wv; a16[b4 * 4 + 2] += s4[2] * wv; a16[b4 * 4 + 3] += s4[3] * wv; } }
#pragma unroll
                for (int b = 0; b < 16; ++b) part[(wave * 16 + b) * 64 + lane] = a16[b];
                __syncthreads();
                for (int q = 0; q < 2; ++q) { const int o = tid + 512 * q, b = o >> 6, col = o & 63; float s = args.in[I_ADAB][j0 + col];
#pragma unroll
                    for (int w = 0; w < 8; ++w) s += part[(w * 16 + b) * 64 + col];
                    modv[b * DIN + j0 + col] = s; }
                __syncthreads();
            }
        }
        __syncthreads();
        {
            LAS float* scr = (LAS float*)(lds + wave * 16384);
            constexpr int I_IN = 16 * (DIN / 32), I_SQ = 16 * (D / 32);
            for (int it = gw; it < I_IN + 3 * I_SQ; it += NGW) {
                int r = it;
                if (r < I_IN) { const int nblk = DIN / 32, kb = r / nblk, nb = r % nblk; transpose_item(args.in[I_WIN], DIN, D, 64 * kb, 32 * nb, (bf16*)(ws + WS_WIN), 32 * nb, scr, lane); continue; } r -= I_IN;
                const int which = r / I_SQ; r -= which * I_SQ; const int nblk = D / 32, kb = r / nblk, nb = r % nblk;
                const float* W = which == 0 ? args.in[I_WBRR] : (which == 1 ? args.in[I_WBRS] : args.in[I_WOUT]);
                bf16* WT = (bf16*)(ws + (which == 0 ? WS_WBRR : (which == 1 ? WS_WBRS : WS_WOUT)));
                transpose_item(W, D, D, 64 * kb, 32 * nb, WT, 32 * nb, scr, lane);
            }
        }
        if (BOTH(0)) GRID_BAR();
    }

    if (IN(1)) {
        for (int rb = gw; rb < NTOK / 32; rb += NGW) {
            const int b = (rb * 32) / SEQ;
            f32x4 A4[4], B4[4];
#pragma unroll
            for (int j = 0; j < 4; ++j) { const int c = 4 * lane + 256 * j; const f32x4 g = *(const f32x4*)(args.in[I_N1G] + c), s = *(const f32x4*)(modv + b * DIN + 1024 + c);
                A4[j] = g * (1.0f + s); B4[j] = *(const f32x4*)(modv + b * DIN + c); }
            for (int r = 0; r < 32; ++r) {
                const size_t m = (size_t)rb * 32 + r;
                const GAS f32x4* xr = (const GAS f32x4*)(x_in + m * D) + lane;
                f32x4 v[4]; float ss = 0.f;
#pragma unroll
                for (int j = 0; j < 4; ++j) { v[j] = xr[64 * j]; ss += (v[j].x * v[j].x + v[j].y * v[j].y) + (v[j].z * v[j].z + v[j].w * v[j].w); }
                const float rstd = 1.0f / sqrtf(wave_sum(ss) * (1.f / D) + EPS);
                GAS v2u* o8 = (GAS v2u*)(Hb + m * D) + lane;
#pragma unroll
                for (int j = 0; j < 4; ++j) { const f32x4 y = v[j] * rstd * A4[j] + B4[j]; v2u o; o.x = pk2(y.x, y.y); o.y = pk2(y.z, y.w); o8[64 * j] = o; }
            }
        }
        if (BOTH(1)) GRID_BAR();
    }

    if (IN(2)) {
        pg8::PlainOrder S; S.init(Hb, (const bf16*)(ws + WS_WIN), NTOK, DIN, G, bx);
        EpiZ E{Zb};
        pg8::gemm_phase<EpiZ, pg8::PlainOrder, true>(lds, S, E);
        if (BOTH(2)) GRID_BAR();
    }

    if (IN(3)) {
        for (int unit = bx; unit < BATCH * 16; unit += G) {
            const int b = unit >> 4, hd = unit & 15, ch0 = hd * 64;
            LAS float* Wa = (LAS float*)lds;
            LAS float* Wx = Wa + 4096;
            LAS float* xc = Wx + 4096;
            LAS float* av = xc + 4096;
            LAS float* uv = av + 4096;
            LAS float* prm = uv + 4096;
            __syncthreads();
            for (int q = 0; q < 8; ++q) { const int idx = tid + 512 * q; Wa[idx] = args.in[I_LWA][(size_t)hd * 4096 + idx]; Wx[idx] = args.in[I_LWX][(size_t)hd * 4096 + idx]; }
            if (tid < 256) prm[tid] = args.in[I_CONVW][(tid >> 6) * D + ch0 + (tid & 63)];
            else if (tid < 320) prm[tid] = args.in[I_CONVB][ch0 + tid - 256];
            else if (tid < 384) prm[tid] = args.in[I_LBA][ch0 + tid - 320];
            else if (tid < 448) prm[tid] = args.in[I_LBX][ch0 + tid - 384];
            else { const float l = args.in[I_LAM][ch0 + tid - 448]; const float sp = (-l > 20.f) ? -l : log1pf(expf(-l)); prm[tid] = 8.0f * sp; }
            __syncthreads();
            float hstate = 0.f;
            const int j = tid & 63, tq = tid >> 6;
            for (int T0 = 0; T0 < SEQ; T0 += 64) {
#pragma unroll
                for (int q = 0; q < 8; ++q) { const int tt = tq + 8 * q, t = T0 + tt; float s = prm[256 + j];
#pragma unroll
                    for (int k = 0; k < 4; ++k) { const int ts = t - 3 + k; if (ts >= 0) s += prm[k * 64 + j] * bf2f(Z0[((size_t)b * SEQ + ts) * D + ch0 + j]); }
                    xc[tt * 64 + j] = s; }
                __syncthreads();
                { float ra[8], ia[8];
#pragma unroll
                    for (int q = 0; q < 8; ++q) { ra[q] = 0.f; ia[q] = 0.f; }
                    for (int i = 0; i < 64; ++i) { const float wa = Wa[i * 64 + j], wx = Wx[i * 64 + j];
#pragma unroll
                        for (int q = 0; q < 8; ++q) { const float xv = xc[(tq + 8 * q) * 64 + i]; ra[q] += xv * wa; ia[q] += xv * wx; } }
#pragma unroll
                    for (int q = 0; q < 8; ++q) { const int tt = tq + 8 * q;
                        const float r = fast_sigmoid(ra[q] + prm[320 + j]), ig = fast_sigmoid(ia[q] + prm[384 + j]);
                        const float la = -r * prm[448 + j]; const float a = expf(la); const float mult = sqrtf(-expm1f(2.0f * la));
                        av[tt * 64 + j] = a; uv[tt * 64 + j] = mult * ig * xc[tt * 64 + j]; } }
                __syncthreads();
                if (wave == 0) { float h = hstate;
                    for (int tt = 0; tt < 64; ++tt) { h = av[tt * 64 + lane] * h + uv[tt * 64 + lane]; uv[tt * 64 + lane] = h; }
                    hstate = h; }
                __syncthreads();
#pragma unroll
                for (int q = 0; q < 8; ++q) { const int tt = tq + 8 * q; const size_t o = ((size_t)b * SEQ + T0 + tt) * D + ch0 + j;
                    Z1[o] = (bf16)f2bf(uv[tt * 64 + j] * bf2f(Z1[o])); }
            }
            __syncthreads();
        }
        __syncthreads();
        for (int chunk = bx; chunk < NTOK / 128; chunk += G) {
            const size_t row0 = (size_t)chunk * 128;
            LAS float* vn = (LAS float*)lds;
            LAS float* WT = vn + 16384;
            LAS float* st = (LAS float*)(lds + AUX_OFF);
            __syncthreads();
            for (int r = 0; r < 16; ++r) { const int s = wave * 16 + r; const bf16* vr = Z3 + (row0 + s) * D;
                float v[16]; const v4u w0 = *(const v4u*)(vr + 8 * lane), w1 = *(const v4u*)(vr + 512 + 8 * lane);
                v[0] = pg8::bf_lo(w0.x); v[1] = pg8::bf_hi(w0.x); v[2] = pg8::bf_lo(w0.y); v[3] = pg8::bf_hi(w0.y); v[4] = pg8::bf_lo(w0.z); v[5] = pg8::bf_hi(w0.z); v[6] = pg8::bf_lo(w0.w); v[7] = pg8::bf_hi(w0.w);
                v[8] = pg8::bf_lo(w1.x); v[9] = pg8::bf_hi(w1.x); v[10] = pg8::bf_lo(w1.y); v[11] = pg8::bf_hi(w1.y); v[12] = pg8::bf_lo(w1.z); v[13] = pg8::bf_hi(w1.z); v[14] = pg8::bf_lo(w1.w); v[15] = pg8::bf_hi(w1.w);
                float sm = 0.f;
#pragma unroll
                for (int i = 0; i < 16; ++i) sm += v[i];
                const float mean = wave_sum(sm) * (1.f / D); float q2 = 0.f;
#pragma unroll
                for (int i = 0; i < 16; ++i) { const float d = v[i] - mean; q2 += d * d; }
                const float rstd = 1.0f / sqrtf(wave_sum(q2) * (1.f / D) + EPS);
                if (lane == 0) { st[2 * s] = mean; st[2 * s + 1] = rstd; } }
            __syncthreads();
            for (int g = 0; g < 8; ++g) {
                for (int q = 0; q < 32; ++q) { const int idx = tid + 512 * q; const int t = idx & 127, s = idx >> 7;
                    WT[s * 128 + t] = (s <= t) ? args.in[I_SGWS][((size_t)g * 128 + t) * 128 + s] : 0.f; }
                for (int q = 0; q < 32; ++q) { const int idx = tid + 512 * q; const int c = idx & 127, s = idx >> 7; const int col = g * 128 + c;
                    vn[s * 128 + c] = (bf2f(Z3[(row0 + s) * D + col]) - st[2 * s]) * st[2 * s + 1] * args.in[I_SGLNG][col] + args.in[I_SGLNB][col]; }
                __syncthreads();
                { const int c = tid & 127, tb = __builtin_amdgcn_readfirstlane(tid >> 7) * 32;
                    float a32[32];
#pragma unroll
                    for (int i = 0; i < 32; ++i) a32[i] = 0.f;
                    for (int s = 0; s < 128; ++s) { const float v = vn[s * 128 + c];
#pragma unroll
                        for (int i4 = 0; i4 < 8; ++i4) { const f32x4 w4 = *(const LAS f32x4*)(WT + s * 128 + tb + 4 * i4);
                            a32[4 * i4 + 0] += w4[0] * v; a32[4 * i4 + 1] += w4[1] * v; a32[4 * i4 + 2] += w4[2] * v; a32[4 * i4 + 3] += w4[3] * v; } }
#pragma unroll
                    for (int i = 0; i < 32; ++i) { const int t = tb + i; const size_t o = (row0 + t) * D + g * 128 + c;
                        const float sv = a32[i] + args.in[I_SGBS][g * 128 + t];
                        Z2[o] = (bf16)f2bf(bf2f(Z2[o]) * sv); } }
                __syncthreads();
            }
        }
        if (BOTH(3)) GRID_BAR();
    }

    if (IN(4)) {
        pg8::PlainOrder S; S.init(Z1, (const bf16*)(ws + WS_WBRR), NTOK, D, G, bx);
        EpiMerge E{Z4, nullptr, Z0};
        pg8::gemm_phase<EpiMerge, pg8::PlainOrder, true>(lds, S, E);
        if (BOTH(4)) GRID_BAR();
    }
    if (IN(5)) {
        pg8::PlainOrder S; S.init(Z2, (const bf16*)(ws + WS_WBRS), NTOK, D, G, bx);
        EpiMerge E{Z5, Z0, Z3};
        pg8::gemm_phase<EpiMerge, pg8::PlainOrder, true>(lds, S, E);
        if (BOTH(5)) GRID_BAR();
    }
    if (IN(6)) {
        pg8::PlainOrder S; S.init(Z3, (const bf16*)(ws + WS_WOUT), NTOK, D, G, bx);
        EpiResid E{x_in, modv + 2048, args.out};
        pg8::gemm_phase<EpiResid, pg8::PlainOrder, true>(lds, S, E);
        if (BOTH(6)) GRID_BAR();
    }

    if (IN(7)) {
        LAS f32x4* wr4 = (LAS f32x4*)lds;
        LAS unsigned* hist = (LAS unsigned*)(lds + AUX_OFF);
        __syncthreads();
        for (int q = 0; q < 16; ++q) { const int idx = tid + 512 * q; const int l = idx & 63, e4 = (idx >> 6) & 7, jq = idx >> 9; const int c = 4 * l + 256 * (jq >> 2) + (jq & 3);
            wr4[idx] = *(const f32x4*)(args.in[I_WR] + (size_t)c * NE + 4 * e4); }
        __syncthreads();
        for (int tb = bx; tb < NTOK / 256; tb += G) {
            if (tid < 32) hist[tid] = 0u;
            __syncthreads();
            const int m0 = tb * 256 + wave * 32; const int b = m0 / SEQ;
            f32x4 A4[4], B4[4];
#pragma unroll
            for (int j = 0; j < 4; ++j) { const int c = 4 * lane + 256 * j; const f32x4 g = *(const f32x4*)(args.in[I_N2G] + c), s = *(const f32x4*)(modv + b * DIN + 4096 + c);
                A4[j] = g * (1.0f + s); B4[j] = *(const f32x4*)(modv + b * DIN + 3072 + c); }
            for (int r = 0; r < 32; ++r) {
                const size_t m = (size_t)m0 + r;
                const GAS f32x4* xr = (const GAS f32x4*)(args.out + m * D) + lane;
                f32x4 v[4]; float ss = 0.f;
#pragma unroll
                for (int j = 0; j < 4; ++j) { v[j] = xr[64 * j]; ss += (v[j].x * v[j].x + v[j].y * v[j].y) + (v[j].z * v[j].z + v[j].w * v[j].w); }
                const float rstd = 1.0f / sqrtf(wave_sum(ss) * (1.f / D) + EPS);
                GAS v2u* o8 = (GAS v2u*)(Hb + m * D) + lane;
#pragma unroll
                for (int j = 0; j < 4; ++j) { v[j] = v[j] * rstd * A4[j] + B4[j]; v2u o; o.x = pk2(v[j].x, v[j].y); o.y = pk2(v[j].z, v[j].w); o8[64 * j] = o; }
                float p[32];
#pragma unroll
                for (int e = 0; e < 32; ++e) p[e] = 0.f;
#pragma unroll
                for (int j = 0; j < 4; ++j)
#pragma unroll
                    for (int q = 0; q < 4; ++q) { const float hv = v[j][q];
#pragma unroll
                        for (int e4 = 0; e4 < 8; ++e4) { const f32x4 w4 = wr4[((j * 4 + q) * 8 + e4) * 64 + lane];
                            p[4 * e4 + 0] += hv * w4[0]; p[4 * e4 + 1] += hv * w4[1]; p[4 * e4 + 2] += hv * w4[2]; p[4 * e4 + 3] += hv * w4[3]; } }
#pragma unroll
                for (int e = 0; e < 32; ++e) p[e] = wave_sum(p[e]) + args.in[I_BR][e];
                float tv[4]; int ti[4];
#pragma unroll
                for (int k = 0; k < 4; ++k) { float best = -3.0e38f; int bi = 0;
#pragma unroll
                    for (int e = 0; e < 32; ++e) { if (p[e] > best) { best = p[e]; bi = e; } }
                    tv[k] = best; ti[k] = bi;
#pragma unroll
                    for (int e = 0; e < 32; ++e) p[e] = (e == bi) ? -3.0e38f : p[e]; }
                const float e1 = expf(tv[1] - tv[0]), e2 = expf(tv[2] - tv[0]), e3 = expf(tv[3] - tv[0]); const float inv = 1.0f / (1.0f + e1 + e2 + e3);
                if (lane < 4) { const int myi = lane == 0 ? ti[0] : (lane == 1 ? ti[1] : (lane == 2 ? ti[2] : ti[3])); const float myw = (lane == 0 ? 1.0f : (lane == 1 ? e1 : (lane == 2 ? e2 : e3))) * inv;
                    top_idx[m * 4 + lane] = myi; top_w[m * 4 + lane] = myw; atomicAdd((unsigned*)&hist[myi], 1u); }
            }
            __syncthreads();
            if (tid < 32) blkcnt[tb * 32 + tid] = (int)hist[tid];
            __syncthreads();
        }
        __syncthreads();
        {
            LAS float* scr = (LAS float*)(lds + wave * 16384);
            constexpr int I_GU = 16 * 64, I_DN = 16 * 32;
            for (int it = gw; it < NE * (I_GU + I_DN); it += NGW) {
                const int e = it / (I_GU + I_DN); int r = it % (I_GU + I_DN);
                if (r < I_GU) { const int kb = r / 64, nb = r % 64; const int n0 = 32 * nb; const int cidx = n0 & 1023; const int drow = (cidx >> 7) * 256 + (n0 >= 1024 ? 128 : 0) + (cidx & 127);
                    transpose_item(args.in[I_WGU] + (size_t)e * D * 2048, 2048, D, 64 * kb, n0, (bf16*)(ws + WS_WGU) + (size_t)e * 2048 * D, drow, scr, lane); }
                else { r -= I_GU; const int kb = r / 32, nb = r % 32;
                    transpose_item(args.in[I_WDN] + (size_t)e * D * D, D, D, 64 * kb, 32 * nb, (bf16*)(ws + WS_WDN) + (size_t)e * D * D, 32 * nb, scr, lane); }
            }
        }
        if (BOTH(7)) GRID_BAR();
    }

    if (IN(8)) {
        LAS int* sp_tot = (LAS int*)(lds);
        LAS int* sp_pre = sp_tot + 512;
        LAS int* tot = sp_pre + 512;
        LAS int* myoff = tot + 32;
        LAS int* pstart = myoff + 32;
        LAS unsigned* cursor = (LAS unsigned*)(pstart + 64);
        for (int tb = bx; tb < NTOK / 256; tb += G) {
            __syncthreads();
            { const int e = tid & 31, part = tid >> 5; int s_tot = 0, s_pre = 0;
                for (int B = part; B < 256; B += 16) { const int cn = blkcnt[B * 32 + e]; s_tot += cn; if (B < tb) s_pre += cn; }
                sp_tot[part * 32 + e] = s_tot; sp_pre[part * 32 + e] = s_pre; }
            __syncthreads();
            if (tid < 32) { int a = 0, p = 0; for (int q = 0; q < 16; ++q) { a += sp_tot[q * 32 + tid]; p += sp_pre[q * 32 + tid]; } tot[tid] = a; myoff[tid] = p; cursor[tid] = 0u; }
            __syncthreads();
            if (tid == 0) { int acc = 0; for (int e = 0; e < 32; ++e) { pstart[e] = acc; acc += ((tot[e] + 255) >> 8) << 8; } pstart[32] = acc; }
            __syncthreads();
            for (int q = 0; q < 2; ++q) { const int a = tid + 512 * q; const int tok = tb * 256 + (a >> 2);
                const int e = top_idx[(size_t)tok * 4 + (a & 3)]; const unsigned rnk = atomicAdd((unsigned*)&cursor[e], 1u);
                const int slot = pstart[e] + myoff[e] + (int)rnk;
                slot_tok[slot] = tok; slot_w[slot] = top_w[(size_t)tok * 4 + (a & 3)]; tok_slot[(size_t)tok * 4 + (a & 3)] = slot; }
            if (tb < 32) { const int e = tb; const int nt_e = (tot[e] + 255) >> 8;
                for (int r = tot[e] + tid; r < nt_e * 256; r += 512) { slot_tok[pstart[e] + r] = 0; slot_w[pstart[e] + r] = 0.f; }
                for (int i = tid; i < nt_e; i += 512) tile_exp[(pstart[e] >> 8) + i] = e;
                if (e == 0 && tid == 0) tile_exp[NTILE_MAX] = pstart[32] >> 8; }
        }
        if (BOTH(8)) GRID_BAR();
    }

    for (int chunk = 0; chunk < 2; ++chunk) {
        const int pgu = 9 + 2 * chunk, pdn = 10 + 2 * chunk;
        if (IN(pgu) || IN(pdn)) {
            const int ntiles = tile_exp[NTILE_MAX];
            const int tile0 = chunk == 0 ? 0 : TILES_A;
            int ntc = chunk == 0 ? (ntiles < TILES_A ? ntiles : TILES_A) : (ntiles - TILES_A); if (ntc < 0) ntc = 0; if (ntc > TILES_B_MAX) ntc = TILES_B_MAX;
            bf16* actb = (bf16*)(ws + WS_ACT);
            bf16* yb = (bf16*)(ws + (chunk == 0 ? WS_YLO : WS_YHI));
            asm volatile("" : "+s"(actb), "+s"(yb));
            if (IN(pgu)) {
                pg8::MoeOrder<true> S{Hb, (const bf16*)(ws + WS_WGU), tile_exp, slot_tok, tile0, ntc, 8, G, vcu};
                EpiGu E{actb, args.in[I_BGU], tile0};
                pg8::gemm_phase<EpiGu, pg8::MoeOrder<true>, true>(lds, S, E);
                if (BOTH(pgu)) GRID_BAR();
            }
            if (IN(pdn)) {
                pg8::MoeOrder<false> S{actb, (const bf16*)(ws + WS_WDN), tile_exp, slot_tok, tile0, ntc, 4, G, vcu};
                EpiDown E{yb, args.in[I_BDN], slot_w, tile0};
                pg8::gemm_phase<EpiDown, pg8::MoeOrder<false>, true>(lds, S, E);
                if (BOTH(pdn)) GRID_BAR();
            }
        }
    }

    if (IN(13)) {
        const bf16* ylo = (const bf16*)(ws + WS_YLO); const bf16* yhi = (const bf16*)(ws + WS_YHI);
        for (int rb = gw; rb < NTOK / 32; rb += NGW) {
            const int b = (rb * 32) / SEQ;
            f32x4 G4[4], F4[4];
#pragma unroll
            for (int j = 0; j < 4; ++j) { const int c = 4 * lane + 256 * j; G4[j] = *(const f32x4*)(modv + b * DIN + 5120 + c); F4[j] = *(const f32x4*)(args.in[I_FG] + c); }
            for (int r = 0; r < 32; ++r) {
                const size_t m = (size_t)rb * 32 + r;
                GAS f32x4* xr = (GAS f32x4*)(args.out + m * D) + lane;
                f32x4 v[4], s4[4];
#pragma unroll
                for (int j = 0; j < 4; ++j) { v[j] = xr[64 * j]; s4[j] = (f32x4){0.f, 0.f, 0.f, 0.f}; }
#pragma unroll
                for (int k = 0; k < 4; ++k) { const int slot = tok_slot[m * 4 + k];
                    const bf16* yr = slot < TILES_A * 256 ? ylo + (size_t)slot * D : yhi + (size_t)(slot - TILES_A * 256) * D;
                    const GAS v2u* y8 = (const GAS v2u*)yr + lane;
#pragma unroll
                    for (int j = 0; j < 4; ++j) { const v2u w = y8[64 * j]; s4[j] += (f32x4){pg8::bf_lo(w.x), pg8::bf_hi(w.x), pg8::bf_lo(w.y), pg8::bf_hi(w.y)}; } }
                float ss = 0.f;
#pragma unroll
                for (int j = 0; j < 4; ++j) { v[j] = v[j] + G4[j] * s4[j]; ss += (v[j].x * v[j].x + v[j].y * v[j].y) + (v[j].z * v[j].z + v[j].w * v[j].w); }
                const float rstd = 1.0f / sqrtf(wave_sum(ss) * (1.f / D) + EPS);
#pragma unroll
                for (int j = 0; j < 4; ++j) xr[64 * j] = v[j] * rstd * F4[j];
            }
        }
    }
#undef IN
#undef BOTH
}

extern "C" void kernel_launch(void* const* d_in, const int* in_sizes, int n_in, void* d_out, int out_size, void* d_ws, size_t ws_size, hipStream_t stream) {
    static int grid = 0;
    if (grid == 0) {
        if (n_in != 28 || out_size != NTOK * D || ws_size < WS_Z + 6 * ZREG) { fprintf(stderr, "kernel_launch: unexpected shapes (n_in %d out %d ws %zu)\n", n_in, out_size, ws_size); grid = -1; return; }
        int dev = 0, cus = 0, per_cu = 0;
        if (hipGetDevice(&dev) != hipSuccess || hipDeviceGetAttribute(&cus, hipDeviceAttributeMultiprocessorCount, dev) != hipSuccess) { grid = -1; return; }
        if (hipFuncSetAttribute((const void*)mega_fwd, hipFuncAttributeMaxDynamicSharedMemorySize, LDS_BYTES) != hipSuccess) { fprintf(stderr, "kernel_launch: hipFuncSetAttribute failed\n"); grid = -1; return; }
        if (hipOccupancyMaxActiveBlocksPerMultiprocessor(&per_cu, (const void*)mega_fwd, NWAVES * 64, LDS_BYTES) != hipSuccess || per_cu < 1)
            fprintf(stderr, "kernel_launch: occupancy query reports %d workgroups per CU\n", per_cu);
        (void)hipGetLastError();
        grid = cus;
    }
    if (grid < 0) return;
    (void)hipMemsetAsync((char*)d_ws + WS_CTL, 0, CTL_ZERO_BYTES, stream);
    Args a{};
    for (int i = 0; i < 28; ++i) a.in[i] = (const float*)d_in[i];
    a.out = (float*)d_out; a.ws = (unsigned char*)d_ws;
#if MK_PER_PHASE
    for (int p = 0; p < N_PHASES; ++p) { a.ph_lo = p; a.ph_hi = p + 1; a.li = p; a.pad = 0; hipLaunchKernelGGL(mega_fwd, dim3(grid), dim3(NWAVES * 64), LDS_BYTES, stream, a); }
#else
    a.ph_lo = 0; a.ph_hi = N_PHASES; a.li = 0; a.pad = 0;
    hipLaunchKernelGGL(mega_fwd, dim3(grid), dim3(NWAVES * 64), LDS_BYTES, stream, a);
#endif
}
```

```cpp
#include <hip/hip_runtime.h>
#include <cstdio>
#include <cstdint>

#ifndef MK_PER_PHASE
#define MK_PER_PHASE 0
#endif

namespace pg8 {
#define PG8_LAS __attribute__((address_space(3)))
typedef unsigned short bf16_t;
typedef short bf16x8 __attribute__((ext_vector_type(8)));
typedef float f32x4 __attribute__((ext_vector_type(4)));
typedef float f32x2 __attribute__((ext_vector_type(2)));
typedef unsigned u32x4 __attribute__((ext_vector_type(4)));
typedef unsigned u32x2 __attribute__((ext_vector_type(2)));
constexpr int BM = 256, BK = 64, HALF = 128, HTB = HALF * BK * 2, STAGE_BYTES = 8 * HTB, NXCD = 8, WGM = 8, KD = 1024;

__host__ __device__ __forceinline__ int lds_byte(int r, int c) { const int st = (r >> 4) * 2 + (c >> 5), rr = r & 15, cc = c & 31, ob = rr * 64 + cc * 2; return st * 1024 + (ob ^ (((ob >> 9) & 1) << 5)); }
__host__ __device__ __forceinline__ void stage_rc(int b, int& R, int& C) { const int st = b / 1024, sb = b % 1024, swz = sb ^ (((sb >> 9) & 1) << 5); R = (st >> 1) * 16 + swz / 64; C = (st & 1) * 32 + (swz % 64) / 2; }
__host__ __device__ __forceinline__ int perm32(int rho) { const int n = rho >> 4, i = rho & 15; return 8 * (i >> 2) + 4 * n + (i & 3); }

struct Unit { int pm, pn, e; };

struct PlainOrder {
    static constexpr bool GATHER = false;
    const bf16_t* A; const bf16_t* Bt; int nM, nN, nwg, G, c;
    __device__ void init(const bf16_t* A_, const bf16_t* Bt_, int M, int N, int G_, int c_) { A = A_; Bt = Bt_; nM = M / BM; nN = N / BM; nwg = nM * nN; G = G_; c = c_; }
    __device__ __forceinline__ bool next(int i, Unit& u) const {
        const long L = (long)i * G + c; if (L >= nwg) return false;
        int wgid = (int)L; { const int q = nwg / NXCD, r = nwg % NXCD, xcd = wgid % NXCD, off = wgid / NXCD; wgid = (xcd < r ? xcd * (q + 1) : r * (q + 1) + (xcd - r) * q) + off; }
        const int nig = WGM * nN, gid = wgid / nig, fm = gid * WGM, gsz = (nM - fm) < WGM ? (nM - fm) : WGM;
        u.pm = fm + ((wgid % nig) % gsz); u.pn = (wgid % nig) / gsz; u.e = 0; return true;
    }
    __device__ __forceinline__ const char* a_base(const Unit& u) const { return (const char*)A + (size_t)u.pm * ((size_t)BM * KD * 2); }
    __device__ __forceinline__ const char* b_base(const Unit& u) const { return (const char*)Bt + (size_t)u.pn * ((size_t)BM * KD * 2); }
    __device__ __forceinline__ void load_rows(const Unit&, unsigned (&)[2][2]) const {}
};
template <bool GATHER_> struct MoeOrder {
    static constexpr bool GATHER = GATHER_;
    const bf16_t* A; const bf16_t* Bt; const int* tile_exp; const int* slot_tok; int tile0, ntile, nN, G, c;
    __device__ __forceinline__ bool next(int i, Unit& u) const {
        const long L = (long)i * G + c; if (L >= (long)ntile * nN) return false;
        const int pl = (int)(L / nN); u.pn = (int)(L % nN); u.pm = tile0 + pl; u.e = tile_exp[u.pm]; return true;
    }
    __device__ __forceinline__ const char* a_base(const Unit& u) const { return GATHER ? (const char*)A : (const char*)A + (size_t)(u.pm - tile0) * ((size_t)BM * KD * 2); }
    __device__ __forceinline__ const char* b_base(const Unit& u) const { return (const char*)Bt + ((size_t)u.e * nN + u.pn) * ((size_t)BM * KD * 2); }
    __device__ __forceinline__ void load_rows(const Unit& u, unsigned (&out)[2][2]) const {
#pragma unroll
        for (int i = 0; i < 2; ++i) { int R, C; stage_rc((int)threadIdx.x * 16 + i * 8192, R, C);
#pragma unroll
            for (int h = 0; h < 2; ++h) out[h][i] = (unsigned)slot_tok[u.pm * BM + h * HALF + R] * (unsigned)(KD * 2) + (unsigned)C * 2u; }
    }
};

__device__ __forceinline__ unsigned cvt_pk_bf16(float lo, float hi) { unsigned r; asm volatile("v_cvt_pk_bf16_f32 %0, %1, %2" : "=v"(r) : "v"(lo), "v"(hi)); return r; }
__device__ __forceinline__ float bf_lo(unsigned w) { return __uint_as_float(w << 16); }
__device__ __forceinline__ float bf_hi(unsigned w) { return __uint_as_float(w & 0xffff0000u); }

template <class Epi, class Sched, bool ALIGN_EPI>
__device__ __forceinline__ void gemm_phase(PG8_LAS unsigned char* lds, const Sched& S, const Epi& E) {
    const int tid = threadIdx.x, wid = __builtin_amdgcn_readfirstlane(tid >> 6), lane = tid & 63, wr = wid >> 2, wc = wid & 3, fr = lane & 15, fq = lane >> 4;
    constexpr int K = KD, nt = K / BK;
    unsigned voffA[2], voffB[2];
#pragma unroll
    for (int i = 0; i < 2; ++i) { int R, C; stage_rc(tid * 16 + i * 8192, R, C); const int Rb = Epi::PERM ? ((R & ~31) + perm32(R & 31)) : R;
        voffA[i] = (unsigned)(R * K + C) * 2u; voffB[i] = (unsigned)(Rb * K + C) * 2u; }
    constexpr size_t kstep = (size_t)(BK * 2);
    constexpr size_t hstep = (size_t)HALF * K * 2;
    const unsigned ldsw = (unsigned)wid * 1024u;
    const int aoff = lds_byte(wr * 64 + fr, fq * 8), boff = lds_byte(wc * 32 + fr, fq * 8);
#define PG8_SA(b, h) (((b) * 2 + (h)) * HTB)
#define PG8_SB(b, h) ((4 + (b) * 2 + (h)) * HTB)
#define PG8_STAGE(bufoff, gbase, voff) do { _Pragma("unroll") for (int _i = 0; _i < 2; ++_i) \
        __builtin_amdgcn_global_load_lds((const unsigned*)((const char*)(gbase) + (voff)[_i]), (PG8_LAS unsigned*)(lds + (bufoff) + ldsw + _i * 8192), 16, 0, 0); } while (0)
#define PG8_STAGE_B(b, h, base) PG8_STAGE(PG8_SB(b, h), (base) + (h) * hstep, voffB)
#define PG8_STAGE_A(b, h, base, GO) do { if constexpr (Sched::GATHER) { PG8_STAGE(PG8_SA(b, h), (base), GO[h]); } else { PG8_STAGE(PG8_SA(b, h), (base) + (h) * hstep, voffA); } } while (0)
#define PG8_LDA(dst, b, h) do { _Pragma("unroll") for (int m = 0; m < 4; ++m) _Pragma("unroll") for (int k = 0; k < 2; ++k) dst[m][k] = *(const PG8_LAS bf16x8*)(lds + PG8_SA(b, h) + aoff + m * 2048 + k * 1024); } while (0)
#define PG8_LDB(dst, b, h) do { _Pragma("unroll") for (int n = 0; n < 2; ++n) _Pragma("unroll") for (int k = 0; k < 2; ++k) dst[n][k] = *(const PG8_LAS bf16x8*)(lds + PG8_SB(b, h) + boff + n * 2048 + k * 1024); } while (0)
#define PG8_MMA(ai, bj, At, Bt) do { __builtin_amdgcn_s_setprio(1); _Pragma("unroll") for (int m = 0; m < 4; ++m) _Pragma("unroll") for (int n = 0; n < 2; ++n) _Pragma("unroll") for (int k = 0; k < 2; ++k) \
        acc[ai][bj][m][n] = __builtin_amdgcn_mfma_f32_16x16x32_bf16(Bt[n][k], At[m][k], acc[ai][bj][m][n], 0, 0, 0); __builtin_amdgcn_s_setprio(0); } while (0)
#define PG8_WAIT_V(n) asm volatile("s_waitcnt vmcnt(" #n ")" ::: "memory")
#define PG8_WAIT_L(n) asm volatile("s_waitcnt lgkmcnt(" #n ")" ::: "memory")
#define PG8_BAR __builtin_amdgcn_s_barrier()
#define PG8_SCHED __builtin_amdgcn_sched_barrier(0)
    Unit cur, nxt; int ui = 0;
    if (!S.next(0, cur)) return;
    f32x4 acc[2][2][4][2];
#pragma unroll
    for (int a = 0; a < 2; ++a)
#pragma unroll
        for (int b = 0; b < 2; ++b)
#pragma unroll
            for (int m = 0; m < 4; ++m)
#pragma unroll
                for (int n = 0; n < 2; ++n) acc[a][b][m][n] = (f32x4){0.f, 0.f, 0.f, 0.f};
    bf16x8 At[4][2], B0[2][2], B1[2][2];
    unsigned gA[2][2] = {{0u, 0u}, {0u, 0u}};
    const char* cA = S.a_base(cur); const char* cB = S.b_base(cur);
    if constexpr (Sched::GATHER) S.load_rows(cur, gA);
    PG8_STAGE_B(0, 0, cB); PG8_STAGE_B(0, 1, cB); PG8_STAGE_A(0, 0, cA, gA); PG8_STAGE_A(0, 1, cA, gA);
    if (wr == 1) PG8_BAR;
    PG8_WAIT_V(2); PG8_BAR;
    PG8_STAGE_B(1, 0, cB + kstep); PG8_STAGE_A(1, 0, cA + kstep, gA); PG8_STAGE_B(1, 1, cB + kstep);
    PG8_WAIT_V(6); PG8_BAR;
    for (;;) {
        const bool has_next = S.next(ui + 1, nxt);
        const char* nA = has_next ? S.a_base(nxt) : cA; const char* nB = has_next ? S.b_base(nxt) : cB;
        for (int t = 0; t < nt; t += 2) {
            const bool last = (t == nt - 2);
            const char* a1 = cA + (size_t)(t + 1) * kstep;
            const char* a2 = last ? nA : cA + (size_t)(t + 2) * kstep; const char* b2 = last ? nB : cB + (size_t)(t + 2) * kstep;
            const char* a3 = a2 + kstep; const char* b3 = b2 + kstep;
            PG8_LDB(B0, 0, 0); PG8_LDB(B1, 0, 1); PG8_SCHED; PG8_LDA(At, 0, 0); PG8_STAGE_A(1, 1, a1, gA);
            if constexpr (Sched::GATHER) { if (last && has_next) S.load_rows(nxt, gA); }
            PG8_WAIT_V(8); PG8_WAIT_L(0); PG8_BAR; PG8_MMA(0, 0, At, B0); PG8_MMA(0, 1, At, B1); PG8_BAR; PG8_SCHED;
            PG8_LDA(At, 0, 1); PG8_STAGE_B(0, 0, b2); PG8_STAGE_B(0, 1, b2); PG8_STAGE_A(0, 0, a2, gA);
            PG8_WAIT_V(8); PG8_WAIT_L(0); PG8_BAR; PG8_MMA(1, 0, At, B0); PG8_MMA(1, 1, At, B1); PG8_BAR; PG8_SCHED;
            PG8_LDB(B0, 1, 0); PG8_LDB(B1, 1, 1); PG8_SCHED; PG8_LDA(At, 1, 0); PG8_STAGE_A(0, 1, a2, gA);
            PG8_WAIT_V(8); PG8_WAIT_L(0); PG8_BAR; PG8_MMA(0, 0, At, B0); PG8_MMA(0, 1, At, B1); PG8_BAR; PG8_SCHED;
            PG8_LDA(At, 1, 1); PG8_STAGE_B(1, 0, b3); PG8_STAGE_B(1, 1, b3); PG8_STAGE_A(1, 0, a3, gA);
            PG8_WAIT_V(8); PG8_WAIT_L(0); PG8_BAR; PG8_MMA(1, 0, At, B0); PG8_MMA(1, 1, At, B1); PG8_BAR; PG8_SCHED;
        }
        if constexpr (ALIGN_EPI) { if (wr == 0) PG8_BAR; }
        E(acc, cur, wr, wc, fr, fq);
        if (!has_next) break;
#pragma unroll
        for (int a = 0; a < 2; ++a)
#pragma unroll
            for (int b = 0; b < 2; ++b)
#pragma unroll
                for (int m = 0; m < 4; ++m)
#pragma unroll
                    for (int n = 0; n < 2; ++n) acc[a][b][m][n] = (f32x4){0.f, 0.f, 0.f, 0.f};
        cur = nxt; cA = nA; cB = nB; ++ui;
        if constexpr (ALIGN_EPI) { if (wr == 1) PG8_BAR; }
    }
    PG8_WAIT_V(0);
    if constexpr (!ALIGN_EPI) { if (wr == 0) PG8_BAR; }
    PG8_BAR;
#undef PG8_SA
#undef PG8_SB
#undef PG8_STAGE
#undef PG8_STAGE_A
#undef PG8_STAGE_B
#undef PG8_LDA
#undef PG8_LDB
#undef PG8_MMA
#undef PG8_WAIT_V
#undef PG8_WAIT_L
#undef PG8_BAR
#undef PG8_SCHED
}
}

constexpr int NWAVES = 8;
constexpr int BATCH = 16, SEQ = 4096, D = 1024, NTOK = BATCH * SEQ, DIN = 6144, NE = 32, TOPK = 4;
constexpr int CAPROWS = NTOK * TOPK + NE * 256, NTILE_MAX = CAPROWS / 256;
constexpr int TILES_A = 512, TILES_B_MAX = NTILE_MAX - TILES_A;
constexpr float EPS = 1e-6f;
constexpr int N_PHASES = 14;

constexpr size_t MiB = 1u << 20;
constexpr size_t WS_CTL = 0, CTL_ZERO_BYTES = 1 * MiB;
constexpr size_t WS_MOD = 1 * MiB;
constexpr size_t WS_WIN = 2 * MiB;
constexpr size_t WS_WBRR = 14 * MiB, WS_WBRS = 16 * MiB, WS_WOUT = 18 * MiB;
constexpr size_t WS_TOPI = 21 * MiB, WS_TOPW = 22 * MiB, WS_TSLOT = 23 * MiB;
constexpr size_t WS_SLOTTOK = 24 * MiB;
constexpr size_t WS_SLOTW = 26 * MiB;
constexpr size_t WS_BLKCNT = 28 * MiB;
constexpr size_t WS_TILEEXP = 28 * MiB + 65536;
constexpr size_t WS_H = 32 * MiB;
constexpr size_t WS_Z = 160 * MiB;
constexpr size_t ZREG = (size_t)NTOK * D * 2;
constexpr size_t WS_WGU = 160 * MiB;
constexpr size_t WS_YHI = 32 * MiB;
constexpr size_t WS_WDN = 304 * MiB;
constexpr size_t WS_ACT = 368 * MiB;
constexpr size_t WS_YLO = 640 * MiB;
constexpr size_t WS_END = 896 * MiB;
static_assert(WS_Z + 6 * ZREG <= 1024 * MiB, "z fits");
static_assert(WS_YHI + (size_t)TILES_B_MAX * 256 * D * 2 <= WS_WDN && WS_WDN + (size_t)NE * D * D * 2 <= WS_ACT && WS_ACT + (size_t)TILES_B_MAX * 256 * D * 2 <= WS_YLO && WS_YLO + (size_t)TILES_A * 256 * D * 2 <= WS_END, "moe map");
constexpr int CW_TMO = 0;
constexpr int CW_BAR = 4096;

constexpr int RING_BYTES = 131072;
constexpr int MISC_OFF = RING_BYTES + 320;
constexpr int AUX_OFF = RING_BYTES + 1024;
constexpr int LDS_BYTES = 147456;

#define GAS __attribute__((address_space(1)))
#define LAS __attribute__((address_space(3)))
typedef unsigned short bf16;
typedef unsigned v4u __attribute__((ext_vector_type(4)));
typedef unsigned v2u __attribute__((ext_vector_type(2)));
typedef float f32x4 __attribute__((ext_vector_type(4)));
typedef GAS unsigned gu32;
#define RLX_AGENT __ATOMIC_RELAXED, __HIP_MEMORY_SCOPE_AGENT
#define LDS_WAIT() asm volatile("s_waitcnt lgkmcnt(0)" ::: "memory")
#define VM_WAIT() asm volatile("s_waitcnt vmcnt(0)" ::: "memory")
__device__ __forceinline__ unsigned f2bf(float f) { unsigned u = __builtin_bit_cast(unsigned, f); return (u + 0x7fffu + ((u >> 16) & 1u)) >> 16; }
__device__ __forceinline__ unsigned pk2(float lo, float hi) { return f2bf(lo) | (f2bf(hi) << 16); }
__device__ __forceinline__ float bf2f(bf16 b) { return __uint_as_float(((unsigned)b) << 16); }

#define XB_TMO      128
#define XB_XCNT(j)  (256  + 64 * (j))
#define XB_XSUB(j)  (1280 + 64 * (j))
#define XB_XGEN(j)  (2304 + 64 * (j))
#define XB_TOP      3328
#define XB_TOPGEN   3392
#define XCD_BAR_WORDS 3456
#define XB_SPIN_CAP (1u << 18)
__device__ __forceinline__ unsigned xb_ld(unsigned* p)              { return __hip_atomic_load(p, __ATOMIC_RELAXED, __HIP_MEMORY_SCOPE_AGENT); }
__device__ __forceinline__ unsigned xb_add(unsigned* p, unsigned v) { return __hip_atomic_fetch_add(p, v, __ATOMIC_RELAXED, __HIP_MEMORY_SCOPE_AGENT); }
__device__ __forceinline__ unsigned xb_xcc_id() { return (unsigned)__builtin_amdgcn_s_getreg((3 << 11) | 20) & 0xFu; }
#define XB_SPIN(cond, bar) do { unsigned _sp = 0; while (cond) { __builtin_amdgcn_s_sleep(1); \
    if ((++_sp & 255u) == 0u) { if (xb_ld(&(bar)[XB_TMO])) break; if (_sp > XB_SPIN_CAP) { atomicAdd(&(bar)[XB_TMO], 1u); break; } } } } while (0)
struct XcdBarrier { unsigned* bar; unsigned x; volatile LAS unsigned* st; };
__device__ __forceinline__ XcdBarrier xcd_barrier_post(unsigned* bar, volatile LAS unsigned* st) {
    XcdBarrier b; b.bar = bar; b.x = xb_xcc_id(); b.st = st;
    if (threadIdx.x == 0) (void)xb_add(&bar[XB_XCNT(b.x)], 1u);
    return b;
}
__device__ __forceinline__ void xcd_barrier_complete(unsigned* bar, unsigned x, unsigned& nloc, unsigned& nx) {
    const unsigned G = gridDim.x * gridDim.y * gridDim.z;
    unsigned sum, cnt, mine, sp = 0u;
    for (;;) {
        sum = 0u; cnt = 0u; mine = 0u;
#pragma unroll
        for (unsigned j = 0; j < 16; ++j) { const unsigned c = xb_ld(&bar[XB_XCNT(j)]); sum += c; cnt += (c > 0u) ? 1u : 0u; mine = (j == x) ? c : mine; }
        if (sum == G) break;
        __builtin_amdgcn_s_sleep(1);
        if ((++sp & 255u) == 0u) { if (xb_ld(&bar[XB_TMO])) break; if (sp > XB_SPIN_CAP) { atomicAdd(&bar[XB_TMO], 1u); break; } }
    }
    nloc = mine > 0u ? mine : 1u; nx = cnt > 0u ? cnt : 1u;
}
__device__ __forceinline__ void xcd_barrier(const XcdBarrier& b) {
    asm volatile("s_waitcnt vmcnt(0)" ::: "memory");
    __syncthreads();
    if (threadIdx.x == 0) {
        unsigned* bar = b.bar;
        __builtin_amdgcn_s_waitcnt(0);
        unsigned nloc = b.st[0], nx = b.st[1];
        if (nloc == 0u) { xcd_barrier_complete(bar, b.x, nloc, nx); b.st[0] = nloc; b.st[1] = nx; }
        const unsigned old = xb_add(&bar[XB_XSUB(b.x)], 1u);
        const unsigned gen = old / nloc;
        if (old + 1u == (gen + 1u) * nloc) {
            __builtin_amdgcn_fence(__ATOMIC_RELEASE, "agent");
            asm volatile("s_waitcnt vmcnt(0)" ::: "memory");
            const unsigned og = xb_add(&bar[XB_TOP], 1u);
            const unsigned tg = og / nx;
            if (og + 1u == (tg + 1u) * nx) xb_add(&bar[XB_TOPGEN], 1u);
            else XB_SPIN(xb_ld(&bar[XB_TOPGEN]) == tg, bar);
            __builtin_amdgcn_fence(__ATOMIC_ACQUIRE, "agent");
            xb_add(&bar[XB_XGEN(b.x)], 1u);
            asm volatile("s_waitcnt vmcnt(0)" ::: "memory");
        } else {
            XB_SPIN(xb_ld(&bar[XB_XGEN(b.x)]) == gen, bar);
            __builtin_amdgcn_fence(__ATOMIC_ACQUIRE, "agent");
            asm volatile("s_waitcnt vmcnt(0)" ::: "memory");
        }
    }
    __syncthreads();
}

__device__ __forceinline__ float wave_sum(float v) {
#pragma unroll
    for (int o = 1; o < 64; o <<= 1) v += __shfl_xor(v, o);
    return v;
}
__device__ __forceinline__ float fast_sigmoid(float x) { return __builtin_amdgcn_rcpf(1.0f + __builtin_amdgcn_exp2f(-1.4426950409f * x)); }
__device__ __forceinline__ float gelu_tanh(float x) { const float a = x * (1.5957691216f + 0.0713548163f * x * x); return x * fast_sigmoid(a); }

struct EpiZ {
    static constexpr bool PERM = true;
    bf16* Z;
    __device__ __forceinline__ void operator()(const pg8::f32x4 (&acc)[2][2][4][2], const pg8::Unit& u, int wr, int wc, int fr, int fq) const {
        const int region = u.pn >> 2; const int row0 = u.pm * 256 + wr * 64 + fr, col0 = (u.pn & 3) * 256 + wc * 32 + 8 * fq;
        bf16* base = Z + (size_t)region * ((size_t)NTOK * D);
        const bool isg = (region >= 1 && region <= 3), iss = (region >= 4);
#pragma unroll
        for (int ai = 0; ai < 2; ++ai)
#pragma unroll
            for (int m = 0; m < 4; ++m) { bf16* rowp = base + (size_t)(row0 + ai * 128 + m * 16) * D + col0;
#pragma unroll
                for (int bj = 0; bj < 2; ++bj) { float v[8];
#pragma unroll
                    for (int j = 0; j < 4; ++j) { v[j] = acc[ai][bj][m][0][j]; v[4 + j] = acc[ai][bj][m][1][j]; }
#pragma unroll
                    for (int j = 0; j < 8; ++j) { const float x = v[j]; const float a = isg ? x * (1.5957691216f + 0.0713548163f * x * x) : x; const float s = fast_sigmoid(a);
                        v[j] = isg ? x * s : (iss ? s : x); }
                    pg8::u32x4 w; w.x = pg8::cvt_pk_bf16(v[0], v[1]); w.y = pg8::cvt_pk_bf16(v[2], v[3]); w.z = pg8::cvt_pk_bf16(v[4], v[5]); w.w = pg8::cvt_pk_bf16(v[6], v[7]);
                    *(pg8::u32x4*)(rowp + bj * 128) = w; } }
    }
};
struct EpiMerge {
    static constexpr bool PERM = true;
    const bf16* gate; const bf16* addend; bf16* out;
    __device__ __forceinline__ void operator()(const pg8::f32x4 (&acc)[2][2][4][2], const pg8::Unit& u, int wr, int wc, int fr, int fq) const {
        const int row0 = u.pm * 256 + wr * 64 + fr, col0 = u.pn * 256 + wc * 32 + 8 * fq;
#pragma unroll
        for (int ai = 0; ai < 2; ++ai)
#pragma unroll
            for (int m = 0; m < 4; ++m) { const size_t off = (size_t)(row0 + ai * 128 + m * 16) * D + col0;
#pragma unroll
                for (int bj = 0; bj < 2; ++bj) {
                    const pg8::u32x4 g = *(const pg8::u32x4*)(gate + off + bj * 128);
                    pg8::u32x4 ad = (pg8::u32x4){0u, 0u, 0u, 0u}; if (addend) ad = *(const pg8::u32x4*)(addend + off + bj * 128);
                    const pg8::f32x4 a0 = acc[ai][bj][m][0], a1 = acc[ai][bj][m][1];
                    pg8::u32x4 w;
                    w.x = pg8::cvt_pk_bf16(pg8::bf_lo(ad.x) + pg8::bf_lo(g.x) * a0[0], pg8::bf_hi(ad.x) + pg8::bf_hi(g.x) * a0[1]);
                    w.y = pg8::cvt_pk_bf16(pg8::bf_lo(ad.y) + pg8::bf_lo(g.y) * a0[2], pg8::bf_hi(ad.y) + pg8::bf_hi(g.y) * a0[3]);
                    w.z = pg8::cvt_pk_bf16(pg8::bf_lo(ad.z) + pg8::bf_lo(g.z) * a1[0], pg8::bf_hi(ad.z) + pg8::bf_hi(g.z) * a1[1]);
                    w.w = pg8::cvt_pk_bf16(pg8::bf_lo(ad.w) + pg8::bf_lo(g.w) * a1[2], pg8::bf_hi(ad.w) + pg8::bf_hi(g.w) * a1[3]);
                    *(pg8::u32x4*)(out + off + bj * 128) = w; } }
    }
};
struct EpiResid {
    static constexpr bool PERM = false;
    const float* x; const float* gt; float* out;
    __device__ __forceinline__ void operator()(const pg8::f32x4 (&acc)[2][2][4][2], const pg8::Unit& u, int wr, int wc, int fr, int fq) const {
        const int row0 = u.pm * 256 + wr * 64 + fr, col0 = u.pn * 256 + wc * 32 + 4 * fq; const int b = u.pm >> 4;
        pg8::f32x4 gv[2][2];
#pragma unroll
        for (int bj = 0; bj < 2; ++bj)
#pragma unroll
            for (int n = 0; n < 2; ++n) gv[bj][n] = *(const pg8::f32x4*)(gt + (size_t)b * DIN + col0 + bj * 128 + n * 16);
#pragma unroll
        for (int ai = 0; ai < 2; ++ai)
#pragma unroll
            for (int m = 0; m < 4; ++m) { const size_t off = (size_t)(row0 + ai * 128 + m * 16) * D + col0;
#pragma unroll
                for (int bj = 0; bj < 2; ++bj)
#pragma unroll
                    for (int n = 0; n < 2; ++n) { const pg8::f32x4 xv = *(const pg8::f32x4*)(x + off + bj * 128 + n * 16);
                        *(pg8::f32x4*)(out + off + bj * 128 + n * 16) = xv + gv[bj][n] * acc[ai][bj][m][n]; } }
    }
};
struct EpiGu {
    static constexpr bool PERM = true;
    bf16* act; const float* bgu; int tile0;
    __device__ __forceinline__ void operator()(const pg8::f32x4 (&acc)[2][2][4][2], const pg8::Unit& u, int wr, int wc, int fr, int fq) const {
        const int row0 = (u.pm - tile0) * 256 + wr * 64 + fr, cc = u.pn * 128 + wc * 32 + 8 * fq;
        const float* bg = bgu + (size_t)u.e * 2048 + cc;
        const pg8::f32x4 bg0 = *(const pg8::f32x4*)(bg), bg1 = *(const pg8::f32x4*)(bg + 4), bu0 = *(const pg8::f32x4*)(bg + 1024), bu1 = *(const pg8::f32x4*)(bg + 1028);
#pragma unroll
        for (int ai = 0; ai < 2; ++ai)
#pragma unroll
            for (int m = 0; m < 4; ++m) { float o[8];
#pragma unroll
                for (int j = 0; j < 8; ++j) {
                    float g = (j < 4 ? acc[ai][0][m][0][j & 3] + bg0[j & 3] : acc[ai][0][m][1][j & 3] + bg1[j & 3]);
                    float up = (j < 4 ? acc[ai][1][m][0][j & 3] + bu0[j & 3] : acc[ai][1][m][1][j & 3] + bu1[j & 3]);
                    g = fminf(g, 7.0f); up = fminf(fmaxf(up, -7.0f), 7.0f);
                    o[j] = (up + 1.0f) * (g * fast_sigmoid(1.702f * g)); }
                pg8::u32x4 w; w.x = pg8::cvt_pk_bf16(o[0], o[1]); w.y = pg8::cvt_pk_bf16(o[2], o[3]); w.z = pg8::cvt_pk_bf16(o[4], o[5]); w.w = pg8::cvt_pk_bf16(o[6], o[7]);
                *(pg8::u32x4*)(act + (size_t)(row0 + ai * 128 + m * 16) * D + cc) = w; }
    }
};
struct EpiDown {
    static constexpr bool PERM = true;
    bf16* y; const float* bd; const float* slot_w; int tile0;
    __device__ __forceinline__ void operator()(const pg8::f32x4 (&acc)[2][2][4][2], const pg8::Unit& u, int wr, int wc, int fr, int fq) const {
        const int rl0 = (u.pm - tile0) * 256 + wr * 64 + fr, rg0 = u.pm * 256 + wr * 64 + fr, col0 = u.pn * 256 + wc * 32 + 8 * fq;
        const float* bp = bd + (size_t)u.e * D + col0;
        pg8::f32x4 bv[2][2];
#pragma unroll
        for (int bj = 0; bj < 2; ++bj) { bv[bj][0] = *(const pg8::f32x4*)(bp + bj * 128); bv[bj][1] = *(const pg8::f32x4*)(bp + bj * 128 + 4); }
#pragma unroll
        for (int ai = 0; ai < 2; ++ai)
#pragma unroll
            for (int m = 0; m < 4; ++m) { const float sw = slot_w[rg0 + ai * 128 + m * 16]; bf16* rowp = y + (size_t)(rl0 + ai * 128 + m * 16) * D + col0;
#pragma unroll
                for (int bj = 0; bj < 2; ++bj) { const pg8::f32x4 v0 = (acc[ai][bj][m][0] + bv[bj][0]) * sw, v1 = (acc[ai][bj][m][1] + bv[bj][1]) * sw;
                    pg8::u32x4 w; w.x = pg8::cvt_pk_bf16(v0[0], v0[1]); w.y = pg8::cvt_pk_bf16(v0[2], v0[3]); w.z = pg8::cvt_pk_bf16(v1[0], v1[1]); w.w = pg8::cvt_pk_bf16(v1[2], v1[3]);
                    *(pg8::u32x4*)(rowp + bj * 128) = w; } }
    }
};

__device__ __forceinline__ void transpose_item(const float* W, int ldn, int K, int k0, int n0, bf16* WT, int drow0, LAS float* scr, int lane) {
#pragma unroll 8
    for (int i = 0; i < 32; ++i) { const int kk = 2 * i + (lane >> 5); scr[kk * 33 + (lane & 31)] = W[(size_t)(k0 + kk) * ldn + n0 + (lane & 31)]; }
    LDS_WAIT(); asm volatile("" ::: "memory");
    const int c = lane & 7;
#pragma unroll
    for (int j = 0; j < 4; ++j) { const int n = (lane >> 3) + 8 * j; const LAS float* s = scr + (8 * c) * 33 + n;
        v4u o; o.x = pk2(s[0 * 33], s[1 * 33]); o.y = pk2(s[2 * 33], s[3 * 33]); o.z = pk2(s[4 * 33], s[5 * 33]); o.w = pk2(s[6 * 33], s[7 * 33]);
        *(GAS v4u*)(WT + (size_t)(drow0 + n) * K + k0 + 8 * c) = o; }
    LDS_WAIT(); asm volatile("" ::: "memory");
}

struct Args {
    const float* in[28]; float* out; unsigned char* ws; int ph_lo, ph_hi, li, pad;
};
enum { I_X = 0, I_C, I_ADAW, I_ADAB, I_N1G, I_WIN, I_CONVW, I_CONVB, I_LWA, I_LBA, I_LWX, I_LBX, I_LAM, I_SGLNG, I_SGLNB, I_SGWS, I_SGBS, I_WBRR, I_WBRS, I_WOUT, I_N2G, I_WR, I_BR, I_WGU, I_BGU, I_WDN, I_BDN, I_FG };

__global__ void __launch_bounds__(NWAVES * 64, 2) mega_fwd(Args args) {
    extern __shared__ __attribute__((aligned(16))) unsigned char lds_raw[];
    LAS unsigned char* lds = (LAS unsigned char*)lds_raw;
    volatile LAS unsigned* MISC = (volatile LAS unsigned*)(lds + MISC_OFF);
    const int tid = threadIdx.x, lane = tid & 63, wave = __builtin_amdgcn_readfirstlane(tid >> 6);
    const int G = gridDim.x; const int bx = blockIdx.x;
    const int vcu = (G % 8 == 0) ? (bx % 8) * (G / 8) + bx / 8 : bx;
    unsigned char* ws = args.ws;
    gu32* ctl = (gu32*)(ws + WS_CTL);
    for (int u = tid; u < (LDS_BYTES - RING_BYTES) / 4; u += NWAVES * 64) ((LAS unsigned*)(lds + RING_BYTES))[u] = 0u;
    __syncthreads();
#if MK_PER_PHASE
    XcdBarrier bar; bar.bar = (unsigned*)(ctl + CW_BAR); bar.x = 0; bar.st = nullptr;
#define GRID_BAR() do { if (tid == 0) __hip_atomic_store(ctl + CW_TMO, 0xBADBA0u, RLX_AGENT); } while (0)
#else
    XcdBarrier bar = xcd_barrier_post((unsigned*)(ctl + CW_BAR), MISC + 8);
#define GRID_BAR() xcd_barrier(bar)
#endif
    const int lo = args.ph_lo, hi = args.ph_hi;
#define IN(k) (lo <= (k) && (k) < hi)
#define BOTH(k) (IN(k) && IN((k) + 1))

    const float* x_in = args.in[I_X];
    float* modv = (float*)(ws + WS_MOD);
    bf16* Hb = (bf16*)(ws + WS_H);
    bf16* Zb = (bf16*)(ws + WS_Z);
    bf16* Z0 = Zb, *Z1 = Zb + (size_t)NTOK * D, *Z2 = Zb + 2 * (size_t)NTOK * D, *Z3 = Zb + 3 * (size_t)NTOK * D, *Z4 = Zb + 4 * (size_t)NTOK * D, *Z5 = Zb + 5 * (size_t)NTOK * D;
    int* top_idx = (int*)(ws + WS_TOPI); float* top_w = (float*)(ws + WS_TOPW); int* tok_slot = (int*)(ws + WS_TSLOT);
    int* slot_tok = (int*)(ws + WS_SLOTTOK); float* slot_w = (float*)(ws + WS_SLOTW); int* blkcnt = (int*)(ws + WS_BLKCNT); int* tile_exp = (int*)(ws + WS_TILEEXP);
    const int gw = vcu * NWAVES + wave, NGW = G * NWAVES;

    if (IN(0)) {
        if (bx < 96) {
            LAS float* sc = (LAS float*)lds;
            LAS float* part = (LAS float*)(lds + 65536);
            const float* cin = args.in[I_C];
            for (int q = 0; q < 32; ++q) { const int idx = tid + 512 * q, k = idx >> 4, b = idx & 15; const float v = cin[b * D + k]; sc[idx] = v * fast_sigmoid(v); }
            __syncthreads();
            for (int task = bx; task < 96; task += G) {
                const int j0 = task * 64; const float* aw = args.in[I_ADAW];
                float a16[16];
#pragma unroll
                for (int b = 0; b < 16; ++b) a16[b] = 0.f;
                for (int kk = 0; kk < 128; ++kk) { const int k = wave * 128 + kk; const float wv = aw[(size_t)k * DIN + j0 + lane];
#pragma unroll
                    for (int b4 = 0; b4 < 4; ++b4) { const f32x4 s4 = *(const LAS f32x4*)(sc + k * 16 + b4 * 4);
                        a16[b4 * 4 + 0] += s4[0] * wv; a16[b4 * 4 + 1] += s4[1] * wv; a16[b4 * 4 + 2] += s4[2] * wv; a16[b4 * 4 + 3] += s4[3] * wv; } }
#pragma unroll
                for (int b = 0; b < 16; ++b) part[(wave * 16 + b) * 64 + lane] = a16[b];
                __syncthreads();
                for (int q = 0; q < 2; ++q) { const int o = tid + 512 * q, b = o >> 6, col = o & 63; float s = args.in[I_ADAB][j0 + col];
#pragma unroll
                    for (int w = 0; w < 8; ++w) s += part[(w * 16 + b) * 64 + col];
                    modv[b * DIN + j0 + col] = s; }
                __syncthreads();
            }
        }
        __syncthreads();
        {
            LAS float* scr = (LAS float*)(lds + wave * 16384);
            constexpr int I_IN = 16 * (DIN / 32), I_SQ = 16 * (D / 32);
            for (int it = gw; it < I_IN + 3 * I_SQ; it += NGW) {
                int r = it;
                if (r < I_IN) { const int nblk = DIN / 32, kb = r / nblk, nb = r % nblk; transpose_item(args.in[I_WIN], DIN, D, 64 * kb, 32 * nb, (bf16*)(ws + WS_WIN), 32 * nb, scr, lane); continue; } r -= I_IN;
                const int which = r / I_SQ; r -= which * I_SQ; const int nblk = D / 32, kb = r / nblk, nb = r % nblk;
                const float* W = which == 0 ? args.in[I_WBRR] : (which == 1 ? args.in[I_WBRS] : args.in[I_WOUT]);
                bf16* WT = (bf16*)(ws + (which == 0 ? WS_WBRR : (which == 1 ? WS_WBRS : WS_WOUT)));
                transpose_item(W, D, D, 64 * kb, 32 * nb, WT, 32 * nb, scr, lane);
            }
        }
        if (BOTH(0)) GRID_BAR();
    }

    if (IN(1)) {
        for (int rb = gw; rb < NTOK / 32; rb += NGW) {
            const int b = (rb * 32) / SEQ;
            f32x4 A4[4], B4[4];
#pragma unroll
            for (int j = 0; j < 4; ++j) { const int c = 4 * lane + 256 * j; const f32x4 g = *(const f32x4*)(args.in[I_N1G] + c), s = *(const f32x4*)(modv + b * DIN + 1024 + c);
                A4[j] = g * (1.0f + s); B4[j] = *(const f32x4*)(modv + b * DIN + c); }
            for (int r = 0; r < 32; ++r) {
                const size_t m = (size_t)rb * 32 + r;
                const GAS f32x4* xr = (const GAS f32x4*)(x_in + m * D) + lane;
                f32x4 v[4]; float ss = 0.f;
#pragma unroll
                for (int j = 0; j < 4; ++j) { v[j] = xr[64 * j]; ss += (v[j].x * v[j].x + v[j].y * v[j].y) + (v[j].z * v[j].z + v[j].w * v[j].w); }
                const float rstd = 1.0f / sqrtf(wave_sum(ss) * (1.f / D) + EPS);
                GAS v2u* o8 = (GAS v2u*)(Hb + m * D) + lane;
#pragma unroll
                for (int j = 0; j < 4; ++j) { const f32x4 y = v[j] * rstd * A4[j] + B4[j]; v2u o; o.x = pk2(y.x, y.y); o.y = pk2(y.z, y.w); o8[64 * j] = o; }
            }
        }
        if (BOTH(1)) GRID_BAR();
    }

    if (IN(2)) {
        pg8::PlainOrder S; S.init(Hb, (const bf16*)(ws + WS_WIN), NTOK, DIN, G, bx);
        EpiZ E{Zb};
        pg8::gemm_phase<EpiZ, pg8::PlainOrder, true>(lds, S, E);
        if (BOTH(2)) GRID_BAR();
    }

    if (IN(3)) {
        for (int unit = bx; unit < BATCH * 16; unit += G) {
            const int b = unit >> 4, hd = unit & 15, ch0 = hd * 64;
            LAS float* Wa = (LAS float*)lds;
            LAS float* Wx = Wa + 4096;
            LAS float* xc = Wx + 4096;
            LAS float* av = xc + 4096;
            LAS float* uv = av + 4096;
            LAS float* prm = uv + 4096;
            __syncthreads();
            for (int q = 0; q < 8; ++q) { const int idx = tid + 512 * q; Wa[idx] = args.in[I_LWA][(size_t)hd * 4096 + idx]; Wx[idx] = args.in[I_LWX][(size_t)hd * 4096 + idx]; }
            if (tid < 256) prm[tid] = args.in[I_CONVW][(tid >> 6) * D + ch0 + (tid & 63)];
            else if (tid < 320) prm[tid] = args.in[I_CONVB][ch0 + tid - 256];
            else if (tid < 384) prm[tid] = args.in[I_LBA][ch0 + tid - 320];
            else if (tid < 448) prm[tid] = args.in[I_LBX][ch0 + tid - 384];
            else { const float l = args.in[I_LAM][ch0 + tid - 448]; const float sp = (-l > 20.f) ? -l : log1pf(expf(-l)); prm[tid] = 8.0f * sp; }
            __syncthreads();
            float hstate = 0.f;
            const int j = tid & 63, tq = tid >> 6;
            for (int T0 = 0; T0 < SEQ; T0 += 64) {
#pragma unroll
                for (int q = 0; q < 8; ++q) { const int tt = tq + 8 * q, t = T0 + tt; float s = prm[256 + j];
#pragma unroll
                    for (int k = 0; k < 4; ++k) { const int ts = t - 3 + k; if (ts >= 0) s += prm[k * 64 + j] * bf2f(Z0[((size_t)b * SEQ + ts) * D + ch0 + j]); }
                    xc[tt * 64 + j] = s; }
                __syncthreads();
                { float ra[8], ia[8];
#pragma unroll
                    for (int q = 0; q < 8; ++q) { ra[q] = 0.f; ia[q] = 0.f; }
                    for (int i = 0; i < 64; ++i) { const float wa = Wa[i * 64 + j], wx = Wx[i * 64 + j];
#pragma unroll
                        for (int q = 0; q < 8; ++q) { const float xv = xc[(tq + 8 * q) * 64 + i]; ra[q] += xv * wa; ia[q] += xv * wx; } }
#pragma unroll
                    for (int q = 0; q < 8; ++q) { const int tt = tq + 8 * q;
                        const float r = fast_sigmoid(ra[q] + prm[320 + j]), ig = fast_sigmoid(ia[q] + prm[384 + j]);
                        const float la = -r * prm[448 + j]; const float a = expf(la); const float mult = sqrtf(-expm1f(2.0f * la));
                        av[tt * 64 + j] = a; uv[tt * 64 + j] = mult * ig * xc[tt * 64 + j]; } }
                __syncthreads();
                if (wave == 0) { float h = hstate;
                    for (int tt = 0; tt < 64; ++tt) { h = av[tt * 64 + lane] * h + uv[tt * 64 + lane]; uv[tt * 64 + lane] = h; }
                    hstate = h; }
                __syncthreads();
#pragma unroll
                for (int q = 0; q < 8; ++q) { const int tt = tq + 8 * q; const size_t o = ((size_t)b * SEQ + T0 + tt) * D + ch0 + j;
                    Z1[o] = (bf16)f2bf(uv[tt * 64 + j] * bf2f(Z1[o])); }
            }
            __syncthreads();
        }
        __syncthreads();
        for (int chunk = bx; chunk < NTOK / 128; chunk += G) {
            const size_t row0 = (size_t)chunk * 128;
            LAS float* vn = (LAS float*)lds;
            LAS float* WT = vn + 16384;
            LAS float* st = (LAS float*)(lds + AUX_OFF);
            __syncthreads();
            for (int r = 0; r < 16; ++r) { const int s = wave * 16 + r; const bf16* vr = Z3 + (row0 + s) * D;
                float v[16]; const v4u w0 = *(const v4u*)(vr + 8 * lane), w1 = *(const v4u*)(vr + 512 + 8 * lane);
                v[0] = pg8::bf_lo(w0.x); v[1] = pg8::bf_hi(w0.x); v[2] = pg8::bf_lo(w0.y); v[3] = pg8::bf_hi(w0.y); v[4] = pg8::bf_lo(w0.z); v[5] = pg8::bf_hi(w0.z); v[6] = pg8::bf_lo(w0.w); v[7] = pg8::bf_hi(w0.w);
                v[8] = pg8::bf_lo(w1.x); v[9] = pg8::bf_hi(w1.x); v[10] = pg8::bf_lo(w1.y); v[11] = pg8::bf_hi(w1.y); v[12] = pg8::bf_lo(w1.z); v[13] = pg8::bf_hi(w1.z); v[14] = pg8::bf_lo(w1.w); v[15] = pg8::bf_hi(w1.w);
                float sm = 0.f;
#pragma unroll
                for (int i = 0; i < 16; ++i) sm += v[i];
                const float mean = wave_sum(sm) * (1.f / D); float q2 = 0.f;
#pragma unroll
                for (int i = 0; i < 16; ++i) { const float d = v[i] - mean; q2 += d * d; }
                const float rstd = 1.0f / sqrtf(wave_sum(q2) * (1.f / D) + EPS);
                if (lane == 0) { st[2 * s] = mean; st[2 * s + 1] = rstd; } }
            __syncthreads();
            for (int g = 0; g < 8; ++g) {
                for (int q = 0; q < 32; ++q) { const int idx = tid + 512 * q; const int t = idx & 127, s = idx >> 7;
                    WT[s * 128 + t] = (s <= t) ? args.in[I_SGWS][((size_t)g * 128 + t) * 128 + s] : 0.f; }
                for (int q = 0; q < 32; ++q) { const int idx = tid + 512 * q; const int c = idx & 127, s = idx >> 7; const int col = g * 128 + c;
                    vn[s * 128 + c] = (bf2f(Z3[(row0 + s) * D + col]) - st[2 * s]) * st[2 * s + 1] * args.in[I_SGLNG][col] + args.in[I_SGLNB][col]; }
                __syncthreads();
                { const int c = tid & 127, tb = __builtin_amdgcn_readfirstlane(tid >> 7) * 32;
                    float a32[32];
#pragma unroll
                    for (int i = 0; i < 32; ++i) a32[i] = 0.f;
                    for (int s = 0; s < 128; ++s) { const float v = vn[s * 128 + c];
#pragma unroll
                        for (int i4 = 0; i4 < 8; ++i4) { const f32x4 w4 = *(const LAS f32x4*)(WT + s * 128 + tb + 4 * i4);
                            a32[4 * i4 + 0] += w4[0] * v; a32[4 * i4 + 1] += w4[1] * v; a32[4 * i4 + 2] += w4[2] * v; a32[4 * i4 + 3] += w4[3] * v; } }
#pragma unroll
                    for (int i = 0; i < 32; ++i) { const int t = tb + i; const size_t o = (row0 + t) * D + g * 128 + c;
                        const float sv = a32[i] + args.in[I_SGBS][g * 128 + t];
                        Z2[o] = (bf16)f2bf(bf2f(Z2[o]) * sv); } }
                __syncthreads();
            }
        }
        if (BOTH(3)) GRID_BAR();
    }

    if (IN(4)) {
        pg8::PlainOrder S; S.init(Z1, (const bf16*)(ws + WS_WBRR), NTOK, D, G, bx);
        EpiMerge E{Z4, nullptr, Z0};
        pg8::gemm_phase<EpiMerge, pg8::PlainOrder, true>(lds, S, E);
        if (BOTH(4)) GRID_BAR();
    }
    if (IN(5)) {
        pg8::PlainOrder S; S.init(Z2, (const bf16*)(ws + WS_WBRS), NTOK, D, G, bx);
        EpiMerge E{Z5, Z0, Z3};
        pg8::gemm_phase<EpiMerge, pg8::PlainOrder, true>(lds, S, E);
        if (BOTH(5)) GRID_BAR();
    }
    if (IN(6)) {
        pg8::PlainOrder S; S.init(Z3, (const bf16*)(ws + WS_WOUT), NTOK, D, G, bx);
        EpiResid E{x_in, modv + 2048, args.out};
        pg8::gemm_phase<EpiResid, pg8::PlainOrder, true>(lds, S, E);
        if (BOTH(6)) GRID_BAR();
    }

    if (IN(7)) {
        LAS f32x4* wr4 = (LAS f32x4*)lds;
        LAS unsigned* hist = (LAS unsigned*)(lds + AUX_OFF);
        __syncthreads();
        for (int q = 0; q < 16; ++q) { const int idx = tid + 512 * q; const int l = idx & 63, e4 = (idx >> 6) & 7, jq = idx >> 9; const int c = 4 * l + 256 * (jq >> 2) + (jq & 3);
            wr4[idx] = *(const f32x4*)(args.in[I_WR] + (size_t)c * NE + 4 * e4); }
        __syncthreads();
        for (int tb = bx; tb < NTOK / 256; tb += G) {
            if (tid < 32) hist[tid] = 0u;
            __syncthreads();
            const int m0 = tb * 256 + wave * 32; const int b = m0 / SEQ;
            f32x4 A4[4], B4[4];
#pragma unroll
            for (int j = 0; j < 4; ++j) { const int c = 4 * lane + 256 * j; const f32x4 g = *(const f32x4*)(args.in[I_N2G] + c), s = *(const f32x4*)(modv + b * DIN + 4096 + c);
                A4[j] = g * (1.0f + s); B4[j] = *(const f32x4*)(modv + b * DIN + 3072 + c); }
            for (int r = 0; r < 32; ++r) {
                const size_t m = (size_t)m0 + r;
                const GAS f32x4* xr = (const GAS f32x4*)(args.out + m * D) + lane;
                f32x4 v[4]; float ss = 0.f;
#pragma unroll
                for (int j = 0; j < 4; ++j) { v[j] = xr[64 * j]; ss += (v[j].x * v[j].x + v[j].y * v[j].y) + (v[j].z * v[j].z + v[j].w * v[j].w); }
                const float rstd = 1.0f / sqrtf(wave_sum(ss) * (1.f / D) + EPS);
                GAS v2u* o8 = (GAS v2u*)(Hb + m * D) + lane;
#pragma unroll
                for (int j = 0; j < 4; ++j) { v[j] = v[j] * rstd * A4[j] + B4[j]; v2u o; o.x = pk2(v[j].x, v[j].y); o.y = pk2(v[j].z, v[j].w); o8[64 * j] = o; }
                float p[32];
#pragma unroll
                for (int e = 0; e < 32; ++e) p[e] = 0.f;
#pragma unroll
                for (int j = 0; j < 4; ++j)
#pragma unroll
                    for (int q = 0; q < 4; ++q) { const float hv = v[j][q];
#pragma unroll
                        for (int e4 = 0; e4 < 8; ++e4) { const f32x4 w4 = wr4[((j * 4 + q) * 8 + e4) * 64 + lane];
                            p[4 * e4 + 0] += hv * w4[0]; p[4 * e4 + 1] += hv * w4[1]; p[4 * e4 + 2] += hv * w4[2]; p[4 * e4 + 3] += hv * w4[3]; } }
#pragma unroll
                for (int e = 0; e < 32; ++e) p[e] = wave_sum(p[e]) + args.in[I_BR][e];
                float tv[4]; int ti[4];
#pragma unroll
                for (int k = 0; k < 4; ++k) { float best = -3.0e38f; int bi = 0;
#pragma unroll
                    for (int e = 0; e < 32; ++e) { if (p[e] > best) { best = p[e]; bi = e; } }
                    tv[k] = best; ti[k] = bi;
#pragma unroll
                    for (int e = 0; e < 32; ++e) p[e] = (e == bi) ? -3.0e38f : p[e]; }
                const float e1 = expf(tv[1] - tv[0]), e2 = expf(tv[2] - tv[0]), e3 = expf(tv[3] - tv[0]); const float inv = 1.0f / (1.0f + e1 + e2 + e3);
                if (lane < 4) { const int myi = lane == 0 ? ti[0] : (lane == 1 ? ti[1] : (lane == 2 ? ti[2] : ti[3])); const float myw = (lane == 0 ? 1.0f : (lane == 1 ? e1 : (lane == 2 ? e2 : e3))) * inv;
                    top_idx[m * 4 + lane] = myi; top_w[m * 4 + lane] = myw; atomicAdd((unsigned*)&hist[myi], 1u); }
            }
            __syncthreads();
            if (tid < 32) blkcnt[tb * 32 + tid] = (int)hist[tid];
            __syncthreads();
        }
        __syncthreads();
        {
            LAS float* scr = (LAS float*)(lds + wave * 16384);
            constexpr int I_GU = 16 * 64, I_DN = 16 * 32;
            for (int it = gw; it < NE * (I_GU + I_DN); it += NGW) {
                const int e = it / (I_GU + I_DN); int r = it % (I_GU + I_DN);
                if (r < I_GU) { const int kb = r / 64, nb = r % 64; const int n0 = 32 * nb; const int cidx = n0 & 1023; const int drow = (cidx >> 7) * 256 + (n0 >= 1024 ? 128 : 0) + (cidx & 127);
                    transpose_item(args.in[I_WGU] + (size_t)e * D * 2048, 2048, D, 64 * kb, n0, (bf16*)(ws + WS_WGU) + (size_t)e * 2048 * D, drow, scr, lane); }
                else { r -= I_GU; const int kb = r / 32, nb = r % 32;
                    transpose_item(args.in[I_WDN] + (size_t)e * D * D, D, D, 64 * kb, 32 * nb, (bf16*)(ws + WS_WDN) + (size_t)e * D * D, 32 * nb, scr, lane); }
            }
        }
        if (BOTH(7)) GRID_BAR();
    }

    if (IN(8)) {
        LAS int* sp_tot = (LAS int*)(lds);
        LAS int* sp_pre = sp_tot + 512;
        LAS int* tot = sp_pre + 512;
        LAS int* myoff = tot + 32;
        LAS int* pstart = myoff + 32;
        LAS unsigned* cursor = (LAS unsigned*)(pstart + 64);
        for (int tb = bx; tb < NTOK / 256; tb += G) {
            __syncthreads();
            { const int e = tid & 31, part = tid >> 5; int s_tot = 0, s_pre = 0;
                for (int B = part; B < 256; B += 16) { const int cn = blkcnt[B * 32 + e]; s_tot += cn; if (B < tb) s_pre += cn; }
                sp_tot[part * 32 + e] = s_tot; sp_pre[part * 32 + e] = s_pre; }
            __syncthreads();
            if (tid < 32) { int a = 0, p = 0; for (int q = 0; q < 16; ++q) { a += sp_tot[q * 32 + tid]; p += sp_pre[q * 32 + tid]; } tot[tid] = a; myoff[tid] = p; cursor[tid] = 0u; }
            __syncthreads();
            if (tid == 0) { int acc = 0; for (int e = 0; e < 32; ++e) { pstart[e] = acc; acc += ((tot[e] + 255) >> 8) << 8; } pstart[32] = acc; }
            __syncthreads();
            for (int q = 0; q < 2; ++q) { const int a = tid + 512 * q; const int tok = tb * 256 + (a >> 2);
                const int e = top_idx[(size_t)tok * 4 + (a & 3)]; const unsigned rnk = atomicAdd((unsigned*)&cursor[e], 1u);
                const int slot = pstart[e] + myoff[e] + (int)rnk;
                slot_tok[slot] = tok; slot_w[slot] = top_w[(size_t)tok * 4 + (a & 3)]; tok_slot[(size_t)tok * 4 + (a & 3)] = slot; }
            if (tb < 32) { const int e = tb; const int nt_e = (tot[e] + 255) >> 8;
                for (int r = tot[e] + tid; r < nt_e * 256; r += 512) { slot_tok[pstart[e] + r] = 0; slot_w[pstart[e] + r] = 0.f; }
                for (int i = tid; i < nt_e; i += 512) tile_exp[(pstart[e] >> 8) + i] = e;
                if (e == 0 && tid == 0) tile_exp[NTILE_MAX] = pstart[32] >> 8; }
        }
        if (BOTH(8)) GRID_BAR();
    }

    for (int chunk = 0; chunk < 2; ++chunk) {
        const int pgu = 9 + 2 * chunk, pdn = 10 + 2 * chunk;
        if (IN(pgu) || IN(pdn)) {
            const int ntiles = tile_exp[NTILE_MAX];
            const int tile0 = chunk == 0 ? 0 : TILES_A;
            int ntc = chunk == 0 ? (ntiles < TILES_A ? ntiles : TILES_A) : (ntiles - TILES_A); if (ntc < 0) ntc = 0; if (ntc > TILES_B_MAX) ntc = TILES_B_MAX;
            bf16* actb = (bf16*)(ws + WS_ACT);
            bf16* yb = (bf16*)(ws + (chunk == 0 ? WS_YLO : WS_YHI));
            asm volatile("" : "+s"(actb), "+s"(yb));
            if (IN(pgu)) {
                pg8::MoeOrder<true> S{Hb, (const bf16*)(ws + WS_WGU), tile_exp, slot_tok, tile0, ntc, 8, G, vcu};
                EpiGu E{actb, args.in[I_BGU], tile0};
                pg8::gemm_phase<EpiGu, pg8::MoeOrder<true>, true>(lds, S, E);
                if (BOTH(pgu)) GRID_BAR();
            }
            if (IN(pdn)) {
                pg8::MoeOrder<false> S{actb, (const bf16*)(ws + WS_WDN), tile_exp, slot_tok, tile0, ntc, 4, G, vcu};
                EpiDown E{yb, args.in[I_BDN], slot_w, tile0};
                pg8::gemm_phase<EpiDown, pg8::MoeOrder<false>, true>(lds, S, E);
                if (BOTH(pdn)) GRID_BAR();
            }
        }
    }

    if (IN(13)) {
        const bf16* ylo = (const bf16*)(ws + WS_YLO); const bf16* yhi = (const bf16*)(ws + WS_YHI);
        for (int rb = gw; rb < NTOK / 32; rb += NGW) {
            const int b = (rb * 32) / SEQ;
            f32x4 G4[4], F4[4];
#pragma unroll
            for (int j = 0; j < 4; ++j) { const int c = 4 * lane + 256 * j; G4[j] = *(const f32x4*)(modv + b * DIN + 5120 + c); F4[j] = *(const f32x4*)(args.in[I_FG] + c); }
            for (int r = 0; r < 32; ++r) {
                const size_t m = (size_t)rb * 32 + r;
                GAS f32x4* xr = (GAS f32x4*)(args.out + m * D) + lane;
                f32x4 v[4], s4[4];
#pragma unroll
                for (int j = 0; j < 4; ++j) { v[j] = xr[64 * j]; s4[j] = (f32x4){0.f, 0.f, 0.f, 0.f}; }
#pragma unroll
                for (int k = 0; k < 4; ++k) { const int slot = tok_slot[m * 4 + k];
                    const bf16* yr = slot < TILES_A * 256 ? ylo + (size_t)slot * D : yhi + (size_t)(slot - TILES_A * 256) * D;
                    const GAS v2u* y8 = (const GAS v2u*)yr + lane;
#pragma unroll
                    for (int j = 0; j < 4; ++j) { const v2u w = y8[64 * j]; s4[j] += (f32x4){pg8::bf_lo(w.x), pg8::bf_hi(w.x), pg8::bf_lo(w.y), pg8::bf_hi(w.y)}; } }
                float ss = 0.f;
#pragma unroll
                for (int j = 0; j < 4; ++j) { v[j] = v[j] + G4[j] * s4[j]; ss += (v[j].x * v[j].x + v[j].y * v[j].y) + (v[j].z * v[j].z + v[j].w * v[j].w); }
                const float rstd = 1.0f / sqrtf(wave_sum(ss) * (1.f / D) + EPS);
#pragma unroll
                for (int j = 0; j < 4; ++j) xr[64 * j] = v[j] * rstd * F4[j];
            }
        }
    }
#undef IN
#undef BOTH
}

extern "C" void kernel_launch(void* const* d_in, const int* in_sizes, int n_in, void* d_out, int out_size, void* d_ws, size_t ws_size, hipStream_t stream) {
    static int grid = 0;
    if (grid == 0) {
        if (n_in != 28 || out_size != NTOK * D || ws_size < WS_Z + 6 * ZREG) { fprintf(stderr, "kernel_launch: unexpected shapes (n_in %d out %d ws %zu)\n", n_in, out_size, ws_size); grid = -1; return; }
        int dev = 0, cus = 0, per_cu = 0;
        if (hipGetDevice(&dev) != hipSuccess || hipDeviceGetAttribute(&cus, hipDeviceAttributeMultiprocessorCount, dev) != hipSuccess) { grid = -1; return; }
        if (hipFuncSetAttribute((const void*)mega_fwd, hipFuncAttributeMaxDynamicSharedMemorySize, LDS_BYTES) != hipSuccess) { fprintf(stderr, "kernel_launch: hipFuncSetAttribute failed\n"); grid = -1; return; }
        if (hipOccupancyMaxActiveBlocksPerMultiprocessor(&per_cu, (const void*)mega_fwd, NWAVES * 64, LDS_BYTES) != hipSuccess || per_cu < 1)
            fprintf(stderr, "kernel_launch: occupancy query reports %d workgroups per CU\n", per_cu);
        (void)hipGetLastError();
        grid = cus;
    }
    if (grid < 0) return;
    (void)hipMemsetAsync((char*)d_ws + WS_CTL, 0, CTL_ZERO_BYTES, stream);
    Args a{};
    for (int i = 0; i < 28; ++i) a.in[i] = (const float*)d_in[i];
    a.out = (float*)d_out; a.ws = (unsigned char*)d_ws;
#if MK_PER_PHASE
    for (int p = 0; p < N_PHASES; ++p) { a.ph_lo = p; a.ph_hi = p + 1; a.li = p; a.pad = 0; hipLaunchKernelGGL(mega_fwd, dim3(grid), dim3(NWAVES * 64), LDS_BYTES, stream, a); }
#else
    a.ph_lo = 0; a.ph_hi = N_PHASES; a.li = 0; a.pad = 0;
    hipLaunchKernelGGL(mega_fwd, dim3(grid), dim3(NWAVES * 64), LDS_BYTES, stream, a);
#endif
}
```

```cpp
#include <hip/hip_runtime.h>
#include <cstdio>
#include <cstdint>

#ifndef MK_PER_PHASE
#define MK_PER_PHASE 0
#endif

namespace pg8 {
#define PG8_LAS __attribute__((address_space(3)))
typedef unsigned short bf16_t;
typedef short bf16x8 __attribute__((ext_vector_type(8)));
typedef float f32x4 __attribute__((ext_vector_type(4)));
typedef float f32x2 __attribute__((ext_vector_type(2)));
typedef unsigned u32x4 __attribute__((ext_vector_type(4)));
typedef unsigned u32x2 __attribute__((ext_vector_type(2)));
constexpr int BM = 256, BK = 64, HALF = 128, HTB = HALF * BK * 2, STAGE_BYTES = 8 * HTB, NXCD = 8, WGM = 8, KD = 1024;

__host__ __device__ __forceinline__ int lds_byte(int r, int c) { const int st = (r >> 4) * 2 + (c >> 5), rr = r & 15, cc = c & 31, ob = rr * 64 + cc * 2; return st * 1024 + (ob ^ (((ob >> 9) & 1) << 5)); }
__host__ __device__ __forceinline__ void stage_rc(int b, int& R, int& C) { const int st = b / 1024, sb = b % 1024, swz = sb ^ (((sb >> 9) & 1) << 5); R = (st >> 1) * 16 + swz / 64; C = (st & 1) * 32 + (swz % 64) / 2; }
__host__ __device__ __forceinline__ int perm32(int rho) { const int n = rho >> 4, i = rho & 15; return 8 * (i >> 2) + 4 * n + (i & 3); }

struct Unit { int pm, pn, e; };

struct PlainOrder {
    static constexpr bool GATHER = false;
    const bf16_t* A; const bf16_t* Bt; int nM, nN, nwg, G, c;
    __device__ void init(const bf16_t* A_, const bf16_t* Bt_, int M, int N, int G_, int c_) { A = A_; Bt = Bt_; nM = M / BM; nN = N / BM; nwg = nM * nN; G = G_; c = c_; }
    __device__ __forceinline__ bool next(int i, Unit& u) const {
        const long L = (long)i * G + c; if (L >= nwg) return false;
        int wgid = (int)L; { const int q = nwg / NXCD, r = nwg % NXCD, xcd = wgid % NXCD, off = wgid / NXCD; wgid = (xcd < r ? xcd * (q + 1) : r * (q + 1) + (xcd - r) * q) + off; }
        const int nig = WGM * nN, gid = wgid / nig, fm = gid * WGM, gsz = (nM - fm) < WGM ? (nM - fm) : WGM;
        u.pm = fm + ((wgid % nig) % gsz); u.pn = (wgid % nig) / gsz; u.e = 0; return true;
    }
    __device__ __forceinline__ const char* a_base(const Unit& u) const { return (const char*)A + (size_t)u.pm * ((size_t)BM * KD * 2); }
    __device__ __forceinline__ const char* b_base(const Unit& u) const { return (const char*)Bt + (size_t)u.pn * ((size_t)BM * KD * 2); }
    __device__ __forceinline__ void load_rows(const Unit&, unsigned (&)[2][2]) const {}
};
template <bool GATHER_> struct MoeOrder {
    static constexpr bool GATHER = GATHER_;
    const bf16_t* A; const bf16_t* Bt; const int* tile_exp; const int* slot_tok; int tile0, ntile, nN, G, c;
    __device__ __forceinline__ bool next(int i, Unit& u) const {
        const long L = (long)i * G + c; if (L >= (long)ntile * nN) return false;
        const int pl = (int)(L / nN); u.pn = (int)(L % nN); u.pm = tile0 + pl; u.e = tile_exp[u.pm]; return true;
    }
    __device__ __forceinline__ const char* a_base(const Unit& u) const { return GATHER ? (const char*)A : (const char*)A + (size_t)(u.pm - tile0) * ((size_t)BM * KD * 2); }
    __device__ __forceinline__ const char* b_base(const Unit& u) const { return (const char*)Bt + ((size_t)u.e * nN + u.pn) * ((size_t)BM * KD * 2); }
    __device__ __forceinline__ void load_rows(const Unit& u, unsigned (&out)[2][2]) const {
#pragma unroll
        for (int i = 0; i < 2; ++i) { int R, C; stage_rc((int)threadIdx.x * 16 + i * 8192, R, C);
#pragma unroll
            for (int h = 0; h < 2; ++h) out[h][i] = (unsigned)slot_tok[u.pm * BM + h * HALF + R] * (unsigned)(KD * 2) + (unsigned)C * 2u; }
    }
};

__device__ __forceinline__ unsigned cvt_pk_bf16(float lo, float hi) { unsigned r; asm volatile("v_cvt_pk_bf16_f32 %0, %1, %2" : "=v"(r) : "v"(lo), "v"(hi)); return r; }
__device__ __forceinline__ float bf_lo(unsigned w) { return __uint_as_float(w << 16); }
__device__ __forceinline__ float bf_hi(unsigned w) { return __uint_as_float(w & 0xffff0000u); }

template <class Epi, class Sched, bool ALIGN_EPI>
__device__ __forceinline__ void gemm_phase(PG8_LAS unsigned char* lds, const Sched& S, const Epi& E) {
    const int tid = threadIdx.x, wid = __builtin_amdgcn_readfirstlane(tid >> 6), lane = tid & 63, wr = wid >> 2, wc = wid & 3, fr = lane & 15, fq = lane >> 4;
    constexpr int K = KD, nt = K / BK;
    unsigned voffA[2], voffB[2];
#pragma unroll
    for (int i = 0; i < 2; ++i) { int R, C; stage_rc(tid * 16 + i * 8192, R, C); const int Rb = Epi::PERM ? ((R & ~31) + perm32(R & 31)) : R;
        voffA[i] = (unsigned)(R * K + C) * 2u; voffB[i] = (unsigned)(Rb * K + C) * 2u; }
    constexpr size_t kstep = (size_t)(BK * 2);
    constexpr size_t hstep = (size_t)HALF * K * 2;
    const unsigned ldsw = (unsigned)wid * 1024u;
    const int aoff = lds_byte(wr * 64 + fr, fq * 8), boff = lds_byte(wc * 32 + fr, fq * 8);
#define PG8_SA(b, h) (((b) * 2 + (h)) * HTB)
#define PG8_SB(b, h) ((4 + (b) * 2 + (h)) * HTB)
#define PG8_STAGE(bufoff, gbase, voff) do { _Pragma("unroll") for (int _i = 0; _i < 2; ++_i) \
        __builtin_amdgcn_global_load_lds((const unsigned*)((const char*)(gbase) + (voff)[_i]), (PG8_LAS unsigned*)(lds + (bufoff) + ldsw + _i * 8192), 16, 0, 0); } while (0)
#define PG8_STAGE_B(b, h, base) PG8_STAGE(PG8_SB(b, h), (base) + (h) * hstep, voffB)
#define PG8_STAGE_A(b, h, base, GO) do { if constexpr (Sched::GATHER) { PG8_STAGE(PG8_SA(b, h), (base), GO[h]); } else { PG8_STAGE(PG8_SA(b, h), (base) + (h) * hstep, voffA); } } while (0)
#define PG8_LDA(dst, b, h) do { _Pragma("unroll") for (int m = 0; m < 4; ++m) _Pragma("unroll") for (int k = 0; k < 2; ++k) dst[m][k] = *(const PG8_LAS bf16x8*)(lds + PG8_SA(b, h) + aoff + m * 2048 + k * 1024); } while (0)
#define PG8_LDB(dst, b, h) do { _Pragma("unroll") for (int n = 0; n < 2; ++n) _Pragma("unroll") for (int k = 0; k < 2; ++k) dst[n][k] = *(const PG8_LAS bf16x8*)(lds + PG8_SB(b, h) + boff + n * 2048 + k * 1024); } while (0)
#define PG8_MMA(ai, bj, At, Bt) do { __builtin_amdgcn_s_setprio(1); _Pragma("unroll") for (int m = 0; m < 4; ++m) _Pragma("unroll") for (int n = 0; n < 2; ++n) _Pragma("unroll") for (int k = 0; k < 2; ++k) \
        acc[ai][bj][m][n] = __builtin_amdgcn_mfma_f32_16x16x32_bf16(Bt[n][k], At[m][k], acc[ai][bj][m][n], 0, 0, 0); __builtin_amdgcn_s_setprio(0); } while (0)
#define PG8_WAIT_V(n) asm volatile("s_waitcnt vmcnt(" #n ")" ::: "memory")
#define PG8_WAIT_L(n) asm volatile("s_waitcnt lgkmcnt(" #n ")" ::: "memory")
#define PG8_BAR __builtin_amdgcn_s_barrier()
#define PG8_SCHED __builtin_amdgcn_sched_barrier(0)
    Unit cur, nxt; int ui = 0;
    if (!S.next(0, cur)) return;
    f32x4 acc[2][2][4][2];
#pragma unroll
    for (int a = 0; a < 2; ++a)
#pragma unroll
        for (int b = 0; b < 2; ++b)
#pragma unroll
            for (int m = 0; m < 4; ++m)
#pragma unroll
                for (int n = 0; n < 2; ++n) acc[a][b][m][n] = (f32x4){0.f, 0.f, 0.f, 0.f};
    bf16x8 At[4][2], B0[2][2], B1[2][2];
    unsigned gA[2][2] = {{0u, 0u}, {0u, 0u}};
    const char* cA = S.a_base(cur); const char* cB = S.b_base(cur);
    if constexpr (Sched::GATHER) S.load_rows(cur, gA);
    PG8_STAGE_B(0, 0, cB); PG8_STAGE_B(0, 1, cB); PG8_STAGE_A(0, 0, cA, gA); PG8_STAGE_A(0, 1, cA, gA);
    if (wr == 1) PG8_BAR;
    PG8_WAIT_V(2); PG8_BAR;
    PG8_STAGE_B(1, 0, cB + kstep); PG8_STAGE_A(1, 0, cA + kstep, gA); PG8_STAGE_B(1, 1, cB + kstep);
    PG8_WAIT_V(6); PG8_BAR;
    for (;;) {
        const bool has_next = S.next(ui + 1, nxt);
        const char* nA = has_next ? S.a_base(nxt) : cA; const char* nB = has_next ? S.b_base(nxt) : cB;
        for (int t = 0; t < nt; t += 2) {
            const bool last = (t == nt - 2);
            const char* a1 = cA + (size_t)(t + 1) * kstep;
            const char* a2 = last ? nA : cA + (size_t)(t + 2) * kstep; const char* b2 = last ? nB : cB + (size_t)(t + 2) * kstep;
            const char* a3 = a2 + kstep; const char* b3 = b2 + kstep;
            PG8_LDB(B0, 0, 0); PG8_LDB(B1, 0, 1); PG8_SCHED; PG8_LDA(At, 0, 0); PG8_STAGE_A(1, 1, a1, gA);
            if constexpr (Sched::GATHER) { if (last && has_next) S.load_rows(nxt, gA); }
            PG8_WAIT_V(8); PG8_WAIT_L(0); PG8_BAR; PG8_MMA(0, 0, At, B0); PG8_MMA(0, 1, At, B1); PG8_BAR; PG8_SCHED;
            PG8_LDA(At, 0, 1); PG8_STAGE_B(0, 0, b2); PG8_STAGE_B(0, 1, b2); PG8_STAGE_A(0, 0, a2, gA);
            PG8_WAIT_V(8); PG8_WAIT_L(0); PG8_BAR; PG8_MMA(1, 0, At, B0); PG8_MMA(1, 1, At, B1); PG8_BAR; PG8_SCHED;
            PG8_LDB(B0, 1, 0); PG8_LDB(B1, 1, 1); PG8_SCHED; PG8_LDA(At, 1, 0); PG8_STAGE_A(0, 1, a2, gA);
            PG8_WAIT_V(8); PG8_WAIT_L(0); PG8_BAR; PG8_MMA(0, 0, At, B0); PG8_MMA(0, 1, At, B1); PG8_BAR; PG8_SCHED;
            PG8_LDA(At, 1, 1); PG8_STAGE_B(1, 0, b3); PG8_STAGE_B(1, 1, b3); PG8_STAGE_A(1, 0, a3, gA);
            PG8_WAIT_V(8); PG8_WAIT_L(0); PG8_BAR; PG8_MMA(1, 0, At, B0); PG8_MMA(1, 1, At, B1); PG8_BAR; PG8_SCHED;
        }
        if constexpr (ALIGN_EPI) { if (wr == 0) PG8_BAR; }
        E(acc, cur, wr, wc, fr, fq);
        if (!has_next) break;
#pragma unroll
        for (int a = 0; a < 2; ++a)
#pragma unroll
            for (int b = 0; b < 2; ++b)
#pragma unroll
                for (int m = 0; m < 4; ++m)
#pragma unroll
                    for (int n = 0; n < 2; ++n) acc[a][b][m][n] = (f32x4){0.f, 0.f, 0.f, 0.f};
        cur = nxt; cA = nA; cB = nB; ++ui;
        if constexpr (ALIGN_EPI) { if (wr == 1) PG8_BAR; }
    }
    PG8_WAIT_V(0);
    if constexpr (!ALIGN_EPI) { if (wr == 0) PG8_BAR; }
    PG8_BAR;
#undef PG8_SA
#undef PG8_SB
#undef PG8_STAGE
#undef PG8_STAGE_A
#undef PG8_STAGE_B
#undef PG8_LDA
#undef PG8_LDB
#undef PG8_MMA
#undef PG8_WAIT_V
#undef PG8_WAIT_L
#undef PG8_BAR
#undef PG8_SCHED
}
}

constexpr int NWAVES = 8;
constexpr int BATCH = 16, SEQ = 4096, D = 1024, NTOK = BATCH * SEQ, DIN = 6144, NE = 32, TOPK = 4;
constexpr int CAPROWS = NTOK * TOPK + NE * 256, NTILE_MAX = CAPROWS / 256;
constexpr int TILES_A = 512, TILES_B_MAX = NTILE_MAX - TILES_A;
constexpr float EPS = 1e-6f;
constexpr int N_PHASES = 14;

constexpr size_t MiB = 1u << 20;
constexpr size_t WS_CTL = 0, CTL_ZERO_BYTES = 1 * MiB;
constexpr size_t WS_MOD = 1 * MiB;
constexpr size_t WS_WIN = 2 * MiB;
constexpr size_t WS_WBRR = 14 * MiB, WS_WBRS = 16 * MiB, WS_WOUT = 18 * MiB;
constexpr size_t WS_SGW = 20 * MiB;
constexpr size_t WS_TOPI = 21 * MiB, WS_TOPW = 22 * MiB, WS_TSLOT = 23 * MiB;
constexpr size_t WS_SLOTTOK = 24 * MiB;
constexpr size_t WS_SLOTW = 26 * MiB;
constexpr size_t WS_BLKCNT = 28 * MiB;
constexpr size_t WS_TILEEXP = 28 * MiB + 65536;
constexpr size_t WS_H = 32 * MiB;
constexpr size_t WS_Z = 160 * MiB;
constexpr size_t ZREG = (size_t)NTOK * D * 2;
constexpr size_t WS_WGU = 160 * MiB;
constexpr size_t WS_YHI = 32 * MiB;
constexpr size_t WS_WDN = 304 * MiB;
constexpr size_t WS_ACT = 368 * MiB;
constexpr size_t WS_YLO = 640 * MiB;
constexpr size_t WS_END = 896 * MiB;
static_assert(WS_Z + 6 * ZREG <= 1024 * MiB, "z fits");
static_assert(WS_YHI + (size_t)TILES_B_MAX * 256 * D * 2 <= WS_WDN && WS_WDN + (size_t)NE * D * D * 2 <= WS_ACT && WS_ACT + (size_t)TILES_B_MAX * 256 * D * 2 <= WS_YLO && WS_YLO + (size_t)TILES_A * 256 * D * 2 <= WS_END, "moe map");
constexpr int CW_TMO = 0;
constexpr int CW_BAR = 4096;

constexpr int RING_BYTES = 131072;
constexpr int MISC_OFF = RING_BYTES + 320;
constexpr int AUX_OFF = RING_BYTES + 1024;
constexpr int LDS_BYTES = 163840;

#define GAS __attribute__((address_space(1)))
#define LAS __attribute__((address_space(3)))
typedef unsigned short bf16;
typedef unsigned v4u __attribute__((ext_vector_type(4)));
typedef unsigned v2u __attribute__((ext_vector_type(2)));
typedef float f32x4 __attribute__((ext_vector_type(4)));
typedef GAS unsigned gu32;
#define RLX_AGENT __ATOMIC_RELAXED, __HIP_MEMORY_SCOPE_AGENT
#define LDS_WAIT() asm volatile("s_waitcnt lgkmcnt(0)" ::: "memory")
#define VM_WAIT() asm volatile("s_waitcnt vmcnt(0)" ::: "memory")
__device__ __forceinline__ unsigned f2bf(float f) { unsigned u = __builtin_bit_cast(unsigned, f); return (u + 0x7fffu + ((u >> 16) & 1u)) >> 16; }
__device__ __forceinline__ unsigned pk2(float lo, float hi) { return f2bf(lo) | (f2bf(hi) << 16); }
__device__ __forceinline__ float bf2f(bf16 b) { return __uint_as_float(((unsigned)b) << 16); }

#define XB_TMO      128
#define XB_XCNT(j)  (256  + 64 * (j))
#define XB_XSUB(j)  (1280 + 64 * (j))
#define XB_XGEN(j)  (2304 + 64 * (j))
#define XB_TOP      3328
#define XB_TOPGEN   3392
#define XCD_BAR_WORDS 3456
#define XB_SPIN_CAP (1u << 18)
__device__ __forceinline__ unsigned xb_ld(unsigned* p)              { return __hip_atomic_load(p, __ATOMIC_RELAXED, __HIP_MEMORY_SCOPE_AGENT); }
__device__ __forceinline__ unsigned xb_add(unsigned* p, unsigned v) { return __hip_atomic_fetch_add(p, v, __ATOMIC_RELAXED, __HIP_MEMORY_SCOPE_AGENT); }
__device__ __forceinline__ unsigned xb_xcc_id() { return (unsigned)__builtin_amdgcn_s_getreg((3 << 11) | 20) & 0xFu; }
#define XB_SPIN(cond, bar) do { unsigned _sp = 0; while (cond) { __builtin_amdgcn_s_sleep(1); \
    if ((++_sp & 255u) == 0u) { if (xb_ld(&(bar)[XB_TMO])) break; if (_sp > XB_SPIN_CAP) { atomicAdd(&(bar)[XB_TMO], 1u); break; } } } } while (0)
struct XcdBarrier { unsigned* bar; unsigned x; volatile LAS unsigned* st; };
__device__ __forceinline__ XcdBarrier xcd_barrier_post(unsigned* bar, volatile LAS unsigned* st) {
    XcdBarrier b; b.bar = bar; b.x = xb_xcc_id(); b.st = st;
    if (threadIdx.x == 0) (void)xb_add(&bar[XB_XCNT(b.x)], 1u);
    return b;
}
__device__ __forceinline__ void xcd_barrier_complete(unsigned* bar, unsigned x, unsigned& nloc, unsigned& nx) {
    const unsigned G = gridDim.x * gridDim.y * gridDim.z;
    unsigned sum, cnt, mine, sp = 0u;
    for (;;) {
        sum = 0u; cnt = 0u; mine = 0u;
#pragma unroll
        for (unsigned j = 0; j < 16; ++j) { const unsigned c = xb_ld(&bar[XB_XCNT(j)]); sum += c; cnt += (c > 0u) ? 1u : 0u; mine = (j == x) ? c : mine; }
        if (sum == G) break;
        __builtin_amdgcn_s_sleep(1);
        if ((++sp & 255u) == 0u) { if (xb_ld(&bar[XB_TMO])) break; if (sp > XB_SPIN_CAP) { atomicAdd(&bar[XB_TMO], 1u); break; } }
    }
    nloc = mine > 0u ? mine : 1u; nx = cnt > 0u ? cnt : 1u;
}
__device__ __forceinline__ void xcd_barrier(const XcdBarrier& b) {
    asm volatile("s_waitcnt vmcnt(0)" ::: "memory");
    __syncthreads();
    if (threadIdx.x == 0) {
        unsigned* bar = b.bar;
        __builtin_amdgcn_s_waitcnt(0);
        unsigned nloc = b.st[0], nx = b.st[1];
        if (nloc == 0u) { xcd_barrier_complete(bar, b.x, nloc, nx); b.st[0] = nloc; b.st[1] = nx; }
        const unsigned old = xb_add(&bar[XB_XSUB(b.x)], 1u);
        const unsigned gen = old / nloc;
        if (old + 1u == (gen + 1u) * nloc) {
            __builtin_amdgcn_fence(__ATOMIC_RELEASE, "agent");
            asm volatile("s_waitcnt vmcnt(0)" ::: "memory");
            const unsigned og = xb_add(&bar[XB_TOP], 1u);
            const unsigned tg = og / nx;
            if (og + 1u == (tg + 1u) * nx) xb_add(&bar[XB_TOPGEN], 1u);
            else XB_SPIN(xb_ld(&bar[XB_TOPGEN]) == tg, bar);
            __builtin_amdgcn_fence(__ATOMIC_ACQUIRE, "agent");
            xb_add(&bar[XB_XGEN(b.x)], 1u);
            asm volatile("s_waitcnt vmcnt(0)" ::: "memory");
        } else {
            XB_SPIN(xb_ld(&bar[XB_XGEN(b.x)]) == gen, bar);
            __builtin_amdgcn_fence(__ATOMIC_ACQUIRE, "agent");
            asm volatile("s_waitcnt vmcnt(0)" ::: "memory");
        }
    }
    __syncthreads();
}

__device__ __forceinline__ float wave_sum(float v) {
#pragma unroll
    for (int o = 1; o < 64; o <<= 1) v += __shfl_xor(v, o);
    return v;
}
__device__ __forceinline__ float fast_sigmoid(float x) { return __builtin_amdgcn_rcpf(1.0f + __builtin_amdgcn_exp2f(-1.4426950409f * x)); }
__device__ __forceinline__ float gelu_tanh(float x) { const float a = x * (1.5957691216f + 0.0713548163f * x * x); return x * fast_sigmoid(a); }

struct EpiZ {
    static constexpr bool PERM = true;
    bf16* Z;
    __device__ __forceinline__ void operator()(const pg8::f32x4 (&acc)[2][2][4][2], const pg8::Unit& u, int wr, int wc, int fr, int fq) const {
        const int region = u.pn >> 2; const int row0 = u.pm * 256 + wr * 64 + fr, col0 = (u.pn & 3) * 256 + wc * 32 + 8 * fq;
        bf16* base = Z + (size_t)region * ((size_t)NTOK * D);
        const bool isg = (region >= 1 && region <= 3), iss = (region >= 4);
#pragma unroll
        for (int ai = 0; ai < 2; ++ai)
#pragma unroll
            for (int m = 0; m < 4; ++m) { bf16* rowp = base + (size_t)(row0 + ai * 128 + m * 16) * D + col0;
#pragma unroll
                for (int bj = 0; bj < 2; ++bj) { float v[8];
#pragma unroll
                    for (int j = 0; j < 4; ++j) { v[j] = acc[ai][bj][m][0][j]; v[4 + j] = acc[ai][bj][m][1][j]; }
#pragma unroll
                    for (int j = 0; j < 8; ++j) { const float x = v[j]; const float a = isg ? x * (1.5957691216f + 0.0713548163f * x * x) : x; const float s = fast_sigmoid(a);
                        v[j] = isg ? x * s : (iss ? s : x); }
                    pg8::u32x4 w; w.x = pg8::cvt_pk_bf16(v[0], v[1]); w.y = pg8::cvt_pk_bf16(v[2], v[3]); w.z = pg8::cvt_pk_bf16(v[4], v[5]); w.w = pg8::cvt_pk_bf16(v[6], v[7]);
                    *(pg8::u32x4*)(rowp + bj * 128) = w; } }
    }
};
struct EpiMerge {
    static constexpr bool PERM = true;
    const bf16* gate; const bf16* addend; bf16* out;
    __device__ __forceinline__ void operator()(const pg8::f32x4 (&acc)[2][2][4][2], const pg8::Unit& u, int wr, int wc, int fr, int fq) const {
        const int row0 = u.pm * 256 + wr * 64 + fr, col0 = u.pn * 256 + wc * 32 + 8 * fq;
#pragma unroll
        for (int ai = 0; ai < 2; ++ai)
#pragma unroll
            for (int m = 0; m < 4; ++m) { const size_t off = (size_t)(row0 + ai * 128 + m * 16) * D + col0;
#pragma unroll
                for (int bj = 0; bj < 2; ++bj) {
                    const pg8::u32x4 g = *(const pg8::u32x4*)(gate + off + bj * 128);
                    pg8::u32x4 ad = (pg8::u32x4){0u, 0u, 0u, 0u}; if (addend) ad = *(const pg8::u32x4*)(addend + off + bj * 128);
                    const pg8::f32x4 a0 = acc[ai][bj][m][0], a1 = acc[ai][bj][m][1];
                    pg8::u32x4 w;
                    w.x = pg8::cvt_pk_bf16(pg8::bf_lo(ad.x) + pg8::bf_lo(g.x) * a0[0], pg8::bf_hi(ad.x) + pg8::bf_hi(g.x) * a0[1]);
                    w.y = pg8::cvt_pk_bf16(pg8::bf_lo(ad.y) + pg8::bf_lo(g.y) * a0[2], pg8::bf_hi(ad.y) + pg8::bf_hi(g.y) * a0[3]);
                    w.z = pg8::cvt_pk_bf16(pg8::bf_lo(ad.z) + pg8::bf_lo(g.z) * a1[0], pg8::bf_hi(ad.z) + pg8::bf_hi(g.z) * a1[1]);
                    w.w = pg8::cvt_pk_bf16(pg8::bf_lo(ad.w) + pg8::bf_lo(g.w) * a1[2], pg8::bf_hi(ad.w) + pg8::bf_hi(g.w) * a1[3]);
                    *(pg8::u32x4*)(out + off + bj * 128) = w; } }
    }
};
struct EpiResid {
    static constexpr bool PERM = false;
    const float* x; const float* gt; float* out;
    __device__ __forceinline__ void operator()(const pg8::f32x4 (&acc)[2][2][4][2], const pg8::Unit& u, int wr, int wc, int fr, int fq) const {
        const int row0 = u.pm * 256 + wr * 64 + fr, col0 = u.pn * 256 + wc * 32 + 4 * fq; const int b = u.pm >> 4;
        pg8::f32x4 gv[2][2];
#pragma unroll
        for (int bj = 0; bj < 2; ++bj)
#pragma unroll
            for (int n = 0; n < 2; ++n) gv[bj][n] = *(const pg8::f32x4*)(gt + (size_t)b * DIN + col0 + bj * 128 + n * 16);
#pragma unroll
        for (int ai = 0; ai < 2; ++ai)
#pragma unroll
            for (int m = 0; m < 4; ++m) { const size_t off = (size_t)(row0 + ai * 128 + m * 16) * D + col0;
#pragma unroll
                for (int bj = 0; bj < 2; ++bj)
#pragma unroll
                    for (int n = 0; n < 2; ++n) { const pg8::f32x4 xv = *(const pg8::f32x4*)(x + off + bj * 128 + n * 16);
                        *(pg8::f32x4*)(out + off + bj * 128 + n * 16) = xv + gv[bj][n] * acc[ai][bj][m][n]; } }
    }
};
struct EpiGu {
    static constexpr bool PERM = true;
    bf16* act; const float* bgu; int tile0;
    __device__ __forceinline__ void operator()(const pg8::f32x4 (&acc)[2][2][4][2], const pg8::Unit& u, int wr, int wc, int fr, int fq) const {
        const int row0 = (u.pm - tile0) * 256 + wr * 64 + fr, cc = u.pn * 128 + wc * 32 + 8 * fq;
        const float* bg = bgu + (size_t)u.e * 2048 + cc;
        const pg8::f32x4 bg0 = *(const pg8::f32x4*)(bg), bg1 = *(const pg8::f32x4*)(bg + 4), bu0 = *(const pg8::f32x4*)(bg + 1024), bu1 = *(const pg8::f32x4*)(bg + 1028);
#pragma unroll
        for (int ai = 0; ai < 2; ++ai)
#pragma unroll
            for (int m = 0; m < 4; ++m) { float o[8];
#pragma unroll
                for (int j = 0; j < 8; ++j) {
                    float g = (j < 4 ? acc[ai][0][m][0][j & 3] + bg0[j & 3] : acc[ai][0][m][1][j & 3] + bg1[j & 3]);
                    float up = (j < 4 ? acc[ai][1][m][0][j & 3] + bu0[j & 3] : acc[ai][1][m][1][j & 3] + bu1[j & 3]);
                    g = fminf(g, 7.0f); up = fminf(fmaxf(up, -7.0f), 7.0f);
                    o[j] = (up + 1.0f) * (g * fast_sigmoid(1.702f * g)); }
                pg8::u32x4 w; w.x = pg8::cvt_pk_bf16(o[0], o[1]); w.y = pg8::cvt_pk_bf16(o[2], o[3]); w.z = pg8::cvt_pk_bf16(o[4], o[5]); w.w = pg8::cvt_pk_bf16(o[6], o[7]);
                *(pg8::u32x4*)(act + (size_t)(row0 + ai * 128 + m * 16) * D + cc) = w; }
    }
};
struct EpiDown {
    static constexpr bool PERM = true;
    bf16* y; const float* bd; const float* slot_w; int tile0;
    __device__ __forceinline__ void operator()(const pg8::f32x4 (&acc)[2][2][4][2], const pg8::Unit& u, int wr, int wc, int fr, int fq) const {
        const int rl0 = (u.pm - tile0) * 256 + wr * 64 + fr, rg0 = u.pm * 256 + wr * 64 + fr, col0 = u.pn * 256 + wc * 32 + 8 * fq;
        const float* bp = bd + (size_t)u.e * D + col0;
        pg8::f32x4 bv[2][2];
#pragma unroll
        for (int bj = 0; bj < 2; ++bj) { bv[bj][0] = *(const pg8::f32x4*)(bp + bj * 128); bv[bj][1] = *(const pg8::f32x4*)(bp + bj * 128 + 4); }
#pragma unroll
        for (int ai = 0; ai < 2; ++ai)
#pragma unroll
            for (int m = 0; m < 4; ++m) { const float sw = slot_w[rg0 + ai * 128 + m * 16]; bf16* rowp = y + (size_t)(rl0 + ai * 128 + m * 16) * D + col0;
#pragma unroll
                for (int bj = 0; bj < 2; ++bj) { const pg8::f32x4 v0 = (acc[ai][bj][m][0] + bv[bj][0]) * sw, v1 = (acc[ai][bj][m][1] + bv[bj][1]) * sw;
                    pg8::u32x4 w; w.x = pg8::cvt_pk_bf16(v0[0], v0[1]); w.y = pg8::cvt_pk_bf16(v0[2], v0[3]); w.z = pg8::cvt_pk_bf16(v1[0], v1[1]); w.w = pg8::cvt_pk_bf16(v1[2], v1[3]);
                    *(pg8::u32x4*)(rowp + bj * 128) = w; } }
    }
};

__device__ __forceinline__ void transpose_item(const float* W, int ldn, int K, int k0, int n0, bf16* WT, int drow0, LAS float* scr, int lane) {
#pragma unroll 8
    for (int i = 0; i < 32; ++i) { const int kk = 2 * i + (lane >> 5); scr[kk * 33 + (lane & 31)] = W[(size_t)(k0 + kk) * ldn + n0 + (lane & 31)]; }
    LDS_WAIT(); asm volatile("" ::: "memory");
    const int c = lane & 7;
#pragma unroll
    for (int j = 0; j < 4; ++j) { const int n = (lane >> 3) + 8 * j; const LAS float* s = scr + (8 * c) * 33 + n;
        v4u o; o.x = pk2(s[0 * 33], s[1 * 33]); o.y = pk2(s[2 * 33], s[3 * 33]); o.z = pk2(s[4 * 33], s[5 * 33]); o.w = pk2(s[6 * 33], s[7 * 33]);
        *(GAS v4u*)(WT + (size_t)(drow0 + n) * K + k0 + 8 * c) = o; }
    LDS_WAIT(); asm volatile("" ::: "memory");
}

struct Args {
    const float* in[28]; float* out; unsigned char* ws; int ph_lo, ph_hi, li, pad;
};
enum { I_X = 0, I_C, I_ADAW, I_ADAB, I_N1G, I_WIN, I_CONVW, I_CONVB, I_LWA, I_LBA, I_LWX, I_LBX, I_LAM, I_SGLNG, I_SGLNB, I_SGWS, I_SGBS, I_WBRR, I_WBRS, I_WOUT, I_N2G, I_WR, I_BR, I_WGU, I_BGU, I_WDN, I_BDN, I_FG };

__global__ void __launch_bounds__(NWAVES * 64, 2) mega_fwd(Args args) {
    extern __shared__ __attribute__((aligned(16))) unsigned char lds_raw[];
    LAS unsigned char* lds = (LAS unsigned char*)lds_raw;
    volatile LAS unsigned* MISC = (volatile LAS unsigned*)(lds + MISC_OFF);
    const int tid = threadIdx.x, lane = tid & 63, wave = __builtin_amdgcn_readfirstlane(tid >> 6);
    const int G = gridDim.x; const int bx = blockIdx.x;
    const int vcu = (G % 8 == 0) ? (bx % 8) * (G / 8) + bx / 8 : bx;
    unsigned char* ws = args.ws;
    gu32* ctl = (gu32*)(ws + WS_CTL);
    for (int u = tid; u < (LDS_BYTES - RING_BYTES) / 4; u += NWAVES * 64) ((LAS unsigned*)(lds + RING_BYTES))[u] = 0u;
    __syncthreads();
#if MK_PER_PHASE
    XcdBarrier bar; bar.bar = (unsigned*)(ctl + CW_BAR); bar.x = 0; bar.st = nullptr;
#define GRID_BAR() do { if (tid == 0) __hip_atomic_store(ctl + CW_TMO, 0xBADBA0u, RLX_AGENT); } while (0)
#else
    XcdBarrier bar = xcd_barrier_post((unsigned*)(ctl + CW_BAR), MISC + 8);
#define GRID_BAR() xcd_barrier(bar)
#endif
    const int lo = args.ph_lo, hi = args.ph_hi;
#define IN(k) (lo <= (k) && (k) < hi)
#define BOTH(k) (IN(k) && IN((k) + 1))

    const float* x_in = args.in[I_X];
    float* modv = (float*)(ws + WS_MOD);
    bf16* Hb = (bf16*)(ws + WS_H);
    bf16* Zb = (bf16*)(ws + WS_Z);
    bf16* Z0 = Zb, *Z1 = Zb + (size_t)NTOK * D, *Z2 = Zb + 2 * (size_t)NTOK * D, *Z3 = Zb + 3 * (size_t)NTOK * D, *Z4 = Zb + 4 * (size_t)NTOK * D, *Z5 = Zb + 5 * (size_t)NTOK * D;
    int* top_idx = (int*)(ws + WS_TOPI); float* top_w = (float*)(ws + WS_TOPW); int* tok_slot = (int*)(ws + WS_TSLOT);
    int* slot_tok = (int*)(ws + WS_SLOTTOK); float* slot_w = (float*)(ws + WS_SLOTW); int* blkcnt = (int*)(ws + WS_BLKCNT); int* tile_exp = (int*)(ws + WS_TILEEXP);
    const int gw = vcu * NWAVES + wave, NGW = G * NWAVES;

    if (IN(0)) {
        if (bx < 96) {
            LAS float* sc = (LAS float*)lds;
            LAS float* part = (LAS float*)(lds + 65536);
            const float* cin = args.in[I_C];
            for (int q = 0; q < 32; ++q) { const int idx = tid + 512 * q, k = idx >> 4, b = idx & 15; const float v = cin[b * D + k]; sc[idx] = v * fast_sigmoid(v); }
            __syncthreads();
            for (int task = bx; task < 96; task += G) {
                const int j0 = task * 64; const float* aw = args.in[I_ADAW];
                float a16[16];
#pragma unroll
                for (int b = 0; b < 16; ++b) a16[b] = 0.f;
                for (int kk = 0; kk < 128; ++kk) { const int k = wave * 128 + kk; const float wv = aw[(size_t)k * DIN + j0 + lane];
#pragma unroll
                    for (int b4 = 0; b4 < 4; ++b4) { const f32x4 s4 = *(const LAS f32x4*)(sc + k * 16 + b4 * 4);
                        a16[b4 * 4 + 0] += s4[0] * wv; a16[b4 * 4 + 1] += s4[1] * wv; a16[b4 * 4 + 2] += s4[2] * wv; a16[b4 * 4 + 3] += s4[3] * wv; } }
#pragma unroll
                for (int b = 0; b < 16; ++b) part[(wave * 16 + b) * 64 + lane] = a16[b];
                __syncthreads();
                for (int q = 0; q < 2; ++q) { const int o = tid + 512 * q, b = o >> 6, col = o & 63; float s = args.in[I_ADAB][j0 + col];
#pragma unroll
                    for (int w = 0; w < 8; ++w) s += part[(w * 16 + b) * 64 + col];
                    modv[b * DIN + j0 + col] = s; }
                __syncthreads();
            }
        }
        __syncthreads();
        {
            LAS float* scr = (LAS float*)(lds + wave * 16384);
            constexpr int I_IN = 16 * (DIN / 32), I_SQ = 16 * (D / 32);
            for (int it = gw; it < I_IN + 3 * I_SQ; it += NGW) {
                int r = it;
                if (r < I_IN) { const int nblk = DIN / 32, kb = r / nblk, nb = r % nblk; transpose_item(args.in[I_WIN], DIN, D, 64 * kb, 32 * nb, (bf16*)(ws + WS_WIN), 32 * nb, scr, lane); continue; } r -= I_IN;
                const int which = r / I_SQ; r -= which * I_SQ; const int nblk = D / 32, kb = r / nblk, nb = r % nblk;
                const float* W = which == 0 ? args.in[I_WBRR] : (which == 1 ? args.in[I_WBRS] : args.in[I_WOUT]);
                bf16* WT = (bf16*)(ws + (which == 0 ? WS_WBRR : (which == 1 ? WS_WBRS : WS_WOUT)));
                transpose_item(W, D, D, 64 * kb, 32 * nb, WT, 32 * nb, scr, lane);
            }
        }
        { bf16* sgw = (bf16*)(ws + WS_SGW);
            for (int idx = gw * 64 + lane; idx < 8 * 128 * 128; idx += NGW * 64) { const int t = (idx >> 7) & 127, s2 = idx & 127; sgw[idx] = (bf16)(s2 <= t ? f2bf(args.in[I_SGWS][idx]) : 0u); } }
        if (BOTH(0)) GRID_BAR();
    }

    if (IN(1)) {
        for (int rb = gw; rb < NTOK / 32; rb += NGW) {
            const int b = (rb * 32) / SEQ;
            f32x4 A4[4], B4[4];
#pragma unroll
            for (int j = 0; j < 4; ++j) { const int c = 4 * lane + 256 * j; const f32x4 g = *(const f32x4*)(args.in[I_N1G] + c), s = *(const f32x4*)(modv + b * DIN + 1024 + c);
                A4[j] = g * (1.0f + s); B4[j] = *(const f32x4*)(modv + b * DIN + c); }
            for (int r = 0; r < 32; ++r) {
                const size_t m = (size_t)rb * 32 + r;
                const GAS f32x4* xr = (const GAS f32x4*)(x_in + m * D) + lane;
                f32x4 v[4]; float ss = 0.f;
#pragma unroll
                for (int j = 0; j < 4; ++j) { v[j] = xr[64 * j]; ss += (v[j].x * v[j].x + v[j].y * v[j].y) + (v[j].z * v[j].z + v[j].w * v[j].w); }
                const float rstd = 1.0f / sqrtf(wave_sum(ss) * (1.f / D) + EPS);
                GAS v2u* o8 = (GAS v2u*)(Hb + m * D) + lane;
#pragma unroll
                for (int j = 0; j < 4; ++j) { const f32x4 y = v[j] * rstd * A4[j] + B4[j]; v2u o; o.x = pk2(y.x, y.y); o.y = pk2(y.z, y.w); o8[64 * j] = o; }
            }
        }
        if (BOTH(1)) GRID_BAR();
    }

    if (IN(2)) {
        pg8::PlainOrder S; S.init(Hb, (const bf16*)(ws + WS_WIN), NTOK, DIN, G, bx);
        EpiZ E{Zb};
        pg8::gemm_phase<EpiZ, pg8::PlainOrder, true>(lds, S, E);
        if (BOTH(2)) GRID_BAR();
    }

    if (IN(3)) {
        typedef float f32x16 __attribute__((ext_vector_type(16)));
        for (int unit = bx; unit < BATCH * 16; unit += G) {
            const int b = unit >> 4, hd = unit & 15, ch0 = hd * 64;
            LAS unsigned char* xb0 = lds + wave * 10240;
            LAS unsigned char* gb = lds + 81920 + wave * 4096;
            LAS unsigned char* wfr = lds + 114688;
            LAS unsigned char* ifr = lds + AUX_OFF;
            LAS float* cwl = (LAS float*)(lds + AUX_OFF + 8192);
            typedef float f32x2l __attribute__((ext_vector_type(2)));
            LAS f32x2l* tot = (LAS f32x2l*)(lds + AUX_OFF + 8192 + 2048);
            __syncthreads();
            for (int q = 0; q < 2; ++q) { const int fid = tid + 512 * q; const int mat = fid >> 9, nt = (fid >> 8) & 1, ks = (fid >> 6) & 3, l = fid & 63, r = l & 31, h = l >> 5;
                const float* W = (mat ? args.in[I_LWX] : args.in[I_LWA]) + (size_t)hd * 4096 + (size_t)(16 * ks + 8 * h) * 64 + 32 * nt + r;
                v4u o; o.x = pk2(W[0], W[64]); o.y = pk2(W[128], W[192]); o.z = pk2(W[256], W[320]); o.w = pk2(W[384], W[448]);
                *(LAS v4u*)(wfr + fid * 16) = o; }
            { const int nt = tid >> 8, ks = (tid >> 6) & 3, l = tid & 63; const int pos = 32 * nt + (l & 31) - 16 * ks - 8 * (l >> 5);
                v4u o; o.x = (pos == 0 ? 0x3F80u : 0u) | (pos == 1 ? 0x3F800000u : 0u); o.y = (pos == 2 ? 0x3F80u : 0u) | (pos == 3 ? 0x3F800000u : 0u);
                o.z = (pos == 4 ? 0x3F80u : 0u) | (pos == 5 ? 0x3F800000u : 0u); o.w = (pos == 6 ? 0x3F80u : 0u) | (pos == 7 ? 0x3F800000u : 0u);
                *(LAS v4u*)(ifr + tid * 16) = o; }
            if (tid < 256) cwl[tid] = args.in[I_CONVW][(tid >> 6) * D + ch0 + (tid & 63)];
            else if (tid < 320) cwl[tid] = args.in[I_CONVB][ch0 + tid - 256];
            float cba[2], cbx[2], csp[2], carry[2];
#pragma unroll
            for (int nt = 0; nt < 2; ++nt) { const int c = ch0 + 32 * nt + (lane & 31); cba[nt] = args.in[I_LBA][c]; cbx[nt] = args.in[I_LBX][c];
                const float lm = args.in[I_LAM][c]; csp[nt] = 8.0f * log1pf(expf(-lm)) * 1.4426950409f; carry[nt] = 0.f; }
            __syncthreads();
            const int r31 = lane & 31, hh = lane >> 5;
            const int tokA = 16 * ((r31 >> 2) & 1) + 4 * (r31 >> 3) + (r31 & 3);
            const int dchunk = (lane & 7) ^ ((lane >> 3) & 7), drow = lane >> 3;
            const bf16* zx = Z0 + (size_t)b * SEQ * D + ch0 + 8 * dchunk;
            const bf16* zg = Z1 + (size_t)b * SEQ * D + ch0 + 8 * dchunk;
#define P3_DMA_X(Tw_, buf_) do { _Pragma("unroll") for (int n_ = 0; n_ < 5; ++n_) { int tk_ = (Tw_) - 8 + 8 * n_ + drow; tk_ = tk_ < 0 ? 0 : tk_; \
                __builtin_amdgcn_global_load_lds((const unsigned*)(zx + (size_t)tk_ * D), (LAS unsigned*)(xb0 + (buf_) * 5120 + n_ * 1024), 16, 0, 0); } } while (0)
#define P3_DMA_G(Tw_) do { _Pragma("unroll") for (int n_ = 0; n_ < 4; ++n_) { const int tk_ = (Tw_) + 8 * n_ + drow; \
                __builtin_amdgcn_global_load_lds((const unsigned*)(zg + (size_t)tk_ * D), (LAS unsigned*)(gb + n_ * 1024), 16, 0, 0); } } while (0)
            P3_DMA_X(wave * 32, 0);
            for (int st = 0; st < 16; ++st) {
                const int Tw = st * 256 + wave * 32, cur = st & 1;
                const int Tn = (st < 15) ? Tw + 256 : Tw;
                P3_DMA_G(Tw);
                P3_DMA_X(Tn, cur ^ 1);
                asm volatile("s_waitcnt vmcnt(9)" ::: "memory");
                LAS unsigned char* xb = xb0 + cur * 5120;
                if (Tw == 0) { if (lane < 24) *(LAS v4u*)(xb + (5 + (lane >> 3)) * 128 + (lane & 7) * 16) = (v4u){0u, 0u, 0u, 0u}; }
                asm volatile("s_waitcnt lgkmcnt(0)" ::: "memory");
                pg8::bf16x8 xa[4];
#pragma unroll
                for (int ks = 0; ks < 4; ++ks) {
                    const f32x4 b0 = *(const LAS f32x4*)(cwl + 256 + 16 * ks + 8 * hh), b1 = *(const LAS f32x4*)(cwl + 256 + 16 * ks + 8 * hh + 4);
                    float xv[8] = {b0[0], b0[1], b0[2], b0[3], b1[0], b1[1], b1[2], b1[3]};
#pragma unroll
                    for (int k = 0; k < 4; ++k) { const int rho = tokA + 5 + k; const int pos = (2 * ks + hh) ^ (rho & 7);
                        const v4u w = *(const LAS v4u*)(xb + rho * 128 + pos * 16);
                        const f32x4 c0 = *(const LAS f32x4*)(cwl + k * 64 + 16 * ks + 8 * hh), c1 = *(const LAS f32x4*)(cwl + k * 64 + 16 * ks + 8 * hh + 4);
                        xv[0] += c0[0] * pg8::bf_lo(w.x); xv[1] += c0[1] * pg8::bf_hi(w.x); xv[2] += c0[2] * pg8::bf_lo(w.y); xv[3] += c0[3] * pg8::bf_hi(w.y);
                        xv[4] += c1[0] * pg8::bf_lo(w.z); xv[5] += c1[1] * pg8::bf_hi(w.z); xv[6] += c1[2] * pg8::bf_lo(w.w); xv[7] += c1[3] * pg8::bf_hi(w.w); }
                    v4u p; p.x = pg8::cvt_pk_bf16(xv[0], xv[1]); p.y = pg8::cvt_pk_bf16(xv[2], xv[3]); p.z = pg8::cvt_pk_bf16(xv[4], xv[5]); p.w = pg8::cvt_pk_bf16(xv[6], xv[7]);
                    xa[ks] = __builtin_bit_cast(pg8::bf16x8, p); }
                float hl[2][16], cp[2][16];
#pragma unroll
                for (int nt = 0; nt < 2; ++nt) {
                    f32x16 ar, ai, ax;
#pragma unroll
                    for (int i = 0; i < 16; ++i) { ar[i] = 0.f; ai[i] = 0.f; ax[i] = 0.f; }
#pragma unroll
                    for (int ks = 0; ks < 4; ++ks) {
                        const pg8::bf16x8 fa = *(const LAS pg8::bf16x8*)(wfr + (((0 * 2 + nt) * 4 + ks) * 64 + lane) * 16);
                        const pg8::bf16x8 fx = *(const LAS pg8::bf16x8*)(wfr + (((1 * 2 + nt) * 4 + ks) * 64 + lane) * 16);
                        const pg8::bf16x8 fi = *(const LAS pg8::bf16x8*)(ifr + ((nt * 4 + ks) * 64 + lane) * 16);
                        ar = __builtin_amdgcn_mfma_f32_32x32x16_bf16(xa[ks], fa, ar, 0, 0, 0);
                        ai = __builtin_amdgcn_mfma_f32_32x32x16_bf16(xa[ks], fx, ai, 0, 0, 0);
                        ax = __builtin_amdgcn_mfma_f32_32x32x16_bf16(xa[ks], fi, ax, 0, 0, 0); }
                    float P = 1.f, H = 0.f;
#pragma unroll
                    for (int i = 0; i < 16; ++i) {
                        const float rg = fast_sigmoid(ar[i] + cba[nt]), ig = fast_sigmoid(ai[i] + cbx[nt]);
                        const float l2 = -rg * csp[nt];
                        const float a = __builtin_amdgcn_exp2f(l2);
                        const float la = l2 * 0.6931471806f;
                        const float m2 = (la > -0.02f) ? (-2.0f * la) * (1.0f + la * (1.0f + 0.66666667f * la)) : (1.0f - a * a);
                        const float u = __builtin_amdgcn_sqrtf(m2) * ig * ax[i];
                        H = a * H + u; P = P * a; hl[nt][i] = H; cp[nt][i] = P; }
                    const float Ho = __shfl_xor(H, 32), Po = __shfl_xor(P, 32);
                    const float H0 = hh ? Ho : 0.f, P0 = hh ? Po : 1.f;
#pragma unroll
                    for (int i = 0; i < 16; ++i) { hl[nt][i] += cp[nt][i] * H0; cp[nt][i] *= P0; }
                    if (hh) tot[(cur * 8 + wave) * 64 + 32 * nt + r31] = (f32x2l){cp[nt][15], hl[nt][15]};
                }
                asm volatile("s_waitcnt vmcnt(5)" ::: "memory");
                {
                    pg8::bf16x8 ga[4];
#pragma unroll
                    for (int ks = 0; ks < 4; ++ks) { const int pos = (2 * ks + hh) ^ (tokA & 7); ga[ks] = *(const LAS pg8::bf16x8*)(gb + tokA * 128 + pos * 16); }
#pragma unroll
                    for (int nt = 0; nt < 2; ++nt) { f32x16 ag;
#pragma unroll
                        for (int i = 0; i < 16; ++i) ag[i] = 0.f;
#pragma unroll
                        for (int ks = 0; ks < 4; ++ks) { const pg8::bf16x8 fi = *(const LAS pg8::bf16x8*)(ifr + ((nt * 4 + ks) * 64 + lane) * 16);
                            ag = __builtin_amdgcn_mfma_f32_32x32x16_bf16(ga[ks], fi, ag, 0, 0, 0); }
#pragma unroll
                        for (int i = 0; i < 16; ++i) { hl[nt][i] *= ag[i]; cp[nt][i] *= ag[i]; } }
                }
                asm volatile("s_waitcnt lgkmcnt(0)" ::: "memory"); __builtin_amdgcn_s_barrier(); asm volatile("" ::: "memory");
#pragma unroll
                for (int nt = 0; nt < 2; ++nt) { float s = carry[nt], cin = 0.f;
#pragma unroll
                    for (int w2 = 0; w2 < 8; ++w2) { const f32x2l ph = tot[(cur * 8 + w2) * 64 + 32 * nt + r31]; cin = (w2 == wave) ? s : cin; s = ph.x * s + ph.y; }
                    carry[nt] = s;
                    bf16* yo = Z1 + ((size_t)b * SEQ + Tw + 16 * hh) * D + ch0 + 32 * nt + r31;
#pragma unroll
                    for (int i = 0; i < 16; ++i) yo[(size_t)i * D] = (bf16)f2bf(hl[nt][i] + cp[nt][i] * cin); }
            }
            asm volatile("s_waitcnt vmcnt(0)" ::: "memory");
#undef P3_DMA_X
#undef P3_DMA_G
        }
        __syncthreads();
        for (int chunk = bx; chunk < NTOK / 128; chunk += G) {
            const size_t row0 = (size_t)chunk * 128;
            LAS unsigned char* vt = lds;
            LAS float* st = (LAS float*)(lds + AUX_OFF);
            const bf16* sgw = (const bf16*)(ws + WS_SGW);
            __syncthreads();
            for (int r = 0; r < 16; ++r) { const int s = wave * 16 + r; const bf16* vr = Z3 + (row0 + s) * D;
                float v[16]; const v4u w0 = *(const v4u*)(vr + 8 * lane), w1 = *(const v4u*)(vr + 512 + 8 * lane);
                v[0] = pg8::bf_lo(w0.x); v[1] = pg8::bf_hi(w0.x); v[2] = pg8::bf_lo(w0.y); v[3] = pg8::bf_hi(w0.y); v[4] = pg8::bf_lo(w0.z); v[5] = pg8::bf_hi(w0.z); v[6] = pg8::bf_lo(w0.w); v[7] = pg8::bf_hi(w0.w);
                v[8] = pg8::bf_lo(w1.x); v[9] = pg8::bf_hi(w1.x); v[10] = pg8::bf_lo(w1.y); v[11] = pg8::bf_hi(w1.y); v[12] = pg8::bf_lo(w1.z); v[13] = pg8::bf_hi(w1.z); v[14] = pg8::bf_lo(w1.w); v[15] = pg8::bf_hi(w1.w);
                float sm = 0.f;
#pragma unroll
                for (int i = 0; i < 16; ++i) sm += v[i];
                const float mean = wave_sum(sm) * (1.f / D); float q2 = 0.f;
#pragma unroll
                for (int i = 0; i < 16; ++i) { const float d = v[i] - mean; q2 += d * d; }
                const float rstd = 1.0f / sqrtf(wave_sum(q2) * (1.f / D) + EPS);
                if (lane == 0) { st[2 * s] = mean; st[2 * s + 1] = rstd; } }
            __syncthreads();
            const int r31 = lane & 31, hh = lane >> 5;
            const int ti = wave >> 1, ci0 = 2 * (wave & 1);
            for (int g = 0; g < 8; ++g) {
                { const int ch = tid & 15; const int col = g * 128 + 8 * ch;
                    const f32x4 g0 = *(const f32x4*)(args.in[I_SGLNG] + col), g1 = *(const f32x4*)(args.in[I_SGLNG] + col + 4), b0 = *(const f32x4*)(args.in[I_SGLNB] + col), b1 = *(const f32x4*)(args.in[I_SGLNB] + col + 4);
#pragma unroll
                    for (int q = 0; q < 4; ++q) { const int s = (tid >> 4) + 32 * q; const v4u w = *(const v4u*)(Z3 + (row0 + s) * D + col);
                        const float mean = st[2 * s], rstd = st[2 * s + 1];
                        v4u o;
                        o.x = pg8::cvt_pk_bf16((pg8::bf_lo(w.x) - mean) * rstd * g0[0] + b0[0], (pg8::bf_hi(w.x) - mean) * rstd * g0[1] + b0[1]);
                        o.y = pg8::cvt_pk_bf16((pg8::bf_lo(w.y) - mean) * rstd * g0[2] + b0[2], (pg8::bf_hi(w.y) - mean) * rstd * g0[3] + b0[3]);
                        o.z = pg8::cvt_pk_bf16((pg8::bf_lo(w.z) - mean) * rstd * g1[0] + b1[0], (pg8::bf_hi(w.z) - mean) * rstd * g1[1] + b1[1]);
                        o.w = pg8::cvt_pk_bf16((pg8::bf_lo(w.w) - mean) * rstd * g1[2] + b1[2], (pg8::bf_hi(w.w) - mean) * rstd * g1[3] + b1[3]);
                        *(LAS v4u*)(vt + 256 * s + 16 * (ch ^ (((s & 3) << 2) | ((s >> 2) & 3)))) = o; } }
                __syncthreads();
                f32x16 acc0, acc1;
#pragma unroll
                for (int i = 0; i < 16; ++i) { acc0[i] = 0.f; acc1[i] = 0.f; }
                const int nks = 2 * (ti + 1);
                const bf16* wrow = sgw + ((size_t)g * 128 + 32 * ti + r31) * 128 + 8 * hh;
                const unsigned vbase = (unsigned)(size_t)vt;
                for (int ks = 0; ks < nks; ++ks) {
                    const pg8::bf16x8 af = *(const pg8::bf16x8*)(wrow + 16 * ks);
                    const unsigned blk = (lane >> 4) & 1, qq = (lane & 15) >> 2, pp = lane & 3;
                    unsigned ad[2][2];
#pragma unroll
                    for (int cc = 0; cc < 2; ++cc)
#pragma unroll
                        for (int t2 = 0; t2 < 2; ++t2) { const unsigned row = 16 * ks + 8 * hh + 4 * t2 + qq, chn = 4 * (ci0 + cc) + 2 * blk + (pp >> 1);
                            ad[cc][t2] = vbase + 256u * row + 16u * (chn ^ (((row & 3) << 2) | ((row >> 2) & 3))) + 8u * (pp & 1); }
                    v2u f00, f01, f10, f11;
                    asm volatile("ds_read_b64_tr_b16 %0, %4\n\tds_read_b64_tr_b16 %1, %5\n\tds_read_b64_tr_b16 %2, %6\n\tds_read_b64_tr_b16 %3, %7\n\ts_waitcnt lgkmcnt(0)"
                                 : "=&v"(f00), "=&v"(f01), "=&v"(f10), "=&v"(f11) : "v"(ad[0][0]), "v"(ad[0][1]), "v"(ad[1][0]), "v"(ad[1][1]) : "memory");
                    const v4u b0v = (v4u){f00.x, f00.y, f01.x, f01.y}, b1v = (v4u){f10.x, f10.y, f11.x, f11.y};
                    acc0 = __builtin_amdgcn_mfma_f32_32x32x16_bf16(af, __builtin_bit_cast(pg8::bf16x8, b0v), acc0, 0, 0, 0);
                    acc1 = __builtin_amdgcn_mfma_f32_32x32x16_bf16(af, __builtin_bit_cast(pg8::bf16x8, b1v), acc1, 0, 0, 0);
                }
#pragma unroll
                for (int i = 0; i < 16; ++i) { const int t = 32 * ti + (i & 3) + 8 * (i >> 2) + 4 * hh; const float bsv = args.in[I_SGBS][g * 128 + t];
                    bf16* o0 = Z2 + (row0 + t) * D + g * 128 + 32 * ci0 + r31;
                    o0[0] = (bf16)f2bf(bf2f(o0[0]) * (acc0[i] + bsv)); o0[32] = (bf16)f2bf(bf2f(o0[32]) * (acc1[i] + bsv)); }
                __syncthreads();
            }
        }
        if (BOTH(3)) GRID_BAR();
    }

    if (IN(4)) {
        pg8::PlainOrder S; S.init(Z1, (const bf16*)(ws + WS_WBRR), NTOK, D, G, bx);
        EpiMerge E{Z4, nullptr, Z0};
        pg8::gemm_phase<EpiMerge, pg8::PlainOrder, true>(lds, S, E);
        if (BOTH(4)) GRID_BAR();
    }
    if (IN(5)) {
        pg8::PlainOrder S; S.init(Z2, (const bf16*)(ws + WS_WBRS), NTOK, D, G, bx);
        EpiMerge E{Z5, Z0, Z3};
        pg8::gemm_phase<EpiMerge, pg8::PlainOrder, true>(lds, S, E);
        if (BOTH(5)) GRID_BAR();
    }
    if (IN(6)) {
        pg8::PlainOrder S; S.init(Z3, (const bf16*)(ws + WS_WOUT), NTOK, D, G, bx);
        EpiResid E{x_in, modv + 2048, args.out};
        pg8::gemm_phase<EpiResid, pg8::PlainOrder, true>(lds, S, E);
        if (BOTH(6)) GRID_BAR();
    }

    if (IN(7)) {
        LAS f32x4* wr4 = (LAS f32x4*)lds;
        LAS unsigned* hist = (LAS unsigned*)(lds + AUX_OFF);
        __syncthreads();
        for (int q = 0; q < 16; ++q) { const int idx = tid + 512 * q; const int l = idx & 63, e4 = (idx >> 6) & 7, jq = idx >> 9; const int c = 4 * l + 256 * (jq >> 2) + (jq & 3);
            wr4[idx] = *(const f32x4*)(args.in[I_WR] + (size_t)c * NE + 4 * e4); }
        __syncthreads();
        for (int tb = bx; tb < NTOK / 256; tb += G) {
            if (tid < 32) hist[tid] = 0u;
            __syncthreads();
            const int m0 = tb * 256 + wave * 32; const int b = m0 / SEQ;
            f32x4 A4[4], B4[4];
#pragma unroll
            for (int j = 0; j < 4; ++j) { const int c = 4 * lane + 256 * j; const f32x4 g = *(const f32x4*)(args.in[I_N2G] + c), s = *(const f32x4*)(modv + b * DIN + 4096 + c);
                A4[j] = g * (1.0f + s); B4[j] = *(const f32x4*)(modv + b * DIN + 3072 + c); }
            for (int r = 0; r < 32; ++r) {
                const size_t m = (size_t)m0 + r;
                const GAS f32x4* xr = (const GAS f32x4*)(args.out + m * D) + lane;
                f32x4 v[4]; float ss = 0.f;
#pragma unroll
                for (int j = 0; j < 4; ++j) { v[j] = xr[64 * j]; ss += (v[j].x * v[j].x + v[j].y * v[j].y) + (v[j].z * v[j].z + v[j].w * v[j].w); }
                const float rstd = 1.0f / sqrtf(wave_sum(ss) * (1.f / D) + EPS);
                GAS v2u* o8 = (GAS v2u*)(Hb + m * D) + lane;
#pragma unroll
                for (int j = 0; j < 4; ++j) { v[j] = v[j] * rstd * A4[j] + B4[j]; v2u o; o.x = pk2(v[j].x, v[j].y); o.y = pk2(v[j].z, v[j].w); o8[64 * j] = o; }
                float p[32];
#pragma unroll
                for (int e = 0; e < 32; ++e) p[e] = 0.f;
#pragma unroll
                for (int j = 0; j < 4; ++j)
#pragma unroll
                    for (int q = 0; q < 4; ++q) { const float hv = v[j][q];
#pragma unroll
                        for (int e4 = 0; e4 < 8; ++e4) { const f32x4 w4 = wr4[((j * 4 + q) * 8 + e4) * 64 + lane];
                            p[4 * e4 + 0] += hv * w4[0]; p[4 * e4 + 1] += hv * w4[1]; p[4 * e4 + 2] += hv * w4[2]; p[4 * e4 + 3] += hv * w4[3]; } }
#pragma unroll
                for (int e = 0; e < 32; ++e) p[e] = wave_sum(p[e]) + args.in[I_BR][e];
                float tv[4]; int ti[4];
#pragma unroll
                for (int k = 0; k < 4; ++k) { float best = -3.0e38f; int bi = 0;
#pragma unroll
                    for (int e = 0; e < 32; ++e) { if (p[e] > best) { best = p[e]; bi = e; } }
                    tv[k] = best; ti[k] = bi;
#pragma unroll
                    for (int e = 0; e < 32; ++e) p[e] = (e == bi) ? -3.0e38f : p[e]; }
                const float e1 = expf(tv[1] - tv[0]), e2 = expf(tv[2] - tv[0]), e3 = expf(tv[3] - tv[0]); const float inv = 1.0f / (1.0f + e1 + e2 + e3);
                if (lane < 4) { const int myi = lane == 0 ? ti[0] : (lane == 1 ? ti[1] : (lane == 2 ? ti[2] : ti[3])); const float myw = (lane == 0 ? 1.0f : (lane == 1 ? e1 : (lane == 2 ? e2 : e3))) * inv;
                    top_idx[m * 4 + lane] = myi; top_w[m * 4 + lane] = myw; atomicAdd((unsigned*)&hist[myi], 1u); }
            }
            __syncthreads();
            if (tid < 32) blkcnt[tb * 32 + tid] = (int)hist[tid];
            __syncthreads();
        }
        __syncthreads();
        {
            LAS float* scr = (LAS float*)(lds + wave * 16384);
            constexpr int I_GU = 16 * 64, I_DN = 16 * 32;
            for (int it = gw; it < NE * (I_GU + I_DN); it += NGW) {
                const int e = it / (I_GU + I_DN); int r = it % (I_GU + I_DN);
                if (r < I_GU) { const int kb = r / 64, nb = r % 64; const int n0 = 32 * nb; const int cidx = n0 & 1023; const int drow = (cidx >> 7) * 256 + (n0 >= 1024 ? 128 : 0) + (cidx & 127);
                    transpose_item(args.in[I_WGU] + (size_t)e * D * 2048, 2048, D, 64 * kb, n0, (bf16*)(ws + WS_WGU) + (size_t)e * 2048 * D, drow, scr, lane); }
                else { r -= I_GU; const int kb = r / 32, nb = r % 32;
                    transpose_item(args.in[I_WDN] + (size_t)e * D * D, D, D, 64 * kb, 32 * nb, (bf16*)(ws + WS_WDN) + (size_t)e * D * D, 32 * nb, scr, lane); }
            }
        }
        if (BOTH(7)) GRID_BAR();
    }

    if (IN(8)) {
        LAS int* sp_tot = (LAS int*)(lds);
        LAS int* sp_pre = sp_tot + 512;
        LAS int* tot = sp_pre + 512;
        LAS int* myoff = tot + 32;
        LAS int* pstart = myoff + 32;
        LAS unsigned* cursor = (LAS unsigned*)(pstart + 64);
        for (int tb = bx; tb < NTOK / 256; tb += G) {
            __syncthreads();
            { const int e = tid & 31, part = tid >> 5; int s_tot = 0, s_pre = 0;
                for (int B = part; B < 256; B += 16) { const int cn = blkcnt[B * 32 + e]; s_tot += cn; if (B < tb) s_pre += cn; }
                sp_tot[part * 32 + e] = s_tot; sp_pre[part * 32 + e] = s_pre; }
            __syncthreads();
            if (tid < 32) { int a = 0, p = 0; for (int q = 0; q < 16; ++q) { a += sp_tot[q * 32 + tid]; p += sp_pre[q * 32 + tid]; } tot[tid] = a; myoff[tid] = p; cursor[tid] = 0u; }
            __syncthreads();
            if (tid == 0) { int acc = 0; for (int e = 0; e < 32; ++e) { pstart[e] = acc; acc += ((tot[e] + 255) >> 8) << 8; } pstart[32] = acc; }
            __syncthreads();
            for (int q = 0; q < 2; ++q) { const int a = tid + 512 * q; const int tok = tb * 256 + (a >> 2);
                const int e = top_idx[(size_t)tok * 4 + (a & 3)]; const unsigned rnk = atomicAdd((unsigned*)&cursor[e], 1u);
                const int slot = pstart[e] + myoff[e] + (int)rnk;
                slot_tok[slot] = tok; slot_w[slot] = top_w[(size_t)tok * 4 + (a & 3)]; tok_slot[(size_t)tok * 4 + (a & 3)] = slot; }
            if (tb < 32) { const int e = tb; const int nt_e = (tot[e] + 255) >> 8;
                for (int r = tot[e] + tid; r < nt_e * 256; r += 512) { slot_tok[pstart[e] + r] = 0; slot_w[pstart[e] + r] = 0.f; }
                for (int i = tid; i < nt_e; i += 512) tile_exp[(pstart[e] >> 8) + i] = e;
                if (e == 0 && tid == 0) tile_exp[NTILE_MAX] = pstart[32] >> 8; }
        }
        if (BOTH(8)) GRID_BAR();
    }

    for (int chunk = 0; chunk < 2; ++chunk) {
        const int pgu = 9 + 2 * chunk, pdn = 10 + 2 * chunk;
        if (IN(pgu) || IN(pdn)) {
            const int ntiles = tile_exp[NTILE_MAX];
            const int tile0 = chunk == 0 ? 0 : TILES_A;
            int ntc = chunk == 0 ? (ntiles < TILES_A ? ntiles : TILES_A) : (ntiles - TILES_A); if (ntc < 0) ntc = 0; if (ntc > TILES_B_MAX) ntc = TILES_B_MAX;
            bf16* actb = (bf16*)(ws + WS_ACT);
            bf16* yb = (bf16*)(ws + (chunk == 0 ? WS_YLO : WS_YHI));
            asm volatile("" : "+s"(actb), "+s"(yb));
            if (IN(pgu)) {
                pg8::MoeOrder<true> S{Hb, (const bf16*)(ws + WS_WGU), tile_exp, slot_tok, tile0, ntc, 8, G, vcu};
                EpiGu E{actb, args.in[I_BGU], tile0};
                pg8::gemm_phase<EpiGu, pg8::MoeOrder<true>, true>(lds, S, E);
                if (BOTH(pgu)) GRID_BAR();
            }
            if (IN(pdn)) {
                pg8::MoeOrder<false> S{actb, (const bf16*)(ws + WS_WDN), tile_exp, slot_tok, tile0, ntc, 4, G, vcu};
                EpiDown E{yb, args.in[I_BDN], slot_w, tile0};
                pg8::gemm_phase<EpiDown, pg8::MoeOrder<false>, true>(lds, S, E);
                if (BOTH(pdn)) GRID_BAR();
            }
        }
    }

    if (IN(13)) {
        const bf16* ylo = (const bf16*)(ws + WS_YLO); const bf16* yhi = (const bf16*)(ws + WS_YHI);
        for (int rb = gw; rb < NTOK / 32; rb += NGW) {
            const int b = (rb * 32) / SEQ;
            f32x4 G4[4], F4[4];
#pragma unroll
            for (int j = 0; j < 4; ++j) { const int c = 4 * lane + 256 * j; G4[j] = *(const f32x4*)(modv + b * DIN + 5120 + c); F4[j] = *(const f32x4*)(args.in[I_FG] + c); }
            for (int r = 0; r < 32; ++r) {
                const size_t m = (size_t)rb * 32 + r;
                GAS f32x4* xr = (GAS f32x4*)(args.out + m * D) + lane;
                f32x4 v[4], s4[4];
#pragma unroll
                for (int j = 0; j < 4; ++j) { v[j] = xr[64 * j]; s4[j] = (f32x4){0.f, 0.f, 0.f, 0.f}; }
#pragma unroll
                for (int k = 0; k < 4; ++k) { const int slot = tok_slot[m * 4 + k];
                    const bf16* yr = slot < TILES_A * 256 ? ylo + (size_t)slot * D : yhi + (size_t)(slot - TILES_A * 256) * D;
                    const GAS v2u* y8 = (const GAS v2u*)yr + lane;
#pragma unroll
                    for (int j = 0; j < 4; ++j) { const v2u w = y8[64 * j]; s4[j] += (f32x4){pg8::bf_lo(w.x), pg8::bf_hi(w.x), pg8::bf_lo(w.y), pg8::bf_hi(w.y)}; } }
                float ss = 0.f;
#pragma unroll
                for (int j = 0; j < 4; ++j) { v[j] = v[j] + G4[j] * s4[j]; ss += (v[j].x * v[j].x + v[j].y * v[j].y) + (v[j].z * v[j].z + v[j].w * v[j].w); }
                const float rstd = 1.0f / sqrtf(wave_sum(ss) * (1.f / D) + EPS);
#pragma unroll
                for (int j = 0; j < 4; ++j) xr[64 * j] = v[j] * rstd * F4[j];
            }
        }
    }
#undef IN
#undef BOTH
}

extern "C" void kernel_launch(void* const* d_in, const int* in_sizes, int n_in, void* d_out, int out_size, void* d_ws, size_t ws_size, hipStream_t stream) {
    static int grid = 0;
    if (grid == 0) {
        if (n_in != 28 || out_size != NTOK * D || ws_size < WS_Z + 6 * ZREG) { fprintf(stderr, "kernel_launch: unexpected shapes (n_in %d out %d ws %zu)\n", n_in, out_size, ws_size); grid = -1; return; }
        int dev = 0, cus = 0, per_cu = 0;
        if (hipGetDevice(&dev) != hipSuccess || hipDeviceGetAttribute(&cus, hipDeviceAttributeMultiprocessorCount, dev) != hipSuccess) { grid = -1; return; }
        if (hipFuncSetAttribute((const void*)mega_fwd, hipFuncAttributeMaxDynamicSharedMemorySize, LDS_BYTES) != hipSuccess) { fprintf(stderr, "kernel_launch: hipFuncSetAttribute failed\n"); grid = -1; return; }
        if (hipOccupancyMaxActiveBlocksPerMultiprocessor(&per_cu, (const void*)mega_fwd, NWAVES * 64, LDS_BYTES) != hipSuccess || per_cu < 1)
            fprintf(stderr, "kernel_launch: occupancy query reports %d workgroups per CU\n", per_cu);
        (void)hipGetLastError();
        grid = cus;
    }
    if (grid < 0) return;
    (void)hipMemsetAsync((char*)d_ws + WS_CTL, 0, CTL_ZERO_BYTES, stream);
    Args a{};
    for (int i = 0; i < 28; ++i) a.in[i] = (const float*)d_in[i];
    a.out = (float*)d_out; a.ws = (unsigned char*)d_ws;
#if MK_PER_PHASE
    for (int p = 0; p < N_PHASES; ++p) { a.ph_lo = p; a.ph_hi = p + 1; a.li = p; a.pad = 0; hipLaunchKernelGGL(mega_fwd, dim3(grid), dim3(NWAVES * 64), LDS_BYTES, stream, a); }
#else
    a.ph_lo = 0; a.ph_hi = N_PHASES; a.li = 0; a.pad = 0;
    hipLaunchKernelGGL(mega_fwd, dim3(grid), dim3(NWAVES * 64), LDS_BYTES, stream, a);
#endif
}
```

```cpp
#include <hip/hip_runtime.h>
#include <cstdio>
#include <cstdint>

#ifndef MK_PER_PHASE
#define MK_PER_PHASE 0
#endif

namespace pg8 {
#define PG8_LAS __attribute__((address_space(3)))
typedef unsigned short bf16_t;
typedef short bf16x8 __attribute__((ext_vector_type(8)));
typedef float f32x4 __attribute__((ext_vector_type(4)));
typedef float f32x2 __attribute__((ext_vector_type(2)));
typedef unsigned u32x4 __attribute__((ext_vector_type(4)));
typedef unsigned u32x2 __attribute__((ext_vector_type(2)));
constexpr int BM = 256, BK = 64, HALF = 128, HTB = HALF * BK * 2, STAGE_BYTES = 8 * HTB, NXCD = 8, WGM = 8, KD = 1024;

__host__ __device__ __forceinline__ int lds_byte(int r, int c) { const int st = (r >> 4) * 2 + (c >> 5), rr = r & 15, cc = c & 31, ob = rr * 64 + cc * 2; return st * 1024 + (ob ^ (((ob >> 9) & 1) << 5)); }
__host__ __device__ __forceinline__ void stage_rc(int b, int& R, int& C) { const int st = b / 1024, sb = b % 1024, swz = sb ^ (((sb >> 9) & 1) << 5); R = (st >> 1) * 16 + swz / 64; C = (st & 1) * 32 + (swz % 64) / 2; }
__host__ __device__ __forceinline__ int perm32(int rho) { const int n = rho >> 4, i = rho & 15; return 8 * (i >> 2) + 4 * n + (i & 3); }

struct Unit { int pm, pn, e, par; };

template <bool FP8_> struct PlainOrderT {
    static constexpr bool GATHER = false, FP8 = FP8_; static constexpr int KB = FP8_ ? KD : KD * 2;
    const bf16_t* A; const bf16_t* Bt; int nM, nN, nwg, G, c;
    __device__ void init(const bf16_t* A_, const bf16_t* Bt_, int M, int N, int G_, int c_) { A = A_; Bt = Bt_; nM = M / BM; nN = N / BM; nwg = nM * nN; G = G_; c = c_; }
    __device__ __forceinline__ bool next(int i, Unit& u) const {
        const long L = (long)i * G + c; if (L >= nwg) return false;
        int wgid = (int)L; { const int q = nwg / NXCD, r = nwg % NXCD, xcd = wgid % NXCD, off = wgid / NXCD; wgid = (xcd < r ? xcd * (q + 1) : r * (q + 1) + (xcd - r) * q) + off; }
        const int nig = WGM * nN, gid = wgid / nig, fm = gid * WGM, gsz = (nM - fm) < WGM ? (nM - fm) : WGM;
        u.pm = fm + ((wgid % nig) % gsz); u.pn = (wgid % nig) / gsz; u.e = 0; return true;
    }
    __device__ __forceinline__ const char* a_base(const Unit& u) const { return (const char*)A + (size_t)u.pm * ((size_t)BM * KB); }
    __device__ __forceinline__ const char* b_base(const Unit& u) const { return (const char*)Bt + (size_t)u.pn * ((size_t)BM * KB); }
    __device__ __forceinline__ void load_rows(const Unit&, unsigned (&)[2][2]) const {}
    __device__ __forceinline__ void load_rows_lds(const Unit&, unsigned (&)[2][2]) const {}
    __device__ __forceinline__ void prefetch_rows(const Unit&, int, int) const {}
    __device__ __forceinline__ void init_lds(int) const {}
};
typedef PlainOrderT<false> PlainOrder;
struct PanelOrder {
    static constexpr bool GATHER = false, FP8 = false; static constexpr int KB = KD * 2;
    const bf16_t* A; const bf16_t* Bt; int panel, nN;
    __device__ __forceinline__ bool next(int i, Unit& u) const { if (i >= nN) return false; u.pm = panel; u.pn = (i + panel) & (nN - 1); u.e = 0; return true; }
    __device__ __forceinline__ const char* a_base(const Unit& u) const { return (const char*)A + (size_t)u.pm * ((size_t)BM * KD * 2); }
    __device__ __forceinline__ const char* b_base(const Unit& u) const { return (const char*)Bt + (size_t)u.pn * ((size_t)BM * KD * 2); }
    __device__ __forceinline__ void load_rows(const Unit&, unsigned (&)[2][2]) const {}
    __device__ __forceinline__ void load_rows_lds(const Unit&, unsigned (&)[2][2]) const {}
    __device__ __forceinline__ void prefetch_rows(const Unit&, int, int) const {}
    __device__ __forceinline__ void init_lds(int) const {}
};
template <bool GATHER_> struct MoeOrder {
    static constexpr bool GATHER = GATHER_, FP8 = true; static constexpr int KB = KD;
    const bf16_t* A; const bf16_t* Bt; const int* tile_exp; const int* slot_tok; int tile0, ntile, nN, G, c; PG8_LAS unsigned char* aux;
    __device__ __forceinline__ bool next(int i, Unit& u) const {
        const int L = i * G + c; if (L >= ntile * nN) return false;
        const int sh = (nN == 8) ? 3 : 2; const int pl = L >> sh; u.pn = L & (nN - 1); u.pm = tile0 + pl; u.e = ((const PG8_LAS int*)(aux + 6144))[u.pm]; return true;
    }
    __device__ __forceinline__ const char* a_base(const Unit& u) const { return GATHER ? (const char*)A : (const char*)A + (size_t)(u.pm - tile0) * ((size_t)BM * KB); }
    __device__ __forceinline__ const char* b_base(const Unit& u) const { return (const char*)Bt + ((size_t)u.e * nN + u.pn) * ((size_t)BM * KB); }
    __device__ __forceinline__ void load_rows(const Unit& u, unsigned (&out)[2][2]) const {
#pragma unroll
        for (int i = 0; i < 2; ++i) { int R, C; stage_rc((int)threadIdx.x * 16 + i * 8192, R, C);
#pragma unroll
            for (int h = 0; h < 2; ++h) out[h][i] = (unsigned)slot_tok[u.pm * BM + h * HALF + R] * (unsigned)KB + (unsigned)C * 2u; }
    }
    __device__ __forceinline__ void load_rows_lds(const Unit& u, unsigned (&out)[2][2]) const {
        const PG8_LAS int* idx = (const PG8_LAS int*)(aux + u.par * 3072 + 2048);
#pragma unroll
        for (int i = 0; i < 2; ++i) { int R, C; stage_rc((int)threadIdx.x * 16 + i * 8192, R, C);
#pragma unroll
            for (int h = 0; h < 2; ++h) out[h][i] = (unsigned)idx[h * HALF + R] * (unsigned)KB + (unsigned)C * 2u; }
    }
    __device__ __forceinline__ void init_lds(int tid) const { for (int i = tid; i < 1056; i += 512) ((PG8_LAS int*)(aux + 6144))[i] = tile_exp[i]; __syncthreads(); }
    __device__ __forceinline__ void prefetch_rows(const Unit& nx, int wid, int lane) const {
        if (GATHER && wid == 2) __builtin_amdgcn_global_load_lds((const unsigned*)(slot_tok + nx.pm * BM + lane * 4), (PG8_LAS unsigned*)(aux + nx.par * 3072 + 2048), 16, 0, 0);
    }
};

typedef __bf16 bf16x2_n __attribute__((ext_vector_type(2)));
__device__ __forceinline__ unsigned cvt_pk_bf16(float lo, float hi) { const f32x2 v = {lo, hi}; const bf16x2_n r = __builtin_convertvector(v, bf16x2_n); return __builtin_bit_cast(unsigned, r); }
__device__ __forceinline__ float bf_lo(unsigned w) { return __uint_as_float(w << 16); }
__device__ __forceinline__ float bf_hi(unsigned w) { return __uint_as_float(w & 0xffff0000u); }

template <class Epi, class Sched, bool ALIGN_EPI>
__device__ __forceinline__ void gemm_phase(PG8_LAS unsigned char* lds, const Sched& S, const Epi& E) {
    static_assert(ALIGN_EPI, "the store-tolerant waits below assume aligned epilogues");
    int tid_ = threadIdx.x; asm volatile("" : "+v"(tid_));
    const int tid = tid_, wid = __builtin_amdgcn_readfirstlane(tid >> 6), lane = tid & 63, wr = wid >> 2, wc = wid & 3, fr = lane & 15, fq = lane >> 4;
    constexpr int KB = Sched::KB, nt = KB / (BK * 2);
    unsigned voffA[2], voffB[2];
#pragma unroll
    for (int i = 0; i < 2; ++i) { int R, C; stage_rc(tid * 16 + i * 8192, R, C); const int Rb = Epi::BREMAP ? (64 * (R >> 5) + perm32(R & 31)) : ((R & ~31) + perm32(R & 31));
        voffA[i] = (unsigned)(R * KB + C * 2); voffB[i] = (unsigned)(Rb * KB + C * 2); }
    constexpr size_t kstep = (size_t)(BK * 2);
    constexpr size_t hstep = (size_t)HALF * KB;
    constexpr size_t hstepB = Epi::BREMAP ? (size_t)32 * KB : hstep;
    const unsigned ldsw = (unsigned)wid * 1024u;
    const int aoff = lds_byte(wr * 64 + fr, fq * 8), boff = lds_byte(wc * 32 + fr, fq * 8);
#define PG8_SA(b, h) (((b) * 2 + (h)) * HTB)
#define PG8_SB(b, h) ((4 + (b) * 2 + (h)) * HTB)
#define PG8_STAGE(bufoff, gbase, voff) do { _Pragma("unroll") for (int _i = 0; _i < 2; ++_i) \
        __builtin_amdgcn_global_load_lds((const unsigned*)((const char*)(gbase) + (voff)[_i]), (PG8_LAS unsigned*)(lds + (bufoff) + ldsw + _i * 8192), 16, 0, 0); } while (0)
#define PG8_STAGE_B(b, h, base) PG8_STAGE(PG8_SB(b, h), (base) + (h) * hstepB, voffB)
#define PG8_STAGE_A(b, h, base, GO) do { if constexpr (Sched::GATHER) { PG8_STAGE(PG8_SA(b, h), (base), GO[h]); } else { PG8_STAGE(PG8_SA(b, h), (base) + (h) * hstep, voffA); } } while (0)
#define PG8_LDA(dst, b, h) do { _Pragma("unroll") for (int m = 0; m < 4; ++m) _Pragma("unroll") for (int k = 0; k < 2; ++k) dst[m][k] = *(const PG8_LAS bf16x8*)(lds + PG8_SA(b, h) + aoff + m * 2048 + k * 1024); } while (0)
#define PG8_LDB(dst, b, h) do { _Pragma("unroll") for (int n = 0; n < 2; ++n) _Pragma("unroll") for (int k = 0; k < 2; ++k) dst[n][k] = *(const PG8_LAS bf16x8*)(lds + PG8_SB(b, h) + boff + n * 2048 + k * 1024); } while (0)
#define PG8_MMA(ai, bj, At, Bt) do { __builtin_amdgcn_s_setprio(1); _Pragma("unroll") for (int m = 0; m < 4; ++m) _Pragma("unroll") for (int n = 0; n < 2; ++n) { \
        if constexpr (Sched::FP8) { typedef int v4i_ __attribute__((ext_vector_type(4))); \
            acc[ai][bj][m][n] = __builtin_amdgcn_mfma_scale_f32_16x16x128_f8f6f4(__builtin_shufflevector(__builtin_bit_cast(v4i_, Bt[n][0]), __builtin_bit_cast(v4i_, Bt[n][1]), 0, 1, 2, 3, 4, 5, 6, 7), \
                __builtin_shufflevector(__builtin_bit_cast(v4i_, At[m][0]), __builtin_bit_cast(v4i_, At[m][1]), 0, 1, 2, 3, 4, 5, 6, 7), acc[ai][bj][m][n], 0, 0, 0, 0, 0, 0); } \
        else { _Pragma("unroll") for (int k = 0; k < 2; ++k) acc[ai][bj][m][n] = __builtin_amdgcn_mfma_f32_16x16x32_bf16(Bt[n][k], At[m][k], acc[ai][bj][m][n], 0, 0, 0); } } \
        __builtin_amdgcn_s_setprio(0); } while (0)
#define PG8_WAIT_V(n) asm volatile("s_waitcnt vmcnt(" #n ")" ::: "memory")
#define PG8_WAIT_L(n) asm volatile("s_waitcnt lgkmcnt(" #n ")" ::: "memory")
#define PG8_BAR __builtin_amdgcn_s_barrier()
#define PG8_SCHED __builtin_amdgcn_sched_barrier(0)
    Unit cur, nxt; int ui = 0;
    S.init_lds(tid);
    if (!S.next(0, cur)) return;
    f32x4 acc[2][2][4][2];
#pragma unroll
    for (int a = 0; a < 2; ++a)
#pragma unroll
        for (int b = 0; b < 2; ++b)
#pragma unroll
            for (int m = 0; m < 4; ++m)
#pragma unroll
                for (int n = 0; n < 2; ++n) acc[a][b][m][n] = (f32x4){0.f, 0.f, 0.f, 0.f};
    bf16x8 At[4][2], B0[2][2], B1[2][2];
    unsigned gA[2][2] = {{0u, 0u}, {0u, 0u}};
    const char* cA = S.a_base(cur); const char* cB = S.b_base(cur);
    if constexpr (Sched::GATHER) S.load_rows(cur, gA);
    PG8_STAGE_B(0, 0, cB); PG8_STAGE_B(0, 1, cB); PG8_STAGE_A(0, 0, cA, gA); PG8_STAGE_A(0, 1, cA, gA);
    if (wr == 1) PG8_BAR;
    PG8_WAIT_V(2); PG8_BAR;
    PG8_STAGE_B(1, 0, cB + kstep); PG8_STAGE_A(1, 0, cA + kstep, gA); PG8_STAGE_B(1, 1, cB + kstep);
    PG8_WAIT_V(6); PG8_BAR;
    cur.par = 0;
    for (;;) {
        const bool has_next = S.next(ui + 1, nxt); nxt.par = (ui + 1) & 1;
        if (has_next) S.prefetch_rows(nxt, wid, lane);
        E.prefetch(cur, wid, lane);
        const char* nA = has_next ? S.a_base(nxt) : cA; const char* nB = has_next ? S.b_base(nxt) : cB;
#define PG8_TRIP(t, last, WV, SKIP11) do { \
            const char* a1 = cA + (size_t)((t) + 1) * kstep; \
            const char* a2 = (last) ? nA : cA + (size_t)((t) + 2) * kstep; const char* b2 = (last) ? nB : cB + (size_t)((t) + 2) * kstep; \
            const char* a3 = a2 + kstep; const char* b3 = b2 + kstep; \
            PG8_LDB(B0, 0, 0); PG8_LDB(B1, 0, 1); PG8_SCHED; PG8_LDA(At, 0, 0); if (!(SKIP11)) PG8_STAGE_A(1, 1, a1, gA); \
            if constexpr (Sched::GATHER) { if ((last) && has_next) S.load_rows_lds(nxt, gA); } \
            WV; PG8_WAIT_L(0); PG8_BAR; PG8_MMA(0, 0, At, B0); PG8_MMA(0, 1, At, B1); PG8_BAR; PG8_SCHED; \
            PG8_LDA(At, 0, 1); PG8_STAGE_B(0, 0, b2); PG8_STAGE_B(0, 1, b2); PG8_STAGE_A(0, 0, a2, gA); \
            WV; PG8_WAIT_L(0); PG8_BAR; PG8_MMA(1, 0, At, B0); PG8_MMA(1, 1, At, B1); PG8_BAR; PG8_SCHED; \
            PG8_LDB(B0, 1, 0); PG8_LDB(B1, 1, 1); PG8_SCHED; PG8_LDA(At, 1, 0); PG8_STAGE_A(0, 1, a2, gA); \
            WV; PG8_WAIT_L(0); PG8_BAR; PG8_MMA(0, 0, At, B0); PG8_MMA(0, 1, At, B1); PG8_BAR; PG8_SCHED; \
            PG8_LDA(At, 1, 1); PG8_STAGE_B(1, 0, b3); PG8_STAGE_B(1, 1, b3); PG8_STAGE_A(1, 0, a3, gA); \
            PG8_WAIT_V(8); PG8_WAIT_L(0); PG8_BAR; PG8_MMA(1, 0, At, B0); PG8_MMA(1, 1, At, B1); PG8_BAR; PG8_SCHED; } while (0)
        int rl = __builtin_amdgcn_readfirstlane((ui > 0) ? 1 : 0); asm volatile("" : "+s"(rl));
#define PG8_WV() do { if (rl) { if constexpr (Epi::NST >= 16) PG8_WAIT_V(24); else if constexpr (Epi::NST >= 8) PG8_WAIT_V(16); else PG8_WAIT_V(12); } else PG8_WAIT_V(8); } while (0)
#pragma nounroll
        for (int t = 0; t < nt; t += 2) { const bool last = (t == nt - 2); PG8_TRIP(t, last, PG8_WV(), rl); rl = 0; asm volatile("" : "+s"(rl)); }
#undef PG8_WV
#undef PG8_TRIP
        if constexpr (ALIGN_EPI) { if (wr == 0) PG8_BAR; }
        if (has_next) PG8_STAGE_A(1, 1, nA + kstep, gA);
        E(acc, cur, wr, wc, fr, fq);
        if (!has_next) break;
#pragma unroll
        for (int a = 0; a < 2; ++a)
#pragma unroll
            for (int b = 0; b < 2; ++b)
#pragma unroll
                for (int m = 0; m < 4; ++m)
#pragma unroll
                    for (int n = 0; n < 2; ++n) acc[a][b][m][n] = (f32x4){0.f, 0.f, 0.f, 0.f};
        cur = nxt; cA = nA; cB = nB; ++ui;
        if constexpr (ALIGN_EPI) { if (wr == 1) PG8_BAR; }
    }
    PG8_WAIT_V(0);
    if constexpr (!ALIGN_EPI) { if (wr == 0) PG8_BAR; }
    PG8_BAR;
#undef PG8_SA
#undef PG8_SB
#undef PG8_STAGE
#undef PG8_STAGE_A
#undef PG8_STAGE_B
#undef PG8_LDA
#undef PG8_LDB
#undef PG8_MMA
#undef PG8_WAIT_V
#undef PG8_WAIT_L
#undef PG8_BAR
#undef PG8_SCHED
}
}

constexpr int NWAVES = 8;
constexpr int BATCH = 16, SEQ = 4096, D = 1024, NTOK = BATCH * SEQ, DIN = 6144, NE = 32, TOPK = 4;
constexpr int CAPROWS = NTOK * TOPK + NE * 256, NTILE_MAX = CAPROWS / 256;
constexpr int TILES_A = 512, TILES_B_MAX = NTILE_MAX - TILES_A;
constexpr float EPS = 1e-6f;
constexpr int N_PHASES = 14;

constexpr size_t MiB = 1u << 20;
constexpr size_t WS_CTL = 0, CTL_ZERO_BYTES = 32768;
constexpr size_t WS_MOD = 1 * MiB;
constexpr size_t WS_WIN = 2 * MiB;
constexpr size_t WS_WBRR = 14 * MiB, WS_WBRS = 16 * MiB, WS_WOUT = 18 * MiB;
constexpr size_t WS_SGW = 20 * MiB;
constexpr size_t WS_TOPI = 21 * MiB, WS_TOPW = 22 * MiB, WS_TSLOT = 23 * MiB;
constexpr size_t WS_SLOTTOK = 24 * MiB;
constexpr size_t WS_SLOTW = 26 * MiB;
constexpr size_t WS_BLKCNT = 28 * MiB;
constexpr size_t WS_TILEEXP = 28 * MiB + 65536;
constexpr size_t WS_H = 32 * MiB;
constexpr size_t WS_H8 = 928 * MiB;
constexpr size_t WS_SGST = 992 * MiB;
constexpr size_t WS_WIN8 = 29 * MiB;
constexpr size_t WS_Z = 160 * MiB;
constexpr size_t ZREG = (size_t)NTOK * D * 2;
constexpr size_t WS_X1B = WS_Z;
constexpr size_t WS_H2 = WS_Z + ZREG;
constexpr size_t WS_WGU = 32 * MiB;
constexpr size_t WS_H2Q = 96 * MiB;
constexpr size_t WS_ACT = 416 * MiB;
constexpr size_t WS_YLO = 688 * MiB;
constexpr size_t WS_WDN = 944 * MiB;
constexpr size_t WS_YX = 1008 * MiB;
constexpr size_t WS_TOTAL = 1024 * MiB;
static_assert(WS_Z + 6 * ZREG <= 1024 * MiB, "z fits");
static_assert(WS_ACT + (size_t)NTILE_MAX * 256 * D <= WS_YLO && WS_YLO + (size_t)TILES_A * 256 * D * 2 <= WS_WDN && WS_WDN + (size_t)NE * D * D * 2 <= WS_YX && WS_YX + (size_t)32 * 256 * D * 2 <= WS_TOTAL && WS_ACT >= WS_H2 + ZREG, "moe map");
__host__ __device__ __forceinline__ size_t y_tile_off(int tile) {
    return tile < 512 ? WS_YLO + (size_t)tile * (256 * D * 2) : (tile < 768 ? WS_H2 + (size_t)(tile - 512) * (256 * D * 2) : (tile < 1024 ? WS_WGU + (size_t)(tile - 768) * (256 * D * 2) : WS_YX + (size_t)(tile - 1024) * (256 * D * 2)));
}
constexpr int CW_TMO = 0;
constexpr int CW_BAR = 4096;

constexpr int RING_BYTES = 131072;
constexpr int MISC_OFF = RING_BYTES + 320;
constexpr int AUX_OFF = RING_BYTES + 1024;
constexpr int LDS_BYTES = 163840;

#define GAS __attribute__((address_space(1)))
#define LAS __attribute__((address_space(3)))
typedef unsigned short bf16;
typedef unsigned v4u __attribute__((ext_vector_type(4)));
typedef unsigned v2u __attribute__((ext_vector_type(2)));
typedef float f32x4 __attribute__((ext_vector_type(4)));
typedef GAS unsigned gu32;
#define RLX_AGENT __ATOMIC_RELAXED, __HIP_MEMORY_SCOPE_AGENT
#define LDS_WAIT() asm volatile("s_waitcnt lgkmcnt(0)" ::: "memory")
#define VM_WAIT() asm volatile("s_waitcnt vmcnt(0)" ::: "memory")
__device__ __forceinline__ unsigned f2bf(float f) { unsigned u = __builtin_bit_cast(unsigned, f); return (u + 0x7fffu + ((u >> 16) & 1u)) >> 16; }
__device__ __forceinline__ unsigned pk2(float lo, float hi) { return f2bf(lo) | (f2bf(hi) << 16); }
__device__ __forceinline__ float bf2f(bf16 b) { return __uint_as_float(((unsigned)b) << 16); }
__device__ __forceinline__ unsigned pk4_fp8(float a, float b, float c, float d) {
    a = __builtin_amdgcn_fmed3f(a, -448.0f, 448.0f); b = __builtin_amdgcn_fmed3f(b, -448.0f, 448.0f); c = __builtin_amdgcn_fmed3f(c, -448.0f, 448.0f); d = __builtin_amdgcn_fmed3f(d, -448.0f, 448.0f);
    int w = __builtin_amdgcn_cvt_pk_fp8_f32(a, b, 0, false); w = __builtin_amdgcn_cvt_pk_fp8_f32(c, d, w, true); return (unsigned)w;
}
constexpr float SC_H2 = 8.0f, SC_W = 128.0f, SC_ACT = 4.0f, SC_Y = 32.0f;

#define XB_TMO      128
#define XB_XCNT(j)  (256  + 64 * (j))
#define XB_XSUB(j)  (1280 + 64 * (j))
#define XB_XGEN(j)  (2304 + 64 * (j))
#define XB_TOP      3328
#define XB_TOPGEN   3392
#define XCD_BAR_WORDS 3456
#define XB_SPIN_CAP (1u << 18)
__device__ __forceinline__ unsigned xb_ld(unsigned* p)              { return __hip_atomic_load(p, __ATOMIC_RELAXED, __HIP_MEMORY_SCOPE_AGENT); }
__device__ __forceinline__ unsigned xb_add(unsigned* p, unsigned v) { return __hip_atomic_fetch_add(p, v, __ATOMIC_RELAXED, __HIP_MEMORY_SCOPE_AGENT); }
__device__ __forceinline__ unsigned xb_xcc_id() { return (unsigned)__builtin_amdgcn_s_getreg((3 << 11) | 20) & 0xFu; }
#define XB_SPIN(cond, bar) do { unsigned _sp = 0; while (cond) { __builtin_amdgcn_s_sleep(1); \
    if ((++_sp & 255u) == 0u) { if (xb_ld(&(bar)[XB_TMO])) break; if (_sp > XB_SPIN_CAP) { atomicAdd(&(bar)[XB_TMO], 1u); break; } } } } while (0)
struct XcdBarrier { unsigned* bar; unsigned x; volatile LAS unsigned* st; };
__device__ __forceinline__ XcdBarrier xcd_barrier_post(unsigned* bar, volatile LAS unsigned* st) {
    XcdBarrier b; b.bar = bar; b.x = xb_xcc_id(); b.st = st;
    if (threadIdx.x == 0) (void)xb_add(&bar[XB_XCNT(b.x)], 1u);
    return b;
}
__device__ __forceinline__ void xcd_barrier_complete(unsigned* bar, unsigned x, unsigned& nloc, unsigned& nx) {
    const unsigned G = gridDim.x * gridDim.y * gridDim.z;
    unsigned sum, cnt, mine, sp = 0u;
    for (;;) {
        sum = 0u; cnt = 0u; mine = 0u;
#pragma unroll
        for (unsigned j = 0; j < 16; ++j) { const unsigned c = xb_ld(&bar[XB_XCNT(j)]); sum += c; cnt += (c > 0u) ? 1u : 0u; mine = (j == x) ? c : mine; }
        if (sum == G) break;
        __builtin_amdgcn_s_sleep(1);
        if ((++sp & 255u) == 0u) { if (xb_ld(&bar[XB_TMO])) break; if (sp > XB_SPIN_CAP) { atomicAdd(&bar[XB_TMO], 1u); break; } }
    }
    nloc = mine > 0u ? mine : 1u; nx = cnt > 0u ? cnt : 1u;
}
__device__ __forceinline__ void xcd_barrier(const XcdBarrier& b) {
    asm volatile("s_waitcnt vmcnt(0)" ::: "memory");
    __syncthreads();
    if (threadIdx.x == 0) {
        unsigned* bar = b.bar;
        __builtin_amdgcn_s_waitcnt(0);
        unsigned nloc = b.st[0], nx = b.st[1];
        if (nloc == 0u) { xcd_barrier_complete(bar, b.x, nloc, nx); b.st[0] = nloc; b.st[1] = nx; }
        const unsigned old = xb_add(&bar[XB_XSUB(b.x)], 1u);
        const unsigned gen = old / nloc;
        if (old + 1u == (gen + 1u) * nloc) {
            __builtin_amdgcn_fence(__ATOMIC_RELEASE, "agent");
            asm volatile("s_waitcnt vmcnt(0)" ::: "memory");
            const unsigned og = xb_add(&bar[XB_TOP], 1u);
            const unsigned tg = og / nx;
            if (og + 1u == (tg + 1u) * nx) xb_add(&bar[XB_TOPGEN], 1u);
            else XB_SPIN(xb_ld(&bar[XB_TOPGEN]) == tg, bar);
            __builtin_amdgcn_fence(__ATOMIC_ACQUIRE, "agent");
            xb_add(&bar[XB_XGEN(b.x)], 1u);
            asm volatile("s_waitcnt vmcnt(0)" ::: "memory");
        } else {
            XB_SPIN(xb_ld(&bar[XB_XGEN(b.x)]) == gen, bar);
            __builtin_amdgcn_fence(__ATOMIC_ACQUIRE, "agent");
            asm volatile("s_waitcnt vmcnt(0)" ::: "memory");
        }
    }
    __syncthreads();
}

__device__ __forceinline__ float wave_sum(float v) {
#pragma unroll
    for (int o = 1; o < 64; o <<= 1) v += __shfl_xor(v, o);
    return v;
}
__device__ __forceinline__ float fast_sigmoid(float x) { return __builtin_amdgcn_rcpf(1.0f + __builtin_amdgcn_exp2f(-1.4426950409f * x)); }
__device__ __forceinline__ float gelu_tanh(float x) { const float a = x * (1.5957691216f + 0.0713548163f * x * x); return x * fast_sigmoid(a); }

__device__ __forceinline__ void stage_store128(LAS unsigned char* stg, int lane, int fr, int fq, pg8::u32x4 w0, pg8::u32x4 w1, bf16* gp, size_t ld8) {
    *(LAS pg8::u32x4*)(stg + fr * 144 + fq * 16) = w0; *(LAS pg8::u32x4*)(stg + fr * 144 + 64 + fq * 16) = w1;
    const pg8::u32x4 r0 = *(const LAS pg8::u32x4*)(stg + (lane >> 3) * 144 + (lane & 7) * 16), r1 = *(const LAS pg8::u32x4*)(stg + ((lane >> 3) + 8) * 144 + (lane & 7) * 16);
    *(pg8::u32x4*)gp = r0; *(pg8::u32x4*)(gp + ld8) = r1;
}
__device__ __forceinline__ void stage_store64(LAS unsigned char* stg, int lane, int fr, int fq, pg8::u32x4 w, bf16* gp) {
    *(LAS pg8::u32x4*)(stg + fr * 80 + fq * 16) = w;
    const pg8::u32x4 r = *(const LAS pg8::u32x4*)(stg + (lane >> 2) * 80 + (lane & 3) * 16);
    *(pg8::u32x4*)gp = r;
}
#define EPI_STG() (lds_epi + (wr * 4 + wc) * 2304)

template <bool F8> struct EpiZT {
    static constexpr bool PERM = true, BREMAP = true; static constexpr int NST = 16;
    bf16* Z; LAS unsigned char* lds_epi; int pn0; float* sgst;
    __device__ __forceinline__ void prefetch(const pg8::Unit&, int, int) const {}
    template <int MODE, bool ST> __device__ __forceinline__ void body(const pg8::f32x4 (&acc)[2][2][4][2], bf16* base, int lane, int wr, int wc, int fr, int fq, float* stp) const {
#pragma unroll
        for (int ai = 0; ai < 2; ++ai)
#pragma unroll
            for (int m = 0; m < 4; ++m) { pg8::u32x4 w[2]; pg8::f32x2 s1 = (pg8::f32x2){0.f, 0.f}, s2 = s1;
#pragma unroll
                for (int bj = 0; bj < 2; ++bj) { unsigned pk[4];
#pragma unroll
                    for (int q = 0; q < 4; ++q) { const pg8::f32x4 a4 = acc[ai][bj][m][q >> 1]; pg8::f32x2 x = (pg8::f32x2){a4[2 * (q & 1)], a4[2 * (q & 1) + 1]}; if constexpr (F8) x = x * (1.0f / (SC_H2 * SC_W)); pg8::f32x2 v;
                        if constexpr (MODE == 0) v = x;
                        else if constexpr (MODE == 1) {
                            const pg8::f32x2 t = x * ((x * x) * (-0.10294324f) + (-2.3022082f));
                            const pg8::f32x2 d = (pg8::f32x2){__builtin_amdgcn_exp2f(t.x), __builtin_amdgcn_exp2f(t.y)} + 1.0f;
                            v = x * (pg8::f32x2){__builtin_amdgcn_rcpf(d.x), __builtin_amdgcn_rcpf(d.y)}; }
                        else { const pg8::f32x2 t = x * (-1.4426950409f);
                            const pg8::f32x2 d = (pg8::f32x2){__builtin_amdgcn_exp2f(t.x), __builtin_amdgcn_exp2f(t.y)} + 1.0f;
                            v = (pg8::f32x2){__builtin_amdgcn_rcpf(d.x), __builtin_amdgcn_rcpf(d.y)}; }
                        if constexpr (ST) { s1 += v; s2 += v * v; }
                        pk[q] = pg8::cvt_pk_bf16(v.x, v.y); }
                    w[bj] = (pg8::u32x4){pk[0], pk[1], pk[2], pk[3]}; }
                if constexpr (ST) { float a = s1.x + s1.y, b = s2.x + s2.y; a += __shfl_xor(a, 16); b += __shfl_xor(b, 16); a += __shfl_xor(a, 32); b += __shfl_xor(b, 32);
                    if (fq == 0) *(pg8::f32x2*)(stp + (size_t)(ai * 128 + m * 16) * 32) = (pg8::f32x2){a, b}; }
                stage_store128(EPI_STG(), lane, fr, fq, w[0], w[1], base + (size_t)(ai * 128 + m * 16) * D, (size_t)8 * D); }
    }
    __device__ __forceinline__ void operator()(const pg8::f32x4 (&acc)[2][2][4][2], const pg8::Unit& u, int wr, int wc, int fr, int fq) const {
        const int pnz = F8 ? (u.pn < 4 ? u.pn : u.pn + 12) : u.pn + pn0; const int region = pnz >> 2; const int lane = fq * 16 + fr;
        bf16* base = Z + (size_t)region * ((size_t)NTOK * D) + (size_t)(u.pm * 256 + wr * 64 + (lane >> 3)) * D + (pnz & 3) * 256 + wc * 64 + 8 * (lane & 7);
        float* stp = sgst + ((size_t)(u.pm * 256 + wr * 64 + fr) * 16 + (pnz & 3) * 4 + wc) * 2;
        if (region == 0) body<0, false>(acc, base, lane, wr, wc, fr, fq, stp);
        else if (region < 3) body<1, false>(acc, base, lane, wr, wc, fr, fq, stp);
        else if (region == 3) body<1, true>(acc, base, lane, wr, wc, fr, fq, stp);
        else body<2, false>(acc, base, lane, wr, wc, fr, fq, stp);
    }
};
template <bool HAS_ADD> struct EpiMergeT {
    static constexpr bool PERM = true, BREMAP = true; static constexpr int NST = 16;
    const bf16* gate; const bf16* addend; bf16* out; LAS unsigned char* lds_epi;
    __device__ __forceinline__ void prefetch(const pg8::Unit&, int, int) const {}
    __device__ __forceinline__ void operator()(const pg8::f32x4 (&acc)[2][2][4][2], const pg8::Unit& u, int wr, int wc, int fr, int fq) const {
        const int lane = fq * 16 + fr; const int row0 = u.pm * 256 + wr * 64 + fr, col0 = u.pn * 256 + wc * 64 + 8 * fq;
        bf16* obase = out + (size_t)(u.pm * 256 + wr * 64 + (lane >> 3)) * D + u.pn * 256 + wc * 64 + 8 * (lane & 7);
        const size_t off0 = (size_t)row0 * D + col0;
        if constexpr (!HAS_ADD) {
            pg8::u32x4 g[2][4][2];
#pragma unroll
            for (int ai = 0; ai < 2; ++ai)
#pragma unroll
                for (int m = 0; m < 4; ++m)
#pragma unroll
                    for (int bj = 0; bj < 2; ++bj) g[ai][m][bj] = *(const pg8::u32x4*)(gate + off0 + (size_t)(ai * 128 + m * 16) * D + bj * 32);
#pragma unroll
            for (int ai = 0; ai < 2; ++ai)
#pragma unroll
                for (int m = 0; m < 4; ++m) { pg8::u32x4 w[2];
#pragma unroll
                    for (int bj = 0; bj < 2; ++bj) { const pg8::u32x4 gg = g[ai][m][bj]; const pg8::f32x4 a0 = acc[ai][bj][m][0], a1 = acc[ai][bj][m][1];
                        w[bj].x = pg8::cvt_pk_bf16(pg8::bf_lo(gg.x) * a0[0], pg8::bf_hi(gg.x) * a0[1]); w[bj].y = pg8::cvt_pk_bf16(pg8::bf_lo(gg.y) * a0[2], pg8::bf_hi(gg.y) * a0[3]);
                        w[bj].z = pg8::cvt_pk_bf16(pg8::bf_lo(gg.z) * a1[0], pg8::bf_hi(gg.z) * a1[1]); w[bj].w = pg8::cvt_pk_bf16(pg8::bf_lo(gg.w) * a1[2], pg8::bf_hi(gg.w) * a1[3]); }
                    stage_store128(EPI_STG(), lane, fr, fq, w[0], w[1], obase + (size_t)(ai * 128 + m * 16) * D, (size_t)8 * D); }
        } else {
#pragma unroll
            for (int ai = 0; ai < 2; ++ai) { pg8::u32x4 g[4][2], ad[4][2];
#pragma unroll
                for (int m = 0; m < 4; ++m)
#pragma unroll
                    for (int bj = 0; bj < 2; ++bj) { const size_t off = off0 + (size_t)(ai * 128 + m * 16) * D + bj * 32; g[m][bj] = *(const pg8::u32x4*)(gate + off); ad[m][bj] = *(const pg8::u32x4*)(addend + off); }
#pragma unroll
                for (int m = 0; m < 4; ++m) { pg8::u32x4 w[2];
#pragma unroll
                    for (int bj = 0; bj < 2; ++bj) { const pg8::u32x4 gg = g[m][bj], aa = ad[m][bj]; const pg8::f32x4 a0 = acc[ai][bj][m][0], a1 = acc[ai][bj][m][1];
                        w[bj].x = pg8::cvt_pk_bf16(pg8::bf_lo(aa.x) + pg8::bf_lo(gg.x) * a0[0], pg8::bf_hi(aa.x) + pg8::bf_hi(gg.x) * a0[1]);
                        w[bj].y = pg8::cvt_pk_bf16(pg8::bf_lo(aa.y) + pg8::bf_lo(gg.y) * a0[2], pg8::bf_hi(aa.y) + pg8::bf_hi(gg.y) * a0[3]);
                        w[bj].z = pg8::cvt_pk_bf16(pg8::bf_lo(aa.z) + pg8::bf_lo(gg.z) * a1[0], pg8::bf_hi(aa.z) + pg8::bf_hi(gg.z) * a1[1]);
                        w[bj].w = pg8::cvt_pk_bf16(pg8::bf_lo(aa.w) + pg8::bf_lo(gg.w) * a1[2], pg8::bf_hi(aa.w) + pg8::bf_hi(gg.w) * a1[3]); }
                    stage_store128(EPI_STG(), lane, fr, fq, w[0], w[1], obase + (size_t)(ai * 128 + m * 16) * D, (size_t)8 * D); } }
        }
    }
};
struct EpiResid {
    static constexpr bool PERM = true, BREMAP = true; static constexpr int NST = 16;
    const float* x; const float* gt; bf16* out; LAS unsigned char* lds_epi;
    __device__ __forceinline__ void prefetch(const pg8::Unit&, int, int) const {}
    __device__ __forceinline__ void operator()(const pg8::f32x4 (&acc)[2][2][4][2], const pg8::Unit& u, int wr, int wc, int fr, int fq) const {
        const int lane = fq * 16 + fr; const int row0 = u.pm * 256 + wr * 64 + fr, col0 = u.pn * 256 + wc * 64 + 8 * fq; const int b = u.pm >> 4;
        bf16* obase = out + (size_t)(u.pm * 256 + wr * 64 + (lane >> 3)) * D + u.pn * 256 + wc * 64 + 8 * (lane & 7);
        pg8::f32x4 gv[2][2];
#pragma unroll
        for (int bj = 0; bj < 2; ++bj)
#pragma unroll
            for (int n = 0; n < 2; ++n) gv[bj][n] = *(const pg8::f32x4*)(gt + (size_t)b * DIN + col0 + bj * 32 + n * 4);
#pragma unroll
        for (int ai = 0; ai < 2; ++ai) { pg8::f32x4 xv[4][2][2];
#pragma unroll
            for (int m = 0; m < 4; ++m)
#pragma unroll
                for (int bj = 0; bj < 2; ++bj) { const size_t off = (size_t)(row0 + ai * 128 + m * 16) * D + col0 + bj * 32; xv[m][bj][0] = *(const pg8::f32x4*)(x + off); xv[m][bj][1] = *(const pg8::f32x4*)(x + off + 4); }
#pragma unroll
            for (int m = 0; m < 4; ++m) { pg8::u32x4 w[2];
#pragma unroll
                for (int bj = 0; bj < 2; ++bj) {
                    const pg8::f32x4 y0 = xv[m][bj][0] + gv[bj][0] * acc[ai][bj][m][0], y1 = xv[m][bj][1] + gv[bj][1] * acc[ai][bj][m][1];
                    w[bj].x = pg8::cvt_pk_bf16(y0[0], y0[1]); w[bj].y = pg8::cvt_pk_bf16(y0[2], y0[3]); w[bj].z = pg8::cvt_pk_bf16(y1[0], y1[1]); w[bj].w = pg8::cvt_pk_bf16(y1[2], y1[3]); }
                stage_store128(EPI_STG(), lane, fr, fq, w[0], w[1], obase + (size_t)(ai * 128 + m * 16) * D, (size_t)8 * D); } }
    }
};
struct EpiGu {
    static constexpr bool PERM = true, BREMAP = false; static constexpr int NST = 4;
    unsigned char* act; const float* bgu; int tile0; LAS unsigned char* lds_epi;
    __device__ __forceinline__ void prefetch(const pg8::Unit& u, int wid, int lane) const {
        if (wid == 0) __builtin_amdgcn_global_load_lds((const unsigned*)(bgu + (size_t)u.e * 2048 + (lane >> 5) * 1024 + u.pn * 128 + (lane & 31) * 4), (LAS unsigned*)(lds_epi + 18432 + u.par * 3072), 16, 0, 0);
    }
    __device__ __forceinline__ void operator()(const pg8::f32x4 (&acc)[2][2][4][2], const pg8::Unit& u, int wr, int wc, int fr, int fq) const {
        const int lane = fq * 16 + fr;
        unsigned char* obase = act + (size_t)((u.pm - tile0) * 256 + wr * 64 + (lane >> 1)) * D + u.pn * 128 + wc * 32 + 16 * (lane & 1);
        const LAS float* bg = (const LAS float*)(lds_epi + 18432 + u.par * 3072) + wc * 32 + 8 * fq;
        const pg8::f32x4 bg0 = *(const LAS pg8::f32x4*)(bg), bg1 = *(const LAS pg8::f32x4*)(bg + 4), bu0 = *(const LAS pg8::f32x4*)(bg + 128), bu1 = *(const LAS pg8::f32x4*)(bg + 132);
        LAS unsigned char* stg = EPI_STG();
        constexpr float SA = 1.0f / (SC_H2 * SC_W);
#pragma unroll
        for (int ai = 0; ai < 2; ++ai)
#pragma unroll
            for (int mp = 0; mp < 2; ++mp) {
#pragma unroll
                for (int mq = 0; mq < 2; ++mq) { const int m = 2 * mp + mq; pg8::f32x2 o[4];
#pragma unroll
                    for (int p = 0; p < 4; ++p) { const int n = p >> 1, j = 2 * (p & 1);
                        const pg8::f32x4 ag = acc[ai][0][m][n], au = acc[ai][1][m][n]; const pg8::f32x4 vbg = n ? bg1 : bg0, vbu = n ? bu1 : bu0;
                        pg8::f32x2 g = (pg8::f32x2){ag[j], ag[j + 1]} * SA + (pg8::f32x2){vbg[j], vbg[j + 1]};
                        pg8::f32x2 up = (pg8::f32x2){au[j], au[j + 1]} * SA + (pg8::f32x2){vbu[j], vbu[j + 1]};
                        g = (pg8::f32x2){fminf(g.x, 7.0f), fminf(g.y, 7.0f)}; up = (pg8::f32x2){__builtin_amdgcn_fmed3f(up.x, -7.0f, 7.0f), __builtin_amdgcn_fmed3f(up.y, -7.0f, 7.0f)};
                        const pg8::f32x2 t = g * (-2.4554669596f);
                        const pg8::f32x2 d = (pg8::f32x2){__builtin_amdgcn_exp2f(t.x), __builtin_amdgcn_exp2f(t.y)} * (1.0f / SC_ACT) + (1.0f / SC_ACT);
                        const pg8::f32x2 gs = g * (pg8::f32x2){__builtin_amdgcn_rcpf(d.x), __builtin_amdgcn_rcpf(d.y)};
                        o[p] = up * gs + gs; }
                    int w0 = __builtin_amdgcn_cvt_pk_fp8_f32(o[0].x, o[0].y, 0, false); w0 = __builtin_amdgcn_cvt_pk_fp8_f32(o[1].x, o[1].y, w0, true);
                    int w1 = __builtin_amdgcn_cvt_pk_fp8_f32(o[2].x, o[2].y, 0, false); w1 = __builtin_amdgcn_cvt_pk_fp8_f32(o[3].x, o[3].y, w1, true);
                    *(LAS pg8::u32x2*)(stg + (16 * mq + fr) * 48 + fq * 8) = (pg8::u32x2){(unsigned)w0, (unsigned)w1}; }
                asm volatile("" ::: "memory");
                const pg8::u32x4 r = *(const LAS pg8::u32x4*)(stg + (lane >> 1) * 48 + (lane & 1) * 16);
                *(GAS pg8::u32x4*)(obase + (size_t)(ai * 128 + mp * 32) * D) = r; }
    }
};
struct EpiDown {
    static constexpr bool PERM = true, BREMAP = true; static constexpr int NST = 8;
    unsigned char* wsb; const float* bd; const float* slot_w; int tile0; LAS unsigned char* lds_epi;
    __device__ __forceinline__ void prefetch(const pg8::Unit& u, int wid, int lane) const {
        if (wid == 0) __builtin_amdgcn_global_load_lds((const unsigned*)(bd + (size_t)u.e * D + u.pn * 256 + lane * 4), (LAS unsigned*)(lds_epi + 18432 + u.par * 3072), 16, 0, 0);
        if (wid == 1) __builtin_amdgcn_global_load_lds((const unsigned*)(slot_w + (size_t)u.pm * 256 + lane * 4), (LAS unsigned*)(lds_epi + 18432 + u.par * 3072 + 1024), 16, 0, 0);
    }
    __device__ __forceinline__ void operator()(const pg8::f32x4 (&acc)[2][2][4][2], const pg8::Unit& u, int wr, int wc, int fr, int fq) const {
        const int lane = fq * 16 + fr;
        unsigned char* obase = wsb + y_tile_off(u.pm) + (size_t)(wr * 64 + (lane >> 2)) * D + u.pn * 256 + wc * 64 + 16 * (lane & 3);
        const LAS float* bp = (const LAS float*)(lds_epi + 18432 + u.par * 3072) + wc * 64 + 8 * fq;
        const LAS float* swp = (const LAS float*)(lds_epi + 18432 + u.par * 3072 + 1024) + wr * 64 + fr;
        LAS unsigned char* stg = EPI_STG();
        pg8::f32x4 bv[2][2];
#pragma unroll
        for (int bj = 0; bj < 2; ++bj) { bv[bj][0] = *(const LAS pg8::f32x4*)(bp + bj * 32); bv[bj][1] = *(const LAS pg8::f32x4*)(bp + bj * 32 + 4); }
#pragma unroll
        for (int ai = 0; ai < 2; ++ai)
#pragma unroll
            for (int m = 0; m < 4; ++m) { const float sw = swp[ai * 128 + m * 16] * SC_Y;
#pragma unroll
                for (int bj = 0; bj < 2; ++bj) { constexpr float SA = 1.0f / (SC_ACT * SC_W); const pg8::f32x4 v0 = (acc[ai][bj][m][0] * SA + bv[bj][0]) * sw, v1 = (acc[ai][bj][m][1] * SA + bv[bj][1]) * sw;
                    *(LAS pg8::u32x2*)(stg + fr * 80 + bj * 32 + fq * 8) = (pg8::u32x2){pk4_fp8(v0[0], v0[1], v0[2], v0[3]), pk4_fp8(v1[0], v1[1], v1[2], v1[3])}; }
                asm volatile("" ::: "memory");
                const pg8::u32x4 r = *(const LAS pg8::u32x4*)(stg + (lane >> 2) * 80 + (lane & 3) * 16);
                *(pg8::u32x4*)(obase + (size_t)(ai * 128 + m * 16) * D) = r; }
    }
};

__device__ __forceinline__ void transpose_item(const float* W, int ldn, int K, int k0, int n0, bf16* WT, int drow0, LAS float* scr, int lane) {
    float tv_[32];
#pragma unroll
    for (int i = 0; i < 32; ++i) tv_[i] = W[(size_t)(k0 + 2 * i + (lane >> 5)) * ldn + n0 + (lane & 31)];
#pragma unroll
    for (int i = 0; i < 32; ++i) scr[(2 * i + (lane >> 5)) * 33 + (lane & 31)] = tv_[i];
    LDS_WAIT(); asm volatile("" ::: "memory");
    const int c = lane & 7;
#pragma unroll
    for (int j = 0; j < 4; ++j) { const int n = (lane >> 3) + 8 * j; const LAS float* s = scr + (8 * c) * 33 + n;
        v4u o; o.x = pk2(s[0 * 33], s[1 * 33]); o.y = pk2(s[2 * 33], s[3 * 33]); o.z = pk2(s[4 * 33], s[5 * 33]); o.w = pk2(s[6 * 33], s[7 * 33]);
        *(GAS v4u*)(WT + (size_t)(drow0 + n) * K + k0 + 8 * c) = o; }
    LDS_WAIT(); asm volatile("" ::: "memory");
}

__device__ __forceinline__ void transpose_item_f8(const float* W, int ldn, int K, int k0, int n0, unsigned char* WT8, int drow0, LAS float* scr, int lane, float sc) {
    float tv_[32];
#pragma unroll
    for (int i = 0; i < 32; ++i) tv_[i] = W[(size_t)(k0 + 2 * i + (lane >> 5)) * ldn + n0 + (lane & 31)];
#pragma unroll
    for (int i = 0; i < 32; ++i) scr[(2 * i + (lane >> 5)) * 33 + (lane & 31)] = tv_[i] * sc;
    LDS_WAIT(); asm volatile("" ::: "memory");
    const int c = lane & 7;
#pragma unroll
    for (int j = 0; j < 4; ++j) { const int n = (lane >> 3) + 8 * j; const LAS float* s = scr + (8 * c) * 33 + n;
        v2u o; o.x = pk4_fp8(s[0 * 33], s[1 * 33], s[2 * 33], s[3 * 33]); o.y = pk4_fp8(s[4 * 33], s[5 * 33], s[6 * 33], s[7 * 33]);
        *(GAS v2u*)(WT8 + (size_t)(drow0 + n) * K + k0 + 8 * c) = o; }
    LDS_WAIT(); asm volatile("" ::: "memory");
}

struct Args {
    const float* in[28]; float* out; unsigned char* ws; int ph_lo, ph_hi, li, pad;
};
enum { I_X = 0, I_C, I_ADAW, I_ADAB, I_N1G, I_WIN, I_CONVW, I_CONVB, I_LWA, I_LBA, I_LWX, I_LBX, I_LAM, I_SGLNG, I_SGLNB, I_SGWS, I_SGBS, I_WBRR, I_WBRS, I_WOUT, I_N2G, I_WR, I_BR, I_WGU, I_BGU, I_WDN, I_BDN, I_FG };

__global__ void __launch_bounds__(NWAVES * 64, 2) mega_fwd(Args args) {
    extern __shared__ __attribute__((aligned(16))) unsigned char lds_raw[];
    LAS unsigned char* lds = (LAS unsigned char*)lds_raw;
    volatile LAS unsigned* MISC = (volatile LAS unsigned*)(lds + MISC_OFF);
    const int tid = threadIdx.x, lane = tid & 63, wave = __builtin_amdgcn_readfirstlane(tid >> 6);
    const int G = gridDim.x; const int bx = blockIdx.x;
    const int vcu = (G % 8 == 0) ? (bx % 8) * (G / 8) + bx / 8 : bx;
    unsigned char* ws = args.ws;
    gu32* ctl = (gu32*)(ws + WS_CTL);
    for (int u = tid; u < (LDS_BYTES - RING_BYTES) / 4; u += NWAVES * 64) ((LAS unsigned*)(lds + RING_BYTES))[u] = 0u;
    __syncthreads();
#if MK_PER_PHASE
    XcdBarrier bar; bar.bar = (unsigned*)(ctl + CW_BAR); bar.x = 0; bar.st = nullptr;
#define GRID_BAR() do { if (tid == 0) __hip_atomic_store(ctl + CW_TMO, 0xBADBA0u, RLX_AGENT); } while (0)
#else
    XcdBarrier bar = xcd_barrier_post((unsigned*)(ctl + CW_BAR), MISC + 8);
#define GRID_BAR() xcd_barrier(bar)
#endif
    const int lo = args.ph_lo, hi = args.ph_hi;
#define IN(k) (lo <= (k) && (k) < hi)
#ifdef DIAG_A_LO
#define STAMP(k) do { if (bx == 0 && threadIdx.x == 0) __hip_atomic_store(ctl + 64 + (k), (unsigned)__builtin_amdgcn_s_memrealtime(), RLX_AGENT); } while (0)
#else
#define STAMP(k) do { } while (0)
#endif
#define BOTH(k) (IN(k) && IN((k) + 1))

    const float* x_in = args.in[I_X];
    float* modv = (float*)(ws + WS_MOD);
    bf16* Hb = (bf16*)(ws + WS_H);
    bf16* X1b = (bf16*)(ws + WS_X1B);
    bf16* H2b = (bf16*)(ws + WS_H2);
    bf16* Zb = (bf16*)(ws + WS_Z);
    bf16* Z0 = Zb, *Z1 = Zb + (size_t)NTOK * D, *Z2 = Zb + 2 * (size_t)NTOK * D, *Z3 = Zb + 3 * (size_t)NTOK * D, *Z4 = Zb + 4 * (size_t)NTOK * D, *Z5 = Zb + 5 * (size_t)NTOK * D;
    int* top_idx = (int*)(ws + WS_TOPI); float* top_w = (float*)(ws + WS_TOPW); int* tok_slot = (int*)(ws + WS_TSLOT);
    int* slot_tok = (int*)(ws + WS_SLOTTOK); float* slot_w = (float*)(ws + WS_SLOTW); int* blkcnt = (int*)(ws + WS_BLKCNT); int* tile_exp = (int*)(ws + WS_TILEEXP);
    const int gw = vcu * NWAVES + wave, NGW = G * NWAVES;

    STAMP(0);
    if (IN(0)) {
        int tid_l = threadIdx.x; asm volatile("" : "+v"(tid_l)); const int tid = tid_l, lane = tid & 63;
        if (bx < 96) {
            LAS float* sc = (LAS float*)lds;
            LAS float* part = (LAS float*)(lds + 65536);
            const float* cin = args.in[I_C];
            { float cv[32];
#pragma unroll
                for (int q = 0; q < 32; ++q) cv[q] = cin[(q >> 1) * D + tid + 512 * (q & 1)];
#pragma unroll
                for (int q = 0; q < 32; ++q) { const float v = cv[q]; sc[(tid + 512 * (q & 1)) * 16 + (q >> 1)] = v * fast_sigmoid(v); } }
            __syncthreads();
            for (int task = bx; task < 96; task += G) {
                const int j0 = task * 64; const float* aw = args.in[I_ADAW];
                float a16[16];
#pragma unroll
                for (int b = 0; b < 16; ++b) a16[b] = 0.f;
                {
                    float wa[64], wb[64];
                    const float* pw = aw + (size_t)(wave * 128) * DIN + j0 + lane;
#define P0_LD(w_, k0_) do { _Pragma("unroll") for (int q = 0; q < 64; ++q) { w_[q] = *pw; pw += DIN; asm volatile("" : "+v"(pw)); } } while (0)
#define P0_FMA(w_, k0_) do { _Pragma("unroll") for (int q = 0; q < 64; ++q) { const int k = wave * 128 + (k0_) + q; const float wv = w_[q]; \
                        _Pragma("unroll") for (int b4 = 0; b4 < 4; ++b4) { const f32x4 s4 = *(const LAS f32x4*)(sc + k * 16 + b4 * 4); \
                            a16[b4 * 4 + 0] += s4[0] * wv; a16[b4 * 4 + 1] += s4[1] * wv; a16[b4 * 4 + 2] += s4[2] * wv; a16[b4 * 4 + 3] += s4[3] * wv; } } } while (0)
                    P0_LD(wa, 0); P0_LD(wb, 64);
                    P0_FMA(wa, 0); P0_FMA(wb, 64);
#undef P0_LD
#undef P0_FMA
                }
#pragma unroll
                for (int b = 0; b < 16; ++b) part[(wave * 16 + b) * 64 + lane] = a16[b];
                __syncthreads();
                for (int q = 0; q < 2; ++q) { const int o = tid + 512 * q, b = o >> 6, col = o & 63; float s = args.in[I_ADAB][j0 + col];
#pragma unroll
                    for (int w = 0; w < 8; ++w) s += part[(w * 16 + b) * 64 + col];
                    modv[b * DIN + j0 + col] = s; }
                __syncthreads();
            }
        }
        __syncthreads();
        {
            LAS float* scr = (LAS float*)(lds + wave * 16384);
            constexpr int I_IN = 16 * (DIN / 32), I_SQ = 16 * (D / 32);
            const int cw = (bx >= 96 ? (bx - 96) : 0) * NWAVES + wave, NCW = (G > 96 ? (G - 96) : 1) * NWAVES;
            for (int it = (bx >= 96 || G <= 96) ? cw : I_IN + 3 * I_SQ; it < I_IN + 3 * I_SQ; it += NCW) {
                int r = it;
                if (r < I_IN) { const int nblk = DIN / 32, kb = r / nblk, nb = r % nblk;
                    if (nb >= 32 && nb < 128) transpose_item(args.in[I_WIN], DIN, D, 64 * kb, 32 * nb, (bf16*)(ws + WS_WIN), 32 * nb, scr, lane);
                    else transpose_item_f8(args.in[I_WIN], DIN, D, 64 * kb, 32 * nb, ws + WS_WIN8, nb < 32 ? 32 * nb : 32 * (nb - 96), scr, lane, SC_W);
                    continue; } r -= I_IN;
                const int which = r / I_SQ; r -= which * I_SQ; const int nblk = D / 32, kb = r / nblk, nb = r % nblk;
                const float* W = which == 0 ? args.in[I_WBRR] : (which == 1 ? args.in[I_WBRS] : args.in[I_WOUT]);
                bf16* WT = (bf16*)(ws + (which == 0 ? WS_WBRR : (which == 1 ? WS_WBRS : WS_WOUT)));
                transpose_item(W, D, D, 64 * kb, 32 * nb, WT, 32 * nb, scr, lane);
            }
        }
        { bf16* sgw = (bf16*)(ws + WS_SGW);
            for (int idx = gw * 64 + lane; idx < 8 * 128 * 128; idx += NGW * 64) { const int t = (idx >> 7) & 127, s2 = idx & 127; sgw[idx] = (bf16)(s2 <= t ? f2bf(args.in[I_SGWS][idx]) : 0u); } }
        if (BOTH(0)) GRID_BAR();
    }

    STAMP(1);
    if (IN(1)) {
        int tid_l = threadIdx.x; asm volatile("" : "+v"(tid_l)); const int tid = tid_l, lane = tid & 63;
        for (int rb = gw; rb < NTOK / 32; rb += NGW) {
            const int b = (rb * 32) / SEQ;
            f32x4 A4[4], B4[4];
#pragma unroll
            for (int j = 0; j < 4; ++j) { const int c = 4 * lane + 256 * j; const f32x4 g = *(const f32x4*)(args.in[I_N1G] + c), s = *(const f32x4*)(modv + b * DIN + 1024 + c);
                A4[j] = g * (1.0f + s); B4[j] = *(const f32x4*)(modv + b * DIN + c); }
            f32x4 v0[4], v1[4], n0[4], n1[4];
#define P1_LOAD(r_, d_) do { const GAS f32x4* xr_ = (const GAS f32x4*)(x_in + ((size_t)rb * 32 + (r_)) * D) + lane; _Pragma("unroll") for (int j = 0; j < 4; ++j) d_[j] = xr_[64 * j]; } while (0)
#define P1_ROW(r_, d_) do { float ss = 0.f; _Pragma("unroll") for (int j = 0; j < 4; ++j) ss += (d_[j].x * d_[j].x + d_[j].y * d_[j].y) + (d_[j].z * d_[j].z + d_[j].w * d_[j].w); \
                const float rstd = 1.0f / sqrtf(wave_sum(ss) * (1.f / D) + EPS); GAS v2u* o8 = (GAS v2u*)(Hb + ((size_t)rb * 32 + (r_)) * D) + lane; \
                GAS unsigned* o4 = (GAS unsigned*)(ws + WS_H8 + ((size_t)rb * 32 + (r_)) * D) + lane; \
                _Pragma("unroll") for (int j = 0; j < 4; ++j) { const f32x4 y = d_[j] * rstd * A4[j] + B4[j]; v2u o; o.x = pg8::cvt_pk_bf16(y.x, y.y); o.y = pg8::cvt_pk_bf16(y.z, y.w); o8[64 * j] = o; \
                    o4[64 * j] = pk4_fp8(y.x * SC_H2, y.y * SC_H2, y.z * SC_H2, y.w * SC_H2); } } while (0)
            P1_LOAD(0, v0); P1_LOAD(1, v1);
            for (int r = 0; r < 32; r += 2) {
                const int rn = (r < 30) ? r + 2 : r;
                P1_LOAD(rn, n0); P1_LOAD(rn + 1, n1);
                P1_ROW(r, v0); P1_ROW(r + 1, v1);
#pragma unroll
                for (int j = 0; j < 4; ++j) { v0[j] = n0[j]; v1[j] = n1[j]; }
            }
#undef P1_LOAD
#undef P1_ROW
        }
        if (BOTH(1)) GRID_BAR();
    }

    STAMP(2);
    if (IN(2)) {
        { pg8::PlainOrder S; S.init(Hb, (const bf16*)(ws + WS_WIN) + (size_t)1024 * D, NTOK, 3072, G, bx);
            EpiZT<false> E{Zb, lds + AUX_OFF, 4, (float*)(ws + WS_SGST)};
            pg8::gemm_phase<EpiZT<false>, pg8::PlainOrder, true>(lds, S, E); }
        { pg8::PlainOrderT<true> S; S.init((const bf16*)(ws + WS_H8), (const bf16*)(ws + WS_WIN8), NTOK, 3072, G, bx);
            EpiZT<true> E{Zb, lds + AUX_OFF, 0, (float*)(ws + WS_SGST)};
            pg8::gemm_phase<EpiZT<true>, pg8::PlainOrderT<true>, true>(lds, S, E); }
        if (BOTH(2)) GRID_BAR();
    }

    STAMP(3);
    if (IN(3)) {
        int tid_l = threadIdx.x; asm volatile("" : "+v"(tid_l)); const int tid = tid_l, lane = tid & 63;
        typedef float f32x16 __attribute__((ext_vector_type(16)));
        for (int unit = bx; unit < BATCH * 16; unit += G) {
            const int b = unit >> 4, hd = unit & 15, ch0 = hd * 64;
            LAS unsigned char* xb0 = lds + wave * 10240;
            LAS unsigned char* gb = lds + 81920 + wave * 4096;
            LAS unsigned char* wfr = lds + 114688;
            LAS unsigned char* ifr = lds + AUX_OFF;
            LAS float* cwl = (LAS float*)(lds + AUX_OFF + 8192);
            typedef float f32x2l __attribute__((ext_vector_type(2)));
            LAS f32x2l* tot = (LAS f32x2l*)(lds + AUX_OFF + 8192 + 2048);
            __syncthreads();
            for (int q = 0; q < 2; ++q) { const int fid = tid + 512 * q; const int mat = fid >> 9, nt = (fid >> 8) & 1, ks = (fid >> 6) & 3, l = fid & 63, r = l & 31, h = l >> 5;
                const float* W = (mat ? args.in[I_LWX] : args.in[I_LWA]) + (size_t)hd * 4096 + (size_t)(16 * ks + 8 * h) * 64 + 32 * nt + r;
                v4u o; o.x = pk2(W[0], W[64]); o.y = pk2(W[128], W[192]); o.z = pk2(W[256], W[320]); o.w = pk2(W[384], W[448]);
                *(LAS v4u*)(wfr + fid * 16) = o; }
            { const int nt = tid >> 8, ks = (tid >> 6) & 3, l = tid & 63; const int pos = 32 * nt + (l & 31) - 16 * ks - 8 * (l >> 5);
                v4u o; o.x = (pos == 0 ? 0x3F80u : 0u) | (pos == 1 ? 0x3F800000u : 0u); o.y = (pos == 2 ? 0x3F80u : 0u) | (pos == 3 ? 0x3F800000u : 0u);
                o.z = (pos == 4 ? 0x3F80u : 0u) | (pos == 5 ? 0x3F800000u : 0u); o.w = (pos == 6 ? 0x3F80u : 0u) | (pos == 7 ? 0x3F800000u : 0u);
                *(LAS v4u*)(ifr + tid * 16) = o; }
            if (tid < 256) cwl[tid] = args.in[I_CONVW][(tid >> 6) * D + ch0 + (tid & 63)];
            else if (tid < 320) cwl[tid] = args.in[I_CONVB][ch0 + tid - 256];
            float cba[2], cbx[2], csp[2], carry[2];
#pragma unroll
            for (int nt = 0; nt < 2; ++nt) { const int c = ch0 + 32 * nt + (lane & 31); cba[nt] = -1.4426950409f * args.in[I_LBA][c]; cbx[nt] = -1.4426950409f * args.in[I_LBX][c];
                const float lm = args.in[I_LAM][c]; csp[nt] = 8.0f * log1pf(expf(-lm)) * 1.4426950409f; carry[nt] = 0.f; }
            __syncthreads();
            const int r31 = lane & 31, hh = lane >> 5;
            const int tokA = 16 * ((r31 >> 2) & 1) + 4 * (r31 >> 3) + (r31 & 3);
            const int dchunk = (lane & 7) ^ ((lane >> 3) & 7), drow = lane >> 3;
            const bf16* zx = Z0 + (size_t)b * SEQ * D + ch0 + 8 * dchunk;
            const bf16* zg = Z1 + (size_t)b * SEQ * D + ch0 + 8 * dchunk;
#define P3_DMA_X(Tw_, buf_) do { _Pragma("unroll") for (int n_ = 0; n_ < 5; ++n_) { int tk_ = (Tw_) - 8 + 8 * n_ + drow; tk_ = tk_ < 0 ? 0 : tk_; \
                __builtin_amdgcn_global_load_lds((const unsigned*)(zx + (size_t)tk_ * D), (LAS unsigned*)(xb0 + (buf_) * 5120 + n_ * 1024), 16, 0, 0); } } while (0)
#define P3_DMA_G(Tw_) do { _Pragma("unroll") for (int n_ = 0; n_ < 4; ++n_) { const int tk_ = (Tw_) + 8 * n_ + drow; \
                __builtin_amdgcn_global_load_lds((const unsigned*)(zg + (size_t)tk_ * D), (LAS unsigned*)(gb + n_ * 1024), 16, 0, 0); } } while (0)
            P3_DMA_X(wave * 32, 0);
            for (int st = 0; st < 16; ++st) {
                const int Tw = st * 256 + wave * 32, cur = st & 1;
                const int Tn = (st < 15) ? Tw + 256 : Tw;
                P3_DMA_G(Tw);
                P3_DMA_X(Tn, cur ^ 1);
                if (st == 0) asm volatile("s_waitcnt vmcnt(9)" ::: "memory");
                else asm volatile("s_waitcnt vmcnt(13)" ::: "memory");
                LAS unsigned char* xb = xb0 + cur * 5120;
                if (Tw == 0) { if (lane < 24) *(LAS v4u*)(xb + (5 + (lane >> 3)) * 128 + (lane & 7) * 16) = (v4u){0u, 0u, 0u, 0u}; }
                asm volatile("s_waitcnt lgkmcnt(0)" ::: "memory");
                pg8::bf16x8 xa[4];
#pragma unroll
                for (int ks = 0; ks < 4; ++ks) {
                    const f32x4 b0 = *(const LAS f32x4*)(cwl + 256 + 16 * ks + 8 * hh), b1 = *(const LAS f32x4*)(cwl + 256 + 16 * ks + 8 * hh + 4);
                    typedef float f32x2q __attribute__((ext_vector_type(2)));
                    f32x2q xq[4] = {(f32x2q){b0[0], b0[1]}, (f32x2q){b0[2], b0[3]}, (f32x2q){b1[0], b1[1]}, (f32x2q){b1[2], b1[3]}};
#pragma unroll
                    for (int k = 0; k < 4; ++k) { const int rho = tokA + 5 + k; const int pos = (2 * ks + hh) ^ (rho & 7);
                        const v4u w = *(const LAS v4u*)(xb + rho * 128 + pos * 16);
                        const f32x4 c0 = *(const LAS f32x4*)(cwl + k * 64 + 16 * ks + 8 * hh), c1 = *(const LAS f32x4*)(cwl + k * 64 + 16 * ks + 8 * hh + 4);
                        xq[0] += (f32x2q){c0[0], c0[1]} * (f32x2q){pg8::bf_lo(w.x), pg8::bf_hi(w.x)}; xq[1] += (f32x2q){c0[2], c0[3]} * (f32x2q){pg8::bf_lo(w.y), pg8::bf_hi(w.y)};
                        xq[2] += (f32x2q){c1[0], c1[1]} * (f32x2q){pg8::bf_lo(w.z), pg8::bf_hi(w.z)}; xq[3] += (f32x2q){c1[2], c1[3]} * (f32x2q){pg8::bf_lo(w.w), pg8::bf_hi(w.w)}; }
                    v4u p; p.x = pg8::cvt_pk_bf16(xq[0].x, xq[0].y); p.y = pg8::cvt_pk_bf16(xq[1].x, xq[1].y); p.z = pg8::cvt_pk_bf16(xq[2].x, xq[2].y); p.w = pg8::cvt_pk_bf16(xq[3].x, xq[3].y);
                    xa[ks] = __builtin_bit_cast(pg8::bf16x8, p); }
                float hl[2][16], cp[2][16];
#pragma unroll
                for (int nt = 0; nt < 2; ++nt) {
                    f32x16 ar, ai, ax;
#pragma unroll
                    for (int i = 0; i < 16; ++i) { ar[i] = 0.f; ai[i] = 0.f; ax[i] = 0.f; }
#pragma unroll
                    for (int ks = 0; ks < 4; ++ks) {
                        const pg8::bf16x8 fa = *(const LAS pg8::bf16x8*)(wfr + (((0 * 2 + nt) * 4 + ks) * 64 + lane) * 16);
                        const pg8::bf16x8 fx = *(const LAS pg8::bf16x8*)(wfr + (((1 * 2 + nt) * 4 + ks) * 64 + lane) * 16);
                        const pg8::bf16x8 fi = *(const LAS pg8::bf16x8*)(ifr + ((nt * 4 + ks) * 64 + lane) * 16);
                        ar = __builtin_amdgcn_mfma_f32_32x32x16_bf16(xa[ks], fa, ar, 0, 0, 0);
                        ai = __builtin_amdgcn_mfma_f32_32x32x16_bf16(xa[ks], fx, ai, 0, 0, 0);
                        ax = __builtin_amdgcn_mfma_f32_32x32x16_bf16(xa[ks], fi, ax, 0, 0, 0); }
                    float P = 1.f, H = 0.f;
#pragma unroll
                    for (int i = 0; i < 16; i += 2) {
                        typedef float f32x2p __attribute__((ext_vector_type(2)));
                        const f32x2p tr = (f32x2p){ar[i], ar[i + 1]} * (-1.4426950409f) + cba[nt], ti2 = (f32x2p){ai[i], ai[i + 1]} * (-1.4426950409f) + cbx[nt];
                        const f32x2p dr = (f32x2p){__builtin_amdgcn_exp2f(tr.x), __builtin_amdgcn_exp2f(tr.y)} + 1.0f, di = (f32x2p){__builtin_amdgcn_exp2f(ti2.x), __builtin_amdgcn_exp2f(ti2.y)} + 1.0f;
                        const f32x2p rg = (f32x2p){__builtin_amdgcn_rcpf(dr.x), __builtin_amdgcn_rcpf(dr.y)}, ig = (f32x2p){__builtin_amdgcn_rcpf(di.x), __builtin_amdgcn_rcpf(di.y)};
                        const f32x2p la = rg * (-csp[nt]);
                        const f32x2p av = (f32x2p){__builtin_amdgcn_exp2f(la.x), __builtin_amdgcn_exp2f(la.y)};
                        const f32x2p m2 = 1.0f - av * av;
                        const f32x2p uu = (f32x2p){__builtin_amdgcn_sqrtf(m2.x), __builtin_amdgcn_sqrtf(m2.y)} * ig * (f32x2p){ax[i], ax[i + 1]};
                        H = av.x * H + uu.x; P = P * av.x; hl[nt][i] = H; cp[nt][i] = P;
                        H = av.y * H + uu.y; P = P * av.y; hl[nt][i + 1] = H; cp[nt][i + 1] = P; }
                    const float Ho = __shfl_xor(H, 32), Po = __shfl_xor(P, 32);
                    const float H0 = hh ? Ho : 0.f, P0 = hh ? Po : 1.f;
#pragma unroll
                    for (int i = 0; i < 16; i += 2) { typedef float f32x2r __attribute__((ext_vector_type(2))); const f32x2r c2 = (f32x2r){cp[nt][i], cp[nt][i + 1]}; const f32x2r h2 = (f32x2r){hl[nt][i], hl[nt][i + 1]} + c2 * H0; const f32x2r c3 = c2 * P0;
                        hl[nt][i] = h2.x; hl[nt][i + 1] = h2.y; cp[nt][i] = c3.x; cp[nt][i + 1] = c3.y; }
                    if (hh) tot[(cur * 8 + wave) * 64 + 32 * nt + r31] = (f32x2l){cp[nt][15], hl[nt][15]};
                }
                asm volatile("s_waitcnt vmcnt(5)" ::: "memory");
                {
                    pg8::bf16x8 ga[4];
#pragma unroll
                    for (int ks = 0; ks < 4; ++ks) { const int pos = (2 * ks + hh) ^ (tokA & 7); ga[ks] = *(const LAS pg8::bf16x8*)(gb + tokA * 128 + pos * 16); }
#pragma unroll
                    for (int nt = 0; nt < 2; ++nt) { f32x16 ag;
#pragma unroll
                        for (int i = 0; i < 16; ++i) ag[i] = 0.f;
#pragma unroll
                        for (int ks = 0; ks < 4; ++ks) { const pg8::bf16x8 fi = *(const LAS pg8::bf16x8*)(ifr + ((nt * 4 + ks) * 64 + lane) * 16);
                            ag = __builtin_amdgcn_mfma_f32_32x32x16_bf16(ga[ks], fi, ag, 0, 0, 0); }
#pragma unroll
                        for (int i = 0; i < 16; i += 2) { typedef float f32x2r __attribute__((ext_vector_type(2))); const f32x2r g2 = (f32x2r){ag[i], ag[i + 1]}; const f32x2r h2 = (f32x2r){hl[nt][i], hl[nt][i + 1]} * g2, c2 = (f32x2r){cp[nt][i], cp[nt][i + 1]} * g2;
                            hl[nt][i] = h2.x; hl[nt][i + 1] = h2.y; cp[nt][i] = c2.x; cp[nt][i + 1] = c2.y; } }
                }
                asm volatile("s_waitcnt lgkmcnt(0)" ::: "memory"); __builtin_amdgcn_s_barrier(); asm volatile("" ::: "memory");
#pragma unroll
                for (int nt = 0; nt < 2; ++nt) { float s = carry[nt], cin = 0.f;
#pragma unroll
                    for (int w2 = 0; w2 < 8; ++w2) { const f32x2l ph = tot[(cur * 8 + w2) * 64 + 32 * nt + r31]; cin = (w2 == wave) ? s : cin; s = ph.x * s + ph.y; }
                    carry[nt] = s;
                    LAS bf16* yl = (LAS bf16*)(gb + (16 * hh) * 128 + (32 * nt + r31) * 2);
#pragma unroll
                    for (int i = 0; i < 16; i += 2) { typedef float f32x2r __attribute__((ext_vector_type(2))); const f32x2r y2 = (f32x2r){hl[nt][i], hl[nt][i + 1]} + (f32x2r){cp[nt][i], cp[nt][i + 1]} * cin;
                        const unsigned pk = pg8::cvt_pk_bf16(y2.x, y2.y); yl[i * 64] = (bf16)(pk & 0xffffu); yl[(i + 1) * 64] = (bf16)(pk >> 16); } }
                asm volatile("" ::: "memory");
                { bf16* yo = Z1 + ((size_t)b * SEQ + Tw + (lane >> 3)) * D + ch0 + 8 * (lane & 7);
                    v4u o[4];
#pragma unroll
                    for (int q = 0; q < 4; ++q) o[q] = *(const LAS v4u*)(gb + ((lane >> 3) + 8 * q) * 128 + (lane & 7) * 16);
#pragma unroll
                    for (int q = 0; q < 4; ++q) *(v4u*)(yo + (size_t)(8 * q) * D) = o[q]; }
                asm volatile("" ::: "memory");
            }
            asm volatile("s_waitcnt vmcnt(0)" ::: "memory");
#undef P3_DMA_X
#undef P3_DMA_G
        }
        __syncthreads();
        STAMP(15);
        LAS float* c_lng = (LAS float*)(lds + AUX_OFF + 1024); LAS float* c_lnb = (LAS float*)(lds + AUX_OFF + 5120); LAS float* c_bs = (LAS float*)(lds + AUX_OFF + 9216);
        for (int q = 0; q < 2; ++q) { c_lng[tid + 512 * q] = args.in[I_SGLNG][tid + 512 * q]; c_lnb[tid + 512 * q] = args.in[I_SGLNB][tid + 512 * q]; c_bs[tid + 512 * q] = args.in[I_SGBS][tid + 512 * q]; }
        for (int chunk = bx; chunk < NTOK / 128; chunk += G) {
            const size_t row0 = (size_t)chunk * 128;
            LAS float* st = (LAS float*)(lds + AUX_OFF);
            const bf16* sgw = (const bf16*)(ws + WS_SGW);
            __syncthreads();
            if (tid < 128) {
                const f32x4* pp = (const f32x4*)(ws + WS_SGST) + (row0 + tid) * 8; float sa = 0.f, sb = 0.f;
                f32x4 p4[8];
#pragma unroll
                for (int i = 0; i < 8; ++i) p4[i] = pp[i];
#pragma unroll
                for (int i = 0; i < 8; ++i) { sa += p4[i].x; sb += p4[i].y; sa += p4[i].z; sb += p4[i].w; }
                const float mean = sa * (1.f / D); const float var = fmaxf(sb * (1.f / D) - mean * mean, 0.f);
                st[2 * tid] = mean; st[2 * tid + 1] = 1.0f / sqrtf(var + EPS); }
            __syncthreads();
            const int r31 = lane & 31, hh = lane >> 5;
            const int ti = wave >> 1, ci0 = 2 * (wave & 1);
            const int bch = tid & 15, bs0 = tid >> 4;
#define SG_BUILD_LOAD(g_, wv_) do { _Pragma("unroll") for (int q = 0; q < 4; ++q) wv_[q] = *(const v4u*)(Z3 + (row0 + bs0 + 32 * q) * D + (g_) * 128 + 8 * bch); } while (0)
#define SG_BUILD_STORE(g_, wv_) do { const int col = (g_) * 128 + 8 * bch; LAS unsigned char* vt_ = lds + ((g_) & 1) * 32768; \
                const f32x4 g0 = *(const LAS f32x4*)(c_lng + col), g1 = *(const LAS f32x4*)(c_lng + col + 4), b0 = *(const LAS f32x4*)(c_lnb + col), b1 = *(const LAS f32x4*)(c_lnb + col + 4); \
                _Pragma("unroll") for (int q = 0; q < 4; ++q) { const int s = bs0 + 32 * q; const v4u w = wv_[q]; const float mean = st[2 * s], rstd = st[2 * s + 1]; v4u o; \
                    o.x = pg8::cvt_pk_bf16((pg8::bf_lo(w.x) - mean) * rstd * g0[0] + b0[0], (pg8::bf_hi(w.x) - mean) * rstd * g0[1] + b0[1]); \
                    o.y = pg8::cvt_pk_bf16((pg8::bf_lo(w.y) - mean) * rstd * g0[2] + b0[2], (pg8::bf_hi(w.y) - mean) * rstd * g0[3] + b0[3]); \
                    o.z = pg8::cvt_pk_bf16((pg8::bf_lo(w.z) - mean) * rstd * g1[0] + b1[0], (pg8::bf_hi(w.z) - mean) * rstd * g1[1] + b1[1]); \
                    o.w = pg8::cvt_pk_bf16((pg8::bf_lo(w.w) - mean) * rstd * g1[2] + b1[2], (pg8::bf_hi(w.w) - mean) * rstd * g1[3] + b1[3]); \
                    *(LAS v4u*)(vt_ + 256 * s + 16 * (bch ^ (((s & 3) << 2) | ((s >> 2) & 3)))) = o; } } while (0)
            const int nks = 2 * (ti + 1);
            pg8::bf16x8 afc[8];
#define SG_LOAD_A(g_, af_) do { const bf16* wrow_ = sgw + ((size_t)(g_) * 128 + 32 * ti + r31) * 128 + 8 * hh; _Pragma("unroll") for (int ks = 0; ks < 8; ++ks) if (ks < nks) af_[ks] = *(const pg8::bf16x8*)(wrow_ + 16 * ks); } while (0)
            v4u wvA[4], wvB[4], guvC[4], guvN[4];
#define SG_GU_LOAD(g_, gv_) do { const bf16* gb_ = Z2 + (row0 + 32 * ti + (lane >> 3)) * D + (g_) * 128 + 32 * ci0 + 8 * (lane & 7); _Pragma("unroll") for (int q = 0; q < 4; ++q) gv_[q] = *(const v4u*)(gb_ + (size_t)(8 * q) * D); } while (0)
            SG_BUILD_LOAD(0, wvA); SG_LOAD_A(0, afc); SG_GU_LOAD(0, guvC); SG_BUILD_STORE(0, wvA); SG_BUILD_LOAD(1, wvA);
            __syncthreads();
#pragma nounroll
            for (int g = 0; g < 8; ++g) {
                float bsv[16];
#pragma unroll
                for (int i = 0; i < 16; ++i) bsv[i] = c_bs[g * 128 + 32 * ti + 4 * hh + (i & 3) + 8 * (i >> 2)];
                bf16* obase = Z2 + (row0 + 32 * ti + (lane >> 3)) * D + g * 128 + 32 * ci0 + 8 * (lane & 7);
                const int gn = (g < 7) ? g + 1 : g, gn2 = (g < 6) ? g + 2 : 7;
                SG_GU_LOAD(gn, guvN); SG_BUILD_LOAD(gn2, wvB);
                f32x16 acc0, acc1;
#pragma unroll
                for (int i = 0; i < 16; ++i) { acc0[i] = 0.f; acc1[i] = 0.f; }
                const unsigned vbase = (unsigned)(size_t)(lds + (g & 1) * 32768);
                const unsigned blk = (lane >> 4) & 1, qq = (lane & 15) >> 2, pp = lane & 3;
#pragma unroll
                for (int kp = 0; kp < 4; ++kp) if (2 * kp < nks) {
                    unsigned ad[2][2][2];
#pragma unroll
                    for (int kk = 0; kk < 2; ++kk)
#pragma unroll
                        for (int cc = 0; cc < 2; ++cc)
#pragma unroll
                            for (int t2 = 0; t2 < 2; ++t2) { const unsigned row = 16 * (2 * kp + kk) + 8 * hh + 4 * t2 + qq, chn = 4 * (ci0 + cc) + 2 * blk + (pp >> 1);
                                ad[kk][cc][t2] = vbase + 256u * row + 16u * (chn ^ (((row & 3) << 2) | ((row >> 2) & 3))) + 8u * (pp & 1); }
                    v2u f[2][2][2];
                    asm volatile("ds_read_b64_tr_b16 %0, %8\n\tds_read_b64_tr_b16 %1, %9\n\tds_read_b64_tr_b16 %2, %10\n\tds_read_b64_tr_b16 %3, %11\n\t"
                                 "ds_read_b64_tr_b16 %4, %12\n\tds_read_b64_tr_b16 %5, %13\n\tds_read_b64_tr_b16 %6, %14\n\tds_read_b64_tr_b16 %7, %15\n\ts_waitcnt lgkmcnt(0)"
                                 : "=&v"(f[0][0][0]), "=&v"(f[0][0][1]), "=&v"(f[0][1][0]), "=&v"(f[0][1][1]), "=&v"(f[1][0][0]), "=&v"(f[1][0][1]), "=&v"(f[1][1][0]), "=&v"(f[1][1][1])
                                 : "v"(ad[0][0][0]), "v"(ad[0][0][1]), "v"(ad[0][1][0]), "v"(ad[0][1][1]), "v"(ad[1][0][0]), "v"(ad[1][0][1]), "v"(ad[1][1][0]), "v"(ad[1][1][1]) : "memory");
#pragma unroll
                    for (int kk = 0; kk < 2; ++kk) {
                        const v4u b0v = (v4u){f[kk][0][0].x, f[kk][0][0].y, f[kk][0][1].x, f[kk][0][1].y}, b1v = (v4u){f[kk][1][0].x, f[kk][1][0].y, f[kk][1][1].x, f[kk][1][1].y};
                        acc0 = __builtin_amdgcn_mfma_f32_32x32x16_bf16(afc[2 * kp + kk], __builtin_bit_cast(pg8::bf16x8, b0v), acc0, 0, 0, 0);
                        acc1 = __builtin_amdgcn_mfma_f32_32x32x16_bf16(afc[2 * kp + kk], __builtin_bit_cast(pg8::bf16x8, b1v), acc1, 0, 0, 0); }
                }
                { LAS float* ep = (LAS float*)(lds + 65536 + wave * 8192);
#pragma unroll
                    for (int i = 0; i < 16; ++i) { const int tl = (i & 3) + 8 * (i >> 2) + 4 * hh; ep[tl * 64 + r31] = acc0[i] + bsv[i]; ep[tl * 64 + 32 + r31] = acc1[i] + bsv[i]; }
#pragma unroll
                    for (int q = 0; q < 4; ++q) { const LAS f32x4* sp = (const LAS f32x4*)(ep + ((lane >> 3) + 8 * q) * 64 + 8 * (lane & 7)); const f32x4 s0 = sp[0], s1 = sp[1]; const v4u gu = guvC[q];
                        v4u o; o.x = pg8::cvt_pk_bf16(pg8::bf_lo(gu.x) * s0[0], pg8::bf_hi(gu.x) * s0[1]); o.y = pg8::cvt_pk_bf16(pg8::bf_lo(gu.y) * s0[2], pg8::bf_hi(gu.y) * s0[3]);
                        o.z = pg8::cvt_pk_bf16(pg8::bf_lo(gu.z) * s1[0], pg8::bf_hi(gu.z) * s1[1]); o.w = pg8::cvt_pk_bf16(pg8::bf_lo(gu.w) * s1[2], pg8::bf_hi(gu.w) * s1[3]);
                        *(v4u*)(obase + (size_t)(8 * q) * D) = o; } }
                SG_LOAD_A(gn, afc);
                if (g < 7) SG_BUILD_STORE(gn, wvA);
#pragma unroll
                for (int q = 0; q < 4; ++q) { wvA[q] = wvB[q]; guvC[q] = guvN[q]; }
                __syncthreads();
            }
#undef SG_BUILD_LOAD
#undef SG_GU_LOAD
#undef SG_BUILD_STORE
#undef SG_LOAD_A
        }
        if (BOTH(3)) GRID_BAR();
    }

    STAMP(4);
    if (IN(4)) {
        int tid_l = threadIdx.x; asm volatile("" : "+v"(tid_l)); const int tid = tid_l, lane = tid & 63;
        { const int panel = bx;
            { pg8::PanelOrder S{Z1, (const bf16*)(ws + WS_WBRR), panel, 4}; EpiMergeT<false> E{Z4, nullptr, Z0, lds + AUX_OFF}; pg8::gemm_phase<EpiMergeT<false>, pg8::PanelOrder, true>(lds, S, E); asm volatile("s_waitcnt vmcnt(0)" ::: "memory"); __syncthreads(); }
            { pg8::PanelOrder S{Z2, (const bf16*)(ws + WS_WBRS), panel, 4}; EpiMergeT<true> E{Z5, Z0, Z3, lds + AUX_OFF}; pg8::gemm_phase<EpiMergeT<true>, pg8::PanelOrder, true>(lds, S, E); asm volatile("s_waitcnt vmcnt(0)" ::: "memory"); __syncthreads(); }
            { pg8::PanelOrder S{Z3, (const bf16*)(ws + WS_WOUT), panel, 4}; EpiResid E{x_in, modv + 2048, X1b, lds + AUX_OFF}; pg8::gemm_phase<EpiResid, pg8::PanelOrder, true>(lds, S, E); asm volatile("s_waitcnt vmcnt(0)\n\tbuffer_inv sc0\n\ts_waitcnt vmcnt(0)" ::: "memory"); __syncthreads(); }
            typedef float f32x16 __attribute__((ext_vector_type(16)));
            LAS unsigned* hist = (LAS unsigned*)(lds + AUX_OFF);
            __syncthreads();
            for (int q = 0; q < 8; ++q) { const int fid = tid + 512 * q; const int ks = fid >> 6, l = fid & 63; const float* W = args.in[I_WR] + (size_t)(16 * ks + 8 * (l >> 5)) * NE + (l & 31);
                float w[8]; unsigned hi[8], lo[8];
#pragma unroll
                for (int j = 0; j < 8; ++j) { w[j] = W[j * NE]; hi[j] = f2bf(w[j]); lo[j] = f2bf(w[j] - __uint_as_float(hi[j] << 16)); }
                *(LAS v4u*)(lds + ((ks * 2 + 0) * 64 + l) * 16) = (v4u){hi[0] | (hi[1] << 16), hi[2] | (hi[3] << 16), hi[4] | (hi[5] << 16), hi[6] | (hi[7] << 16)};
                *(LAS v4u*)(lds + ((ks * 2 + 1) * 64 + l) * 16) = (v4u){lo[0] | (lo[1] << 16), lo[2] | (lo[3] << 16), lo[4] | (lo[5] << 16), lo[6] | (lo[7] << 16)}; }
            __syncthreads();
            { const int tb = panel;
                if (tid < 32) hist[tid] = 0u;
                const int m0 = tb * 256 + wave * 32; const int b = m0 / SEQ;
                {
                    f32x4 A4[2][2], B4[2][2];
#pragma unroll
                    for (int j = 0; j < 2; ++j)
#pragma unroll
                        for (int q = 0; q < 2; ++q) { const int c = 8 * lane + 512 * j + 4 * q; const f32x4 g = *(const f32x4*)(args.in[I_N2G] + c), s = *(const f32x4*)(modv + b * DIN + 4096 + c);
                            A4[j][q] = g * (1.0f + s); B4[j][q] = *(const f32x4*)(modv + b * DIN + 3072 + c); }
                    f32x4 v[2][2]; v4u xw[2], xn[2];
                    { const GAS v4u* xr = (const GAS v4u*)(X1b + (size_t)m0 * D) + lane; xw[0] = xr[0]; xw[1] = xr[64]; }
                    for (int r = 0; r < 32; ++r) {
                        const size_t m = (size_t)m0 + r;
                        { const size_t mn = (r < 31) ? m + 1 : m; const GAS v4u* xr = (const GAS v4u*)(X1b + mn * D) + lane; xn[0] = xr[0]; xn[1] = xr[64]; }
#pragma unroll
                        for (int j = 0; j < 2; ++j) { v[j][0] = (f32x4){pg8::bf_lo(xw[j].x), pg8::bf_hi(xw[j].x), pg8::bf_lo(xw[j].y), pg8::bf_hi(xw[j].y)}; v[j][1] = (f32x4){pg8::bf_lo(xw[j].z), pg8::bf_hi(xw[j].z), pg8::bf_lo(xw[j].w), pg8::bf_hi(xw[j].w)}; }
                        float ss = 0.f;
#pragma unroll
                        for (int j = 0; j < 2; ++j)
#pragma unroll
                            for (int q = 0; q < 2; ++q) ss += (v[j][q].x * v[j][q].x + v[j][q].y * v[j][q].y) + (v[j][q].z * v[j][q].z + v[j][q].w * v[j][q].w);
                        const float rstd = 1.0f / sqrtf(wave_sum(ss) * (1.f / D) + EPS);
                        GAS v4u* o16 = (GAS v4u*)(H2b + m * D) + lane; GAS v2u* o8 = (GAS v2u*)(ws + WS_H2Q + m * D) + lane;
#pragma unroll
                        for (int j = 0; j < 2; ++j) { const f32x4 y0 = v[j][0] * rstd * A4[j][0] + B4[j][0], y1 = v[j][1] * rstd * A4[j][1] + B4[j][1];
                            v4u o; o.x = pg8::cvt_pk_bf16(y0.x, y0.y); o.y = pg8::cvt_pk_bf16(y0.z, y0.w); o.z = pg8::cvt_pk_bf16(y1.x, y1.y); o.w = pg8::cvt_pk_bf16(y1.z, y1.w); o16[64 * j] = o;
                            o8[64 * j] = (v2u){pk4_fp8(y0.x * SC_H2, y0.y * SC_H2, y0.z * SC_H2, y0.w * SC_H2), pk4_fp8(y1.x * SC_H2, y1.y * SC_H2, y1.z * SC_H2, y1.w * SC_H2)}; }
                        xw[0] = xn[0]; xw[1] = xn[1];
                    }
                }
                asm volatile("s_waitcnt vmcnt(0)" ::: "memory");
                asm volatile("buffer_inv sc0\n\ts_waitcnt vmcnt(0)" ::: "memory");
                __syncthreads();
                {
                    const int n = lane & 31, h = lane >> 5;
                    f32x16 acc;
#pragma unroll
                    for (int i = 0; i < 16; ++i) acc[i] = 0.f;
                    const bf16* hrow = H2b + (size_t)(m0 + n) * D + 8 * h;
                    for (int ch = 0; ch < 2; ++ch) {
                        pg8::bf16x8 hb[32];
#pragma unroll
                        for (int i = 0; i < 32; ++i) hb[i] = *(const pg8::bf16x8*)(hrow + 16 * (ch * 32 + i));
#pragma unroll
                        for (int i = 0; i < 32; ++i) { const int ks = ch * 32 + i;
                            const pg8::bf16x8 wh = *(const LAS pg8::bf16x8*)(lds + ((ks * 2 + 0) * 64 + lane) * 16), wl = *(const LAS pg8::bf16x8*)(lds + ((ks * 2 + 1) * 64 + lane) * 16);
                            acc = __builtin_amdgcn_mfma_f32_32x32x16_bf16(wh, hb[i], acc, 0, 0, 0);
                            acc = __builtin_amdgcn_mfma_f32_32x32x16_bf16(wl, hb[i], acc, 0, 0, 0); }
                    }
                    float p[16];
#pragma unroll
                    for (int i = 0; i < 16; ++i) p[i] = acc[i] + args.in[I_BR][(i & 3) + 8 * (i >> 2) + 4 * h];
                    float cv[8]; int ce[8];
#pragma unroll
                    for (int k = 0; k < 4; ++k) { float best = -3.0e38f; int bi = 0;
#pragma unroll
                        for (int i = 0; i < 16; ++i) { if (p[i] > best) { best = p[i]; bi = i; } }
                        cv[k] = best; ce[k] = (bi & 3) + 8 * (bi >> 2) + 4 * h;
#pragma unroll
                        for (int i = 0; i < 16; ++i) p[i] = (i == bi) ? -3.0e38f : p[i]; }
#pragma unroll
                    for (int k = 0; k < 4; ++k) { cv[4 + k] = __shfl_xor(cv[k], 32); ce[4 + k] = __shfl_xor(ce[k], 32); }
                    float tv[4]; int ti[4];
#pragma unroll
                    for (int k = 0; k < 4; ++k) { float best = -3.0e38f; int be = 64, bs = 0;
#pragma unroll
                        for (int s = 0; s < 8; ++s) { const bool better = (cv[s] > best) || (cv[s] == best && ce[s] < be); if (better) { best = cv[s]; be = ce[s]; bs = s; } }
                        tv[k] = best; ti[k] = be;
#pragma unroll
                        for (int s = 0; s < 8; ++s) cv[s] = (s == bs) ? -3.0e38f : cv[s]; }
                    const float e1 = expf(tv[1] - tv[0]), e2 = expf(tv[2] - tv[0]), e3 = expf(tv[3] - tv[0]); const float inv = 1.0f / (1.0f + e1 + e2 + e3);
                    if (h == 0) { const size_t m = (size_t)m0 + n;
                        *(int4*)(top_idx + m * 4) = make_int4(ti[0], ti[1], ti[2], ti[3]);
                        *(float4*)(top_w + m * 4) = make_float4(inv, e1 * inv, e2 * inv, e3 * inv);
#pragma unroll
                        for (int k = 0; k < 4; ++k) atomicAdd((unsigned*)&hist[ti[k]], 1u); }
                }
                __syncthreads();
                if (tid < 32) blkcnt[tb * 32 + tid] = (int)hist[tid];
                __syncthreads();
            }
        }
        __syncthreads();
        {
            LAS float* scr = (LAS float*)(lds + wave * 16384);
            constexpr int I_GU = 16 * 64, I_DN = 16 * 32;
            for (int it = gw; it < NE * (I_GU + I_DN); it += NGW) {
                const int e = it / (I_GU + I_DN); int r = it % (I_GU + I_DN);
                if (r < I_GU) { const int kb = r / 64, nb = r % 64; const int n0 = 32 * nb; const int cidx = n0 & 1023; const int drow = (cidx >> 7) * 256 + (n0 >= 1024 ? 128 : 0) + (cidx & 127);
                    transpose_item_f8(args.in[I_WGU] + (size_t)e * D * 2048, 2048, D, 64 * kb, n0, ws + WS_WGU + (size_t)e * 2048 * D, drow, scr, lane, SC_W); }
                else { r -= I_GU; const int kb = r / 32, nb = r % 32;
                    transpose_item_f8(args.in[I_WDN] + (size_t)e * D * D, D, D, 64 * kb, 32 * nb, ws + WS_WDN + (size_t)e * D * D, 32 * nb, scr, lane, SC_W); }
            }
        }
        if (BOTH(4)) GRID_BAR();
    }
    STAMP(5); STAMP(6); STAMP(7);


    STAMP(8);
    if (IN(8)) {
        int tid_l = threadIdx.x; asm volatile("" : "+v"(tid_l)); const int tid = tid_l, lane = tid & 63;
        LAS int* sp_tot = (LAS int*)(lds);
        LAS int* sp_pre = sp_tot + 512;
        LAS int* tot = sp_pre + 512;
        LAS int* myoff = tot + 32;
        LAS int* pstart = myoff + 32;
        LAS unsigned* cursor = (LAS unsigned*)(pstart + 64);
        for (int tb = bx; tb < NTOK / 256; tb += G) {
            __syncthreads();
            { const int e = tid & 31, part = tid >> 5; int s_tot = 0, s_pre = 0;
                for (int B = part; B < 256; B += 16) { const int cn = blkcnt[B * 32 + e]; s_tot += cn; if (B < tb) s_pre += cn; }
                sp_tot[part * 32 + e] = s_tot; sp_pre[part * 32 + e] = s_pre; }
            __syncthreads();
            if (tid < 32) { int a = 0, p = 0; for (int q = 0; q < 16; ++q) { a += sp_tot[q * 32 + tid]; p += sp_pre[q * 32 + tid]; } tot[tid] = a; myoff[tid] = p; cursor[tid] = 0u; }
            __syncthreads();
            if (tid == 0) { int acc = 0; for (int e = 0; e < 32; ++e) { pstart[e] = acc; acc += ((tot[e] + 255) >> 8) << 8; } pstart[32] = acc; }
            __syncthreads();
            for (int q = 0; q < 2; ++q) { const int a = tid + 512 * q; const int tok = tb * 256 + (a >> 2);
                const int e = top_idx[(size_t)tok * 4 + (a & 3)]; const unsigned rnk = atomicAdd((unsigned*)&cursor[e], 1u);
                const int slot = pstart[e] + myoff[e] + (int)rnk;
                slot_tok[slot] = tok; slot_w[slot] = top_w[(size_t)tok * 4 + (a & 3)]; tok_slot[(size_t)tok * 4 + (a & 3)] = slot; }
            if (tb < 32) { const int e = tb; const int nt_e = (tot[e] + 255) >> 8;
                for (int r = tot[e] + tid; r < nt_e * 256; r += 512) { slot_tok[pstart[e] + r] = 0; slot_w[pstart[e] + r] = 0.f; }
                for (int i = tid; i < nt_e; i += 512) tile_exp[(pstart[e] >> 8) + i] = e;
                if (e == 0 && tid == 0) tile_exp[NTILE_MAX] = pstart[32] >> 8; }
        }
        if (BOTH(8)) GRID_BAR();
    }

    {
        const int pgu = 9, pdn = 10;
        if (IN(pgu) || IN(pdn)) {
            const int ntiles = tile_exp[NTILE_MAX];
            const int tile0 = 0;
            int ntc = ntiles; if (ntc < 0) ntc = 0; if (ntc > NTILE_MAX) ntc = NTILE_MAX;
            bf16* actb = (bf16*)(ws + WS_ACT);
            asm volatile("" : "+s"(actb));
            STAMP(pgu);
            if (IN(pgu)) {
                pg8::MoeOrder<true> S{(const bf16*)(ws + WS_H2Q), (const bf16*)(ws + WS_WGU), tile_exp, slot_tok, tile0, ntc, 8, G, vcu, lds + AUX_OFF + 18432};
                EpiGu E{(unsigned char*)actb, args.in[I_BGU], tile0, lds + AUX_OFF};
                pg8::gemm_phase<EpiGu, pg8::MoeOrder<true>, true>(lds, S, E);
                if (BOTH(pgu)) GRID_BAR();
            }
            STAMP(pdn);
            if (IN(pdn)) {
                pg8::MoeOrder<false> S{actb, (const bf16*)(ws + WS_WDN), tile_exp, slot_tok, tile0, ntc, 4, G, vcu, lds + AUX_OFF + 18432};
                EpiDown E{ws, args.in[I_BDN], slot_w, tile0, lds + AUX_OFF};
                pg8::gemm_phase<EpiDown, pg8::MoeOrder<false>, true>(lds, S, E);
                if (BOTH(pdn)) GRID_BAR();
            }
        }
    }

    STAMP(13);
    if (IN(13)) {
        int tid_l = threadIdx.x; asm volatile("" : "+v"(tid_l)); const int tid = tid_l, lane = tid & 63;
        for (int rb = gw; rb < NTOK / 32; rb += NGW) {
            const int b = (rb * 32) / SEQ;
            f32x4 G4[2][2], F4[2][2];
#pragma unroll
            for (int j = 0; j < 2; ++j)
#pragma unroll
                for (int q = 0; q < 2; ++q) { const int c = 8 * lane + 512 * j + 4 * q; G4[j][q] = *(const f32x4*)(modv + b * DIN + 5120 + c) * (1.0f / SC_Y); F4[j][q] = *(const f32x4*)(args.in[I_FG] + c); }
            const v2u sl = *(const v2u*)(tok_slot + (size_t)rb * 128 + 2 * lane);
            f32x4 v[2][2]; v4u xv[2], xn[2], xm[2]; v2u yv[4][2], yn[4][2], ym[4][2];
#define P13_LOAD(r_, xv_, yy_) do { const size_t m_ = (size_t)rb * 32 + (r_); const GAS v4u* xr_ = (const GAS v4u*)(X1b + m_ * D) + lane; \
                _Pragma("unroll") for (int j = 0; j < 2; ++j) xv_[j] = xr_[64 * j]; \
                _Pragma("unroll") for (int k = 0; k < 4; ++k) { const int slot_ = (int)__builtin_amdgcn_readlane((k & 1) ? sl.y : sl.x, 2 * (r_) + (k >> 1)); \
                    const GAS v2u* y8_ = (const GAS v2u*)(ws + y_tile_off(slot_ >> 8) + (size_t)(slot_ & 255) * D) + lane; \
                    _Pragma("unroll") for (int j = 0; j < 2; ++j) yy_[k][j] = y8_[64 * j]; } } while (0)
            P13_LOAD(0, xv, yv); P13_LOAD(1, xn, yn);
            for (int r = 0; r < 32; ++r) {
                const int rn = (r < 30) ? r + 2 : 31;
                P13_LOAD(rn, xm, ym);
                float ss = 0.f;
#pragma unroll
                for (int j = 0; j < 2; ++j) { typedef float f32x2c __attribute__((ext_vector_type(2)));
                    f32x2c s01 = (f32x2c){0.f, 0.f}, s23 = s01, s45 = s01, s67 = s01;
#pragma unroll
                    for (int k = 0; k < 4; ++k) { const v2u w = yv[k][j];
                        s01 += __builtin_amdgcn_cvt_pk_f32_fp8((int)w.x, false); s23 += __builtin_amdgcn_cvt_pk_f32_fp8((int)w.x, true);
                        s45 += __builtin_amdgcn_cvt_pk_f32_fp8((int)w.y, false); s67 += __builtin_amdgcn_cvt_pk_f32_fp8((int)w.y, true); }
                    v[j][0] = (f32x4){pg8::bf_lo(xv[j].x), pg8::bf_hi(xv[j].x), pg8::bf_lo(xv[j].y), pg8::bf_hi(xv[j].y)} + G4[j][0] * (f32x4){s01.x, s01.y, s23.x, s23.y};
                    v[j][1] = (f32x4){pg8::bf_lo(xv[j].z), pg8::bf_hi(xv[j].z), pg8::bf_lo(xv[j].w), pg8::bf_hi(xv[j].w)} + G4[j][1] * (f32x4){s45.x, s45.y, s67.x, s67.y};
#pragma unroll
                    for (int q = 0; q < 2; ++q) ss += (v[j][q].x * v[j][q].x + v[j][q].y * v[j][q].y) + (v[j][q].z * v[j][q].z + v[j][q].w * v[j][q].w); }
                const float rstd = 1.0f / sqrtf(wave_sum(ss) * (1.f / D) + EPS);
                GAS f32x4* xo = (GAS f32x4*)(args.out + ((size_t)rb * 32 + r) * D) + 2 * lane;
#pragma unroll
                for (int j = 0; j < 2; ++j)
#pragma unroll
                    for (int q = 0; q < 2; ++q) xo[128 * j + q] = v[j][q] * rstd * F4[j][q];
#pragma unroll
                for (int j = 0; j < 2; ++j) { xv[j] = xn[j]; xn[j] = xm[j];
#pragma unroll
                    for (int k = 0; k < 4; ++k) { yv[k][j] = yn[k][j]; yn[k][j] = ym[k][j]; } }
            }
#undef P13_LOAD
        }
    }
#ifdef DIAG_A_LO
    {
        GRID_BAR(); STAMP(14); GRID_BAR();
        const float us_a = (float)(__hip_atomic_load(ctl + 64 + DIAG_A_HI, RLX_AGENT) - __hip_atomic_load(ctl + 64 + DIAG_A_LO, RLX_AGENT)) * 0.01f;
        const float us_b = (float)(__hip_atomic_load(ctl + 64 + DIAG_B_HI, RLX_AGENT) - __hip_atomic_load(ctl + 64 + DIAG_B_LO, RLX_AGENT)) * 0.01f;
        const float sc = 1.0f + 1e-4f * (10.0f * rintf(us_a * 0.1f)); const float us_bq = 10.0f * rintf(us_b * 0.1f);
        for (size_t i = (size_t)bx * 512 + threadIdx.x; i < (size_t)NTOK * D; i += (size_t)G * 512) { float v = args.out[i] * sc; if (i == 0) v += us_bq * 0.25f; args.out[i] = v; }
    }
#endif
#undef IN
#undef BOTH
}

extern "C" void kernel_launch(void* const* d_in, const int* in_sizes, int n_in, void* d_out, int out_size, void* d_ws, size_t ws_size, hipStream_t stream) {
    static int grid = 0;
    if (grid == 0) {
        if (n_in != 28 || out_size != NTOK * D || ws_size < WS_TOTAL) { fprintf(stderr, "kernel_launch: unexpected shapes (n_in %d out %d ws %zu)\n", n_in, out_size, ws_size); grid = -1; return; }
        int dev = 0, cus = 0, per_cu = 0;
        if (hipGetDevice(&dev) != hipSuccess || hipDeviceGetAttribute(&cus, hipDeviceAttributeMultiprocessorCount, dev) != hipSuccess) { grid = -1; return; }
        if (hipFuncSetAttribute((const void*)mega_fwd, hipFuncAttributeMaxDynamicSharedMemorySize, LDS_BYTES) != hipSuccess) { fprintf(stderr, "kernel_launch: hipFuncSetAttribute failed\n"); grid = -1; return; }
        if (hipOccupancyMaxActiveBlocksPerMultiprocessor(&per_cu, (const void*)mega_fwd, NWAVES * 64, LDS_BYTES) != hipSuccess || per_cu < 1)
            fprintf(stderr, "kernel_launch: occupancy query reports %d workgroups per CU\n", per_cu);
        (void)hipGetLastError();
        grid = cus;
        if (grid != NTOK / 256) { fprintf(stderr, "kernel_launch: built for %d CUs, device has %d\n", NTOK / 256, cus); grid = -1; return; }
    }
    if (grid < 0) return;
    (void)hipMemsetAsync((char*)d_ws + WS_CTL, 0, CTL_ZERO_BYTES, stream);
    Args a{};
    for (int i = 0; i < 28; ++i) a.in[i] = (const float*)d_in[i];
    a.out = (float*)d_out; a.ws = (unsigned char*)d_ws;
#if MK_PER_PHASE
    for (int p = 0; p < N_PHASES; ++p) { a.ph_lo = p; a.ph_hi = p + 1; a.li = p; a.pad = 0; hipLaunchKernelGGL(mega_fwd, dim3(grid), dim3(NWAVES * 64), LDS_BYTES, stream, a); }
#else
    a.ph_lo = 0; a.ph_hi = N_PHASES; a.li = 0; a.pad = 0;
    hipLaunchKernelGGL(mega_fwd, dim3(grid), dim3(NWAVES * 64), LDS_BYTES, stream, a);
#endif
}
```

```cpp
#include <hip/hip_runtime.h>
#include <cstdio>
#include <cstdint>

#ifndef MK_PER_PHASE
#define MK_PER_PHASE 0
#endif

namespace pg8 {
#define PG8_LAS __attribute__((address_space(3)))
typedef unsigned short bf16_t;
typedef short bf16x8 __attribute__((ext_vector_type(8)));
typedef float f32x4 __attribute__((ext_vector_type(4)));
typedef float f32x2 __attribute__((ext_vector_type(2)));
typedef unsigned u32x4 __attribute__((ext_vector_type(4)));
typedef unsigned u32x2 __attribute__((ext_vector_type(2)));
constexpr int BM = 256, BK = 64, HALF = 128, HTB = HALF * BK * 2, STAGE_BYTES = 8 * HTB, NXCD = 8, WGM = 8, KD = 1024;

__host__ __device__ __forceinline__ int lds_byte(int r, int c) { const int st = (r >> 4) * 2 + (c >> 5), rr = r & 15, cc = c & 31, ob = rr * 64 + cc * 2; return st * 1024 + (ob ^ (((ob >> 9) & 1) << 5)); }
__host__ __device__ __forceinline__ void stage_rc(int b, int& R, int& C) { const int st = b / 1024, sb = b % 1024, swz = sb ^ (((sb >> 9) & 1) << 5); R = (st >> 1) * 16 + swz / 64; C = (st & 1) * 32 + (swz % 64) / 2; }
__host__ __device__ __forceinline__ int perm32(int rho) { const int n = rho >> 4, i = rho & 15; return 8 * (i >> 2) + 4 * n + (i & 3); }

struct Unit { int pm, pn, e, par; };

template <bool FP8_> struct PlainOrderT {
    static constexpr bool GATHER = false, FP8 = FP8_; static constexpr int KB = FP8_ ? KD : KD * 2;
    const bf16_t* A; const bf16_t* Bt; int nM, nN, nwg, G, c;
    __device__ void init(const bf16_t* A_, const bf16_t* Bt_, int M, int N, int G_, int c_) { A = A_; Bt = Bt_; nM = M / BM; nN = N / BM; nwg = nM * nN; G = G_; c = c_; }
    __device__ __forceinline__ bool next(int i, Unit& u) const {
        const long L = (long)i * G + c; if (L >= nwg) return false;
        int wgid = (int)L; { const int q = nwg / NXCD, r = nwg % NXCD, xcd = wgid % NXCD, off = wgid / NXCD; wgid = (xcd < r ? xcd * (q + 1) : r * (q + 1) + (xcd - r) * q) + off; }
        const int nig = WGM * nN, gid = wgid / nig, fm = gid * WGM, gsz = (nM - fm) < WGM ? (nM - fm) : WGM;
        u.pm = fm + ((wgid % nig) % gsz); u.pn = (wgid % nig) / gsz; u.e = 0; return true;
    }
    __device__ __forceinline__ const char* a_base(const Unit& u) const { return (const char*)A + (size_t)u.pm * ((size_t)BM * KB); }
    __device__ __forceinline__ const char* b_base(const Unit& u) const { return (const char*)Bt + (size_t)u.pn * ((size_t)BM * KB); }
    __device__ __forceinline__ void load_rows(const Unit&, unsigned (&)[2][2]) const {}
    __device__ __forceinline__ void load_rows_lds(const Unit&, unsigned (&)[2][2]) const {}
    __device__ __forceinline__ void prefetch_rows(const Unit&, int, int) const {}
    __device__ __forceinline__ void init_lds(int) const {}
};
typedef PlainOrderT<false> PlainOrder;
struct PanelOrder {
    static constexpr bool GATHER = false, FP8 = false; static constexpr int KB = KD * 2;
    const bf16_t* A; const bf16_t* Bt; int panel, nN;
    __device__ __forceinline__ bool next(int i, Unit& u) const { if (i >= nN) return false; u.pm = panel; u.pn = (i + panel) & (nN - 1); u.e = 0; return true; }
    __device__ __forceinline__ const char* a_base(const Unit& u) const { return (const char*)A + (size_t)u.pm * ((size_t)BM * KD * 2); }
    __device__ __forceinline__ const char* b_base(const Unit& u) const { return (const char*)Bt + (size_t)u.pn * ((size_t)BM * KD * 2); }
    __device__ __forceinline__ void load_rows(const Unit&, unsigned (&)[2][2]) const {}
    __device__ __forceinline__ void load_rows_lds(const Unit&, unsigned (&)[2][2]) const {}
    __device__ __forceinline__ void prefetch_rows(const Unit&, int, int) const {}
    __device__ __forceinline__ void init_lds(int) const {}
};
template <bool GATHER_> struct MoeOrder {
    static constexpr bool GATHER = GATHER_, FP8 = true; static constexpr int KB = KD;
    const bf16_t* A; const bf16_t* Bt; const int* tile_exp; const int* slot_tok; int tile0, ntile, nN, G, c; PG8_LAS unsigned char* aux;
    __device__ __forceinline__ bool next(int i, Unit& u) const {
        const int L = i * G + c; if (L >= ntile * nN) return false;
        const int sh = (nN == 8) ? 3 : 2; const int pl = L >> sh; u.pn = L & (nN - 1); u.pm = tile0 + pl; u.e = ((const PG8_LAS int*)(aux + 6144))[u.pm]; return true;
    }
    __device__ __forceinline__ const char* a_base(const Unit& u) const { return GATHER ? (const char*)A : (const char*)A + (size_t)(u.pm - tile0) * ((size_t)BM * KB); }
    __device__ __forceinline__ const char* b_base(const Unit& u) const { return (const char*)Bt + ((size_t)u.e * nN + u.pn) * ((size_t)BM * KB); }
    __device__ __forceinline__ void load_rows(const Unit& u, unsigned (&out)[2][2]) const {
#pragma unroll
        for (int i = 0; i < 2; ++i) { int R, C; stage_rc((int)threadIdx.x * 16 + i * 8192, R, C);
#pragma unroll
            for (int h = 0; h < 2; ++h) out[h][i] = (unsigned)slot_tok[u.pm * BM + h * HALF + R] * (unsigned)KB + (unsigned)C * 2u; }
    }
    __device__ __forceinline__ void load_rows_lds(const Unit& u, unsigned (&out)[2][2]) const {
        const PG8_LAS int* idx = (const PG8_LAS int*)(aux + u.par * 3072 + 2048);
#pragma unroll
        for (int i = 0; i < 2; ++i) { int R, C; stage_rc((int)threadIdx.x * 16 + i * 8192, R, C);
#pragma unroll
            for (int h = 0; h < 2; ++h) out[h][i] = (unsigned)idx[h * HALF + R] * (unsigned)KB + (unsigned)C * 2u; }
    }
    __device__ __forceinline__ void init_lds(int tid) const { for (int i = tid; i < 1056; i += 512) ((PG8_LAS int*)(aux + 6144))[i] = tile_exp[i]; __syncthreads(); }
    __device__ __forceinline__ void prefetch_rows(const Unit& nx, int wid, int lane) const {
        if (GATHER && wid == 2) __builtin_amdgcn_global_load_lds((const unsigned*)(slot_tok + nx.pm * BM + lane * 4), (PG8_LAS unsigned*)(aux + nx.par * 3072 + 2048), 16, 0, 0);
    }
};

typedef __bf16 bf16x2_n __attribute__((ext_vector_type(2)));
__device__ __forceinline__ unsigned cvt_pk_bf16(float lo, float hi) { const f32x2 v = {lo, hi}; const bf16x2_n r = __builtin_convertvector(v, bf16x2_n); return __builtin_bit_cast(unsigned, r); }
__device__ __forceinline__ float bf_lo(unsigned w) { return __uint_as_float(w << 16); }
__device__ __forceinline__ float bf_hi(unsigned w) { return __uint_as_float(w & 0xffff0000u); }

template <class Epi, class Sched, bool ALIGN_EPI>
__device__ __forceinline__ void gemm_phase(PG8_LAS unsigned char* lds, const Sched& S, const Epi& E) {
    static_assert(ALIGN_EPI, "the store-tolerant waits below assume aligned epilogues");
    int tid_ = threadIdx.x; asm volatile("" : "+v"(tid_));
    const int tid = tid_, wid = __builtin_amdgcn_readfirstlane(tid >> 6), lane = tid & 63, wr = wid >> 2, wc = wid & 3, fr = lane & 15, fq = lane >> 4;
    constexpr int KB = Sched::KB, nt = KB / (BK * 2);
    unsigned voffA[2], voffB[2];
#pragma unroll
    for (int i = 0; i < 2; ++i) { int R, C; stage_rc(tid * 16 + i * 8192, R, C); const int Rb = Epi::BREMAP ? (64 * (R >> 5) + perm32(R & 31)) : ((R & ~31) + perm32(R & 31));
        voffA[i] = (unsigned)(R * KB + C * 2); voffB[i] = (unsigned)(Rb * KB + C * 2); }
    constexpr size_t kstep = (size_t)(BK * 2);
    constexpr size_t hstep = (size_t)HALF * KB;
    constexpr size_t hstepB = Epi::BREMAP ? (size_t)32 * KB : hstep;
    const unsigned ldsw = (unsigned)wid * 1024u;
    const int aoff = lds_byte(wr * 64 + fr, fq * 8), boff = lds_byte(wc * 32 + fr, fq * 8);
#define PG8_SA(b, h) (((b) * 2 + (h)) * HTB)
#define PG8_SB(b, h) ((4 + (b) * 2 + (h)) * HTB)
#define PG8_STAGE(bufoff, gbase, voff) do { _Pragma("unroll") for (int _i = 0; _i < 2; ++_i) \
        __builtin_amdgcn_global_load_lds((const unsigned*)((const char*)(gbase) + (voff)[_i]), (PG8_LAS unsigned*)(lds + (bufoff) + ldsw + _i * 8192), 16, 0, 0); } while (0)
#define PG8_STAGE_B(b, h, base) PG8_STAGE(PG8_SB(b, h), (base) + (h) * hstepB, voffB)
#define PG8_STAGE_A(b, h, base, GO) do { if constexpr (Sched::GATHER) { PG8_STAGE(PG8_SA(b, h), (base), GO[h]); } else { PG8_STAGE(PG8_SA(b, h), (base) + (h) * hstep, voffA); } } while (0)
#define PG8_LDA(dst, b, h) do { _Pragma("unroll") for (int m = 0; m < 4; ++m) _Pragma("unroll") for (int k = 0; k < 2; ++k) dst[m][k] = *(const PG8_LAS bf16x8*)(lds + PG8_SA(b, h) + aoff + m * 2048 + k * 1024); } while (0)
#define PG8_LDB(dst, b, h) do { _Pragma("unroll") for (int n = 0; n < 2; ++n) _Pragma("unroll") for (int k = 0; k < 2; ++k) dst[n][k] = *(const PG8_LAS bf16x8*)(lds + PG8_SB(b, h) + boff + n * 2048 + k * 1024); } while (0)
#define PG8_MMA(ai, bj, At, Bt) do { __builtin_amdgcn_s_setprio(1); _Pragma("unroll") for (int m = 0; m < 4; ++m) _Pragma("unroll") for (int n = 0; n < 2; ++n) { \
        if constexpr (Sched::FP8) { typedef int v4i_ __attribute__((ext_vector_type(4))); \
            acc[ai][bj][m][n] = __builtin_amdgcn_mfma_scale_f32_16x16x128_f8f6f4(__builtin_shufflevector(__builtin_bit_cast(v4i_, Bt[n][0]), __builtin_bit_cast(v4i_, Bt[n][1]), 0, 1, 2, 3, 4, 5, 6, 7), \
                __builtin_shufflevector(__builtin_bit_cast(v4i_, At[m][0]), __builtin_bit_cast(v4i_, At[m][1]), 0, 1, 2, 3, 4, 5, 6, 7), acc[ai][bj][m][n], 0, 0, 0, 0, 0, 0); } \
        else { _Pragma("unroll") for (int k = 0; k < 2; ++k) acc[ai][bj][m][n] = __builtin_amdgcn_mfma_f32_16x16x32_bf16(Bt[n][k], At[m][k], acc[ai][bj][m][n], 0, 0, 0); } } \
        __builtin_amdgcn_s_setprio(0); } while (0)
#define PG8_WAIT_V(n) asm volatile("s_waitcnt vmcnt(" #n ")" ::: "memory")
#define PG8_WAIT_L(n) asm volatile("s_waitcnt lgkmcnt(" #n ")" ::: "memory")
#define PG8_BAR __builtin_amdgcn_s_barrier()
#define PG8_SCHED __builtin_amdgcn_sched_barrier(0)
    Unit cur, nxt; int ui = 0;
    S.init_lds(tid);
    if (!S.next(0, cur)) return;
    f32x4 acc[2][2][4][2];
#pragma unroll
    for (int a = 0; a < 2; ++a)
#pragma unroll
        for (int b = 0; b < 2; ++b)
#pragma unroll
            for (int m = 0; m < 4; ++m)
#pragma unroll
                for (int n = 0; n < 2; ++n) acc[a][b][m][n] = (f32x4){0.f, 0.f, 0.f, 0.f};
    bf16x8 At[4][2], B0[2][2], B1[2][2];
    unsigned gA[2][2] = {{0u, 0u}, {0u, 0u}};
    const char* cA = S.a_base(cur); const char* cB = S.b_base(cur);
    if constexpr (Sched::GATHER) S.load_rows(cur, gA);
    PG8_STAGE_B(0, 0, cB); PG8_STAGE_B(0, 1, cB); PG8_STAGE_A(0, 0, cA, gA); PG8_STAGE_A(0, 1, cA, gA);
    if (wr == 1) PG8_BAR;
    PG8_WAIT_V(2); PG8_BAR;
    PG8_STAGE_B(1, 0, cB + kstep); PG8_STAGE_A(1, 0, cA + kstep, gA); PG8_STAGE_B(1, 1, cB + kstep);
    PG8_WAIT_V(6); PG8_BAR;
    cur.par = 0;
    for (;;) {
        const bool has_next = S.next(ui + 1, nxt); nxt.par = (ui + 1) & 1;
        if (has_next) S.prefetch_rows(nxt, wid, lane);
        E.prefetch(cur, wid, lane);
        const char* nA = has_next ? S.a_base(nxt) : cA; const char* nB = has_next ? S.b_base(nxt) : cB;
#define PG8_TRIP(t, last, WV, SKIP11) do { \
            const char* a1 = cA + (size_t)((t) + 1) * kstep; \
            const char* a2 = (last) ? nA : cA + (size_t)((t) + 2) * kstep; const char* b2 = (last) ? nB : cB + (size_t)((t) + 2) * kstep; \
            const char* a3 = a2 + kstep; const char* b3 = b2 + kstep; \
            PG8_LDB(B0, 0, 0); PG8_LDB(B1, 0, 1); PG8_SCHED; PG8_LDA(At, 0, 0); if (!(SKIP11)) PG8_STAGE_A(1, 1, a1, gA); \
            if constexpr (Sched::GATHER) { if ((last) && has_next) S.load_rows_lds(nxt, gA); } \
            WV; PG8_WAIT_L(0); PG8_BAR; PG8_MMA(0, 0, At, B0); PG8_MMA(0, 1, At, B1); PG8_BAR; PG8_SCHED; \
            PG8_LDA(At, 0, 1); PG8_STAGE_B(0, 0, b2); PG8_STAGE_B(0, 1, b2); PG8_STAGE_A(0, 0, a2, gA); \
            WV; PG8_WAIT_L(0); PG8_BAR; PG8_MMA(1, 0, At, B0); PG8_MMA(1, 1, At, B1); PG8_BAR; PG8_SCHED; \
            PG8_LDB(B0, 1, 0); PG8_LDB(B1, 1, 1); PG8_SCHED; PG8_LDA(At, 1, 0); PG8_STAGE_A(0, 1, a2, gA); \
            WV; PG8_WAIT_L(0); PG8_BAR; PG8_MMA(0, 0, At, B0); PG8_MMA(0, 1, At, B1); PG8_BAR; PG8_SCHED; \
            PG8_LDA(At, 1, 1); PG8_STAGE_B(1, 0, b3); PG8_STAGE_B(1, 1, b3); PG8_STAGE_A(1, 0, a3, gA); \
            PG8_WAIT_V(8); PG8_WAIT_L(0); PG8_BAR; PG8_MMA(1, 0, At, B0); PG8_MMA(1, 1, At, B1); PG8_BAR; PG8_SCHED; } while (0)
        int rl = __builtin_amdgcn_readfirstlane((ui > 0) ? 1 : 0); asm volatile("" : "+s"(rl));
#define PG8_WV() do { if (rl) { if constexpr (Epi::NST >= 16) PG8_WAIT_V(24); else if constexpr (Epi::NST >= 8) PG8_WAIT_V(16); else PG8_WAIT_V(12); } else PG8_WAIT_V(8); } while (0)
#pragma nounroll
        for (int t = 0; t < nt; t += 2) { const bool last = (t == nt - 2); PG8_TRIP(t, last, PG8_WV(), rl); rl = 0; asm volatile("" : "+s"(rl)); }
#undef PG8_WV
#undef PG8_TRIP
        if constexpr (ALIGN_EPI) { if (wr == 0) PG8_BAR; }
        if (has_next) PG8_STAGE_A(1, 1, nA + kstep, gA);
        E(acc, cur, wr, wc, fr, fq);
        if (!has_next) break;
#pragma unroll
        for (int a = 0; a < 2; ++a)
#pragma unroll
            for (int b = 0; b < 2; ++b)
#pragma unroll
                for (int m = 0; m < 4; ++m)
#pragma unroll
                    for (int n = 0; n < 2; ++n) acc[a][b][m][n] = (f32x4){0.f, 0.f, 0.f, 0.f};
        cur = nxt; cA = nA; cB = nB; ++ui;
        if constexpr (ALIGN_EPI) { if (wr == 1) PG8_BAR; }
    }
    PG8_WAIT_V(0);
    if constexpr (!ALIGN_EPI) { if (wr == 0) PG8_BAR; }
    PG8_BAR;
#undef PG8_SA
#undef PG8_SB
#undef PG8_STAGE
#undef PG8_STAGE_A
#undef PG8_STAGE_B
#undef PG8_LDA
#undef PG8_LDB
#undef PG8_MMA
#undef PG8_WAIT_V
#undef PG8_WAIT_L
#undef PG8_BAR
#undef PG8_SCHED
}
}

constexpr int NWAVES = 8;
constexpr int BATCH = 16, SEQ = 4096, D = 1024, NTOK = BATCH * SEQ, DIN = 6144, NE = 32, TOPK = 4;
constexpr int CAPROWS = NTOK * TOPK + NE * 256, NTILE_MAX = CAPROWS / 256;
constexpr int TILES_A = 512, TILES_B_MAX = NTILE_MAX - TILES_A;
constexpr float EPS = 1e-6f;
constexpr int N_PHASES = 14;

constexpr size_t MiB = 1u << 20;
constexpr size_t WS_CTL = 0, CTL_ZERO_BYTES = 32768;
constexpr size_t WS_MOD = 1 * MiB;
constexpr size_t WS_WIN = 2 * MiB;
constexpr size_t WS_WBRR = 14 * MiB, WS_WBRS = 16 * MiB, WS_WOUT = 18 * MiB;
constexpr size_t WS_SGW = 20 * MiB;
constexpr size_t WS_TOPI = 21 * MiB, WS_TOPW = 22 * MiB, WS_TSLOT = 23 * MiB;
constexpr size_t WS_SLOTTOK = 24 * MiB;
constexpr size_t WS_SLOTW = 26 * MiB;
constexpr size_t WS_BLKCNT = 28 * MiB;
constexpr size_t WS_TILEEXP = 28 * MiB + 65536;
constexpr size_t WS_H = 32 * MiB;
constexpr size_t WS_H8 = 928 * MiB;
constexpr size_t WS_SGST = 992 * MiB;
constexpr size_t WS_WIN8 = 29 * MiB;
constexpr size_t WS_Z = 160 * MiB;
constexpr size_t ZREG = (size_t)NTOK * D * 2;
constexpr size_t WS_X1B = WS_Z;
constexpr size_t WS_H2 = WS_Z + ZREG;
constexpr size_t WS_WGU = 32 * MiB;
constexpr size_t WS_H2Q = 96 * MiB;
constexpr size_t WS_ACT = 416 * MiB;
constexpr size_t WS_YLO = 688 * MiB;
constexpr size_t WS_WDN = 944 * MiB;
constexpr size_t WS_YX = 1008 * MiB;
constexpr size_t WS_TOTAL = 1024 * MiB;
static_assert(WS_Z + 6 * ZREG <= 1024 * MiB, "z fits");
static_assert(WS_ACT + (size_t)NTILE_MAX * 256 * D <= WS_YLO && WS_YLO + (size_t)TILES_A * 256 * D * 2 <= WS_WDN && WS_WDN + (size_t)NE * D * D * 2 <= WS_YX && WS_YX + (size_t)32 * 256 * D * 2 <= WS_TOTAL && WS_ACT >= WS_H2 + ZREG, "moe map");
__host__ __device__ __forceinline__ size_t y_tile_off(int tile) {
    return tile < 512 ? WS_YLO + (size_t)tile * (256 * D * 2) : (tile < 768 ? WS_H2 + (size_t)(tile - 512) * (256 * D * 2) : (tile < 1024 ? WS_WGU + (size_t)(tile - 768) * (256 * D * 2) : WS_YX + (size_t)(tile - 1024) * (256 * D * 2)));
}
constexpr int CW_TMO = 0;
constexpr int CW_BAR = 4096;

constexpr int RING_BYTES = 131072;
constexpr int MISC_OFF = RING_BYTES + 320;
constexpr int AUX_OFF = RING_BYTES + 1024;
constexpr int LDS_BYTES = 163840;

#define GAS __attribute__((address_space(1)))
#define LAS __attribute__((address_space(3)))
typedef unsigned short bf16;
typedef unsigned v4u __attribute__((ext_vector_type(4)));
typedef unsigned v2u __attribute__((ext_vector_type(2)));
typedef float f32x4 __attribute__((ext_vector_type(4)));
typedef GAS unsigned gu32;
#define RLX_AGENT __ATOMIC_RELAXED, __HIP_MEMORY_SCOPE_AGENT
#define LDS_WAIT() asm volatile("s_waitcnt lgkmcnt(0)" ::: "memory")
#define VM_WAIT() asm volatile("s_waitcnt vmcnt(0)" ::: "memory")
__device__ __forceinline__ unsigned f2bf(float f) { unsigned u = __builtin_bit_cast(unsigned, f); return (u + 0x7fffu + ((u >> 16) & 1u)) >> 16; }
__device__ __forceinline__ unsigned pk2(float lo, float hi) { return f2bf(lo) | (f2bf(hi) << 16); }
__device__ __forceinline__ float bf2f(bf16 b) { return __uint_as_float(((unsigned)b) << 16); }
__device__ __forceinline__ unsigned pk4_fp8(float a, float b, float c, float d) {
    a = __builtin_amdgcn_fmed3f(a, -448.0f, 448.0f); b = __builtin_amdgcn_fmed3f(b, -448.0f, 448.0f); c = __builtin_amdgcn_fmed3f(c, -448.0f, 448.0f); d = __builtin_amdgcn_fmed3f(d, -448.0f, 448.0f);
    int w = __builtin_amdgcn_cvt_pk_fp8_f32(a, b, 0, false); w = __builtin_amdgcn_cvt_pk_fp8_f32(c, d, w, true); return (unsigned)w;
}
constexpr float SC_H2 = 8.0f, SC_W = 128.0f, SC_ACT = 4.0f, SC_Y = 32.0f;

#define XB_TMO      128
#define XB_XCNT(j)  (256  + 64 * (j))
#define XB_XSUB(j)  (1280 + 64 * (j))
#define XB_XGEN(j)  (2304 + 64 * (j))
#define XB_TOP      3328
#define XB_TOPGEN   3392
#define XCD_BAR_WORDS 3456
#define XB_SPIN_CAP (1u << 18)
__device__ __forceinline__ unsigned xb_ld(unsigned* p)              { return __hip_atomic_load(p, __ATOMIC_RELAXED, __HIP_MEMORY_SCOPE_AGENT); }
__device__ __forceinline__ unsigned xb_add(unsigned* p, unsigned v) { return __hip_atomic_fetch_add(p, v, __ATOMIC_RELAXED, __HIP_MEMORY_SCOPE_AGENT); }
__device__ __forceinline__ unsigned xb_xcc_id() { return (unsigned)__builtin_amdgcn_s_getreg((3 << 11) | 20) & 0xFu; }
#define XB_SPIN(cond, bar) do { unsigned _sp = 0; while (cond) { __builtin_amdgcn_s_sleep(1); \
    if ((++_sp & 255u) == 0u) { if (xb_ld(&(bar)[XB_TMO])) break; if (_sp > XB_SPIN_CAP) { atomicAdd(&(bar)[XB_TMO], 1u); break; } } } } while (0)
struct XcdBarrier { unsigned* bar; unsigned x; volatile LAS unsigned* st; };
__device__ __forceinline__ XcdBarrier xcd_barrier_post(unsigned* bar, volatile LAS unsigned* st) {
    XcdBarrier b; b.bar = bar; b.x = xb_xcc_id(); b.st = st;
    if (threadIdx.x == 0) (void)xb_add(&bar[XB_XCNT(b.x)], 1u);
    return b;
}
__device__ __forceinline__ void xcd_barrier_complete(unsigned* bar, unsigned x, unsigned& nloc, unsigned& nx) {
    const unsigned G = gridDim.x * gridDim.y * gridDim.z;
    unsigned sum, cnt, mine, sp = 0u;
    for (;;) {
        sum = 0u; cnt = 0u; mine = 0u;
#pragma unroll
        for (unsigned j = 0; j < 16; ++j) { const unsigned c = xb_ld(&bar[XB_XCNT(j)]); sum += c; cnt += (c > 0u) ? 1u : 0u; mine = (j == x) ? c : mine; }
        if (sum == G) break;
        __builtin_amdgcn_s_sleep(1);
        if ((++sp & 255u) == 0u) { if (xb_ld(&bar[XB_TMO])) break; if (sp > XB_SPIN_CAP) { atomicAdd(&bar[XB_TMO], 1u); break; } }
    }
    nloc = mine > 0u ? mine : 1u; nx = cnt > 0u ? cnt : 1u;
}
__device__ __forceinline__ void xcd_barrier(const XcdBarrier& b) {
    asm volatile("s_waitcnt vmcnt(0)" ::: "memory");
    __syncthreads();
    if (threadIdx.x == 0) {
        unsigned* bar = b.bar;
        __builtin_amdgcn_s_waitcnt(0);
        unsigned nloc = b.st[0], nx = b.st[1];
        if (nloc == 0u) { xcd_barrier_complete(bar, b.x, nloc, nx); b.st[0] = nloc; b.st[1] = nx; }
        const unsigned old = xb_add(&bar[XB_XSUB(b.x)], 1u);
        const unsigned gen = old / nloc;
        if (old + 1u == (gen + 1u) * nloc) {
            __builtin_amdgcn_fence(__ATOMIC_RELEASE, "agent");
            asm volatile("s_waitcnt vmcnt(0)" ::: "memory");
            const unsigned og = xb_add(&bar[XB_TOP], 1u);
            const unsigned tg = og / nx;
            if (og + 1u == (tg + 1u) * nx) xb_add(&bar[XB_TOPGEN], 1u);
            else XB_SPIN(xb_ld(&bar[XB_TOPGEN]) == tg, bar);
            __builtin_amdgcn_fence(__ATOMIC_ACQUIRE, "agent");
            xb_add(&bar[XB_XGEN(b.x)], 1u);
            asm volatile("s_waitcnt vmcnt(0)" ::: "memory");
        } else {
            XB_SPIN(xb_ld(&bar[XB_XGEN(b.x)]) == gen, bar);
            __builtin_amdgcn_fence(__ATOMIC_ACQUIRE, "agent");
            asm volatile("s_waitcnt vmcnt(0)" ::: "memory");
        }
    }
    __syncthreads();
}

__device__ __forceinline__ float wave_sum(float v) {
#pragma unroll
    for (int o = 1; o < 64; o <<= 1) v += __shfl_xor(v, o);
    return v;
}
__device__ __forceinline__ float fast_sigmoid(float x) { return __builtin_amdgcn_rcpf(1.0f + __builtin_amdgcn_exp2f(-1.4426950409f * x)); }
__device__ __forceinline__ float gelu_tanh(float x) { const float a = x * (1.5957691216f + 0.0713548163f * x * x); return x * fast_sigmoid(a); }

__device__ __forceinline__ void stage_store128(LAS unsigned char* stg, int lane, int fr, int fq, pg8::u32x4 w0, pg8::u32x4 w1, bf16* gp, size_t ld8) {
    *(LAS pg8::u32x4*)(stg + fr * 144 + fq * 16) = w0; *(LAS pg8::u32x4*)(stg + fr * 144 + 64 + fq * 16) = w1;
    const pg8::u32x4 r0 = *(const LAS pg8::u32x4*)(stg + (lane >> 3) * 144 + (lane & 7) * 16), r1 = *(const LAS pg8::u32x4*)(stg + ((lane >> 3) + 8) * 144 + (lane & 7) * 16);
    *(pg8::u32x4*)gp = r0; *(pg8::u32x4*)(gp + ld8) = r1;
}
__device__ __forceinline__ void stage_store64(LAS unsigned char* stg, int lane, int fr, int fq, pg8::u32x4 w, bf16* gp) {
    *(LAS pg8::u32x4*)(stg + fr * 80 + fq * 16) = w;
    const pg8::u32x4 r = *(const LAS pg8::u32x4*)(stg + (lane >> 2) * 80 + (lane & 3) * 16);
    *(pg8::u32x4*)gp = r;
}
#define EPI_STG() (lds_epi + (wr * 4 + wc) * 2304)

template <bool F8> struct EpiZT {
    static constexpr bool PERM = true, BREMAP = true; static constexpr int NST = 16;
    bf16* Z; LAS unsigned char* lds_epi; int pn0; float* sgst;
    __device__ __forceinline__ void prefetch(const pg8::Unit&, int, int) const {}
    template <int MODE, bool ST> __device__ __forceinline__ void body(const pg8::f32x4 (&acc)[2][2][4][2], bf16* base, int lane, int wr, int wc, int fr, int fq, float* stp) const {
#pragma unroll
        for (int ai = 0; ai < 2; ++ai)
#pragma unroll
            for (int m = 0; m < 4; ++m) { pg8::u32x4 w[2]; pg8::f32x2 s1 = (pg8::f32x2){0.f, 0.f}, s2 = s1;
#pragma unroll
                for (int bj = 0; bj < 2; ++bj) { unsigned pk[4];
#pragma unroll
                    for (int q = 0; q < 4; ++q) { const pg8::f32x4 a4 = acc[ai][bj][m][q >> 1]; pg8::f32x2 x = (pg8::f32x2){a4[2 * (q & 1)], a4[2 * (q & 1) + 1]}; if constexpr (F8) x = x * (1.0f / (SC_H2 * SC_W)); pg8::f32x2 v;
                        if constexpr (MODE == 0) v = x;
                        else if constexpr (MODE == 1) {
                            const pg8::f32x2 t = x * ((x * x) * (-0.10294324f) + (-2.3022082f));
                            const pg8::f32x2 d = (pg8::f32x2){__builtin_amdgcn_exp2f(t.x), __builtin_amdgcn_exp2f(t.y)} + 1.0f;
                            v = x * (pg8::f32x2){__builtin_amdgcn_rcpf(d.x), __builtin_amdgcn_rcpf(d.y)}; }
                        else { const pg8::f32x2 t = x * (-1.4426950409f);
                            const pg8::f32x2 d = (pg8::f32x2){__builtin_amdgcn_exp2f(t.x), __builtin_amdgcn_exp2f(t.y)} + 1.0f;
                            v = (pg8::f32x2){__builtin_amdgcn_rcpf(d.x), __builtin_amdgcn_rcpf(d.y)}; }
                        if constexpr (ST) { s1 += v; s2 += v * v; }
                        pk[q] = pg8::cvt_pk_bf16(v.x, v.y); }
                    w[bj] = (pg8::u32x4){pk[0], pk[1], pk[2], pk[3]}; }
                if constexpr (ST) { float a = s1.x + s1.y, b = s2.x + s2.y; a += __shfl_xor(a, 16); b += __shfl_xor(b, 16); a += __shfl_xor(a, 32); b += __shfl_xor(b, 32);
                    if (fq == 0) *(pg8::f32x2*)(stp + (size_t)(ai * 128 + m * 16) * 32) = (pg8::f32x2){a, b}; }
                stage_store128(EPI_STG(), lane, fr, fq, w[0], w[1], base + (size_t)(ai * 128 + m * 16) * D, (size_t)8 * D); }
    }
    __device__ __forceinline__ void operator()(const pg8::f32x4 (&acc)[2][2][4][2], const pg8::Unit& u, int wr, int wc, int fr, int fq) const {
        const int pnz = F8 ? (u.pn < 4 ? u.pn : u.pn + 12) : u.pn + pn0; const int region = pnz >> 2; const int lane = fq * 16 + fr;
        bf16* base = Z + (size_t)region * ((size_t)NTOK * D) + (size_t)(u.pm * 256 + wr * 64 + (lane >> 3)) * D + (pnz & 3) * 256 + wc * 64 + 8 * (lane & 7);
        float* stp = sgst + ((size_t)(u.pm * 256 + wr * 64 + fr) * 16 + (pnz & 3) * 4 + wc) * 2;
        if (region == 0) body<0, false>(acc, base, lane, wr, wc, fr, fq, stp);
        else if (region < 3) body<1, false>(acc, base, lane, wr, wc, fr, fq, stp);
        else if (region == 3) body<1, true>(acc, base, lane, wr, wc, fr, fq, stp);
        else body<2, false>(acc, base, lane, wr, wc, fr, fq, stp);
    }
};
template <bool HAS_ADD> struct EpiMergeT {
    static constexpr bool PERM = true, BREMAP = true; static constexpr int NST = 16;
    const bf16* gate; const bf16* addend; bf16* out; LAS unsigned char* lds_epi;
    __device__ __forceinline__ void prefetch(const pg8::Unit&, int, int) const {}
    __device__ __forceinline__ void operator()(const pg8::f32x4 (&acc)[2][2][4][2], const pg8::Unit& u, int wr, int wc, int fr, int fq) const {
        const int lane = fq * 16 + fr; const int row0 = u.pm * 256 + wr * 64 + fr, col0 = u.pn * 256 + wc * 64 + 8 * fq;
        bf16* obase = out + (size_t)(u.pm * 256 + wr * 64 + (lane >> 3)) * D + u.pn * 256 + wc * 64 + 8 * (lane & 7);
        const size_t off0 = (size_t)row0 * D + col0;
        if constexpr (!HAS_ADD) {
            pg8::u32x4 g[2][4][2];
#pragma unroll
            for (int ai = 0; ai < 2; ++ai)
#pragma unroll
                for (int m = 0; m < 4; ++m)
#pragma unroll
                    for (int bj = 0; bj < 2; ++bj) g[ai][m][bj] = *(const pg8::u32x4*)(gate + off0 + (size_t)(ai * 128 + m * 16) * D + bj * 32);
#pragma unroll
            for (int ai = 0; ai < 2; ++ai)
#pragma unroll
                for (int m = 0; m < 4; ++m) { pg8::u32x4 w[2];
#pragma unroll
                    for (int bj = 0; bj < 2; ++bj) { const pg8::u32x4 gg = g[ai][m][bj]; const pg8::f32x4 a0 = acc[ai][bj][m][0], a1 = acc[ai][bj][m][1];
                        w[bj].x = pg8::cvt_pk_bf16(pg8::bf_lo(gg.x) * a0[0], pg8::bf_hi(gg.x) * a0[1]); w[bj].y = pg8::cvt_pk_bf16(pg8::bf_lo(gg.y) * a0[2], pg8::bf_hi(gg.y) * a0[3]);
                        w[bj].z = pg8::cvt_pk_bf16(pg8::bf_lo(gg.z) * a1[0], pg8::bf_hi(gg.z) * a1[1]); w[bj].w = pg8::cvt_pk_bf16(pg8::bf_lo(gg.w) * a1[2], pg8::bf_hi(gg.w) * a1[3]); }
                    stage_store128(EPI_STG(), lane, fr, fq, w[0], w[1], obase + (size_t)(ai * 128 + m * 16) * D, (size_t)8 * D); }
        } else {
#pragma unroll
            for (int ai = 0; ai < 2; ++ai) { pg8::u32x4 g[4][2], ad[4][2];
#pragma unroll
                for (int m = 0; m < 4; ++m)
#pragma unroll
                    for (int bj = 0; bj < 2; ++bj) { const size_t off = off0 + (size_t)(ai * 128 + m * 16) * D + bj * 32; g[m][bj] = *(const pg8::u32x4*)(gate + off); ad[m][bj] = *(const pg8::u32x4*)(addend + off); }
#pragma unroll
                for (int m = 0; m < 4; ++m) { pg8::u32x4 w[2];
#pragma unroll
                    for (int bj = 0; bj < 2; ++bj) { const pg8::u32x4 gg = g[m][bj], aa = ad[m][bj]; const pg8::f32x4 a0 = acc[ai][bj][m][0], a1 = acc[ai][bj][m][1];
                        w[bj].x = pg8::cvt_pk_bf16(pg8::bf_lo(aa.x) + pg8::bf_lo(gg.x) * a0[0], pg8::bf_hi(aa.x) + pg8::bf_hi(gg.x) * a0[1]);
                        w[bj].y = pg8::cvt_pk_bf16(pg8::bf_lo(aa.y) + pg8::bf_lo(gg.y) * a0[2], pg8::bf_hi(aa.y) + pg8::bf_hi(gg.y) * a0[3]);
                        w[bj].z = pg8::cvt_pk_bf16(pg8::bf_lo(aa.z) + pg8::bf_lo(gg.z) * a1[0], pg8::bf_hi(aa.z) + pg8::bf_hi(gg.z) * a1[1]);
                        w[bj].w = pg8::cvt_pk_bf16(pg8::bf_lo(aa.w) + pg8::bf_lo(gg.w) * a1[2], pg8::bf_hi(aa.w) + pg8::bf_hi(gg.w) * a1[3]); }
                    stage_store128(EPI_STG(), lane, fr, fq, w[0], w[1], obase + (size_t)(ai * 128 + m * 16) * D, (size_t)8 * D); } }
        }
    }
};
struct EpiResid {
    static constexpr bool PERM = true, BREMAP = true; static constexpr int NST = 16;
    const float* x; const float* gt; bf16* out; LAS unsigned char* lds_epi;
    __device__ __forceinline__ void prefetch(const pg8::Unit&, int, int) const {}
    __device__ __forceinline__ void operator()(const pg8::f32x4 (&acc)[2][2][4][2], const pg8::Unit& u, int wr, int wc, int fr, int fq) const {
        const int lane = fq * 16 + fr; const int row0 = u.pm * 256 + wr * 64 + fr, col0 = u.pn * 256 + wc * 64 + 8 * fq; const int b = u.pm >> 4;
        bf16* obase = out + (size_t)(u.pm * 256 + wr * 64 + (lane >> 3)) * D + u.pn * 256 + wc * 64 + 8 * (lane & 7);
        pg8::f32x4 gv[2][2];
#pragma unroll
        for (int bj = 0; bj < 2; ++bj)
#pragma unroll
            for (int n = 0; n < 2; ++n) gv[bj][n] = *(const pg8::f32x4*)(gt + (size_t)b * DIN + col0 + bj * 32 + n * 4);
#pragma unroll
        for (int ai = 0; ai < 2; ++ai) { pg8::f32x4 xv[4][2][2];
#pragma unroll
            for (int m = 0; m < 4; ++m)
#pragma unroll
                for (int bj = 0; bj < 2; ++bj) { const size_t off = (size_t)(row0 + ai * 128 + m * 16) * D + col0 + bj * 32; xv[m][bj][0] = *(const pg8::f32x4*)(x + off); xv[m][bj][1] = *(const pg8::f32x4*)(x + off + 4); }
#pragma unroll
            for (int m = 0; m < 4; ++m) { pg8::u32x4 w[2];
#pragma unroll
                for (int bj = 0; bj < 2; ++bj) {
                    const pg8::f32x4 y0 = xv[m][bj][0] + gv[bj][0] * acc[ai][bj][m][0], y1 = xv[m][bj][1] + gv[bj][1] * acc[ai][bj][m][1];
                    w[bj].x = pg8::cvt_pk_bf16(y0[0], y0[1]); w[bj].y = pg8::cvt_pk_bf16(y0[2], y0[3]); w[bj].z = pg8::cvt_pk_bf16(y1[0], y1[1]); w[bj].w = pg8::cvt_pk_bf16(y1[2], y1[3]); }
                stage_store128(EPI_STG(), lane, fr, fq, w[0], w[1], obase + (size_t)(ai * 128 + m * 16) * D, (size_t)8 * D); } }
    }
};
struct EpiGu {
    static constexpr bool PERM = true, BREMAP = false; static constexpr int NST = 4;
    unsigned char* act; const float* bgu; int tile0; LAS unsigned char* lds_epi;
    __device__ __forceinline__ void prefetch(const pg8::Unit& u, int wid, int lane) const {
        if (wid == 0) __builtin_amdgcn_global_load_lds((const unsigned*)(bgu + (size_t)u.e * 2048 + (lane >> 5) * 1024 + u.pn * 128 + (lane & 31) * 4), (LAS unsigned*)(lds_epi + 18432 + u.par * 3072), 16, 0, 0);
    }
    __device__ __forceinline__ void operator()(const pg8::f32x4 (&acc)[2][2][4][2], const pg8::Unit& u, int wr, int wc, int fr, int fq) const {
        const int lane = fq * 16 + fr;
        unsigned char* obase = act + (size_t)((u.pm - tile0) * 256 + wr * 64 + (lane >> 1)) * D + u.pn * 128 + wc * 32 + 16 * (lane & 1);
        const LAS float* bg = (const LAS float*)(lds_epi + 18432 + u.par * 3072) + wc * 32 + 8 * fq;
        const pg8::f32x4 bg0 = *(const LAS pg8::f32x4*)(bg), bg1 = *(const LAS pg8::f32x4*)(bg + 4), bu0 = *(const LAS pg8::f32x4*)(bg + 128), bu1 = *(const LAS pg8::f32x4*)(bg + 132);
        LAS unsigned char* stg = EPI_STG();
        constexpr float SA = 1.0f / (SC_H2 * SC_W);
#pragma unroll
        for (int ai = 0; ai < 2; ++ai)
#pragma unroll
            for (int mp = 0; mp < 2; ++mp) {
#pragma unroll
                for (int mq = 0; mq < 2; ++mq) { const int m = 2 * mp + mq; pg8::f32x2 o[4];
#pragma unroll
                    for (int p = 0; p < 4; ++p) { const int n = p >> 1, j = 2 * (p & 1);
                        const pg8::f32x4 ag = acc[ai][0][m][n], au = acc[ai][1][m][n]; const pg8::f32x4 vbg = n ? bg1 : bg0, vbu = n ? bu1 : bu0;
                        pg8::f32x2 g = (pg8::f32x2){ag[j], ag[j + 1]} * SA + (pg8::f32x2){vbg[j], vbg[j + 1]};
                        pg8::f32x2 up = (pg8::f32x2){au[j], au[j + 1]} * SA + (pg8::f32x2){vbu[j], vbu[j + 1]};
                        g = (pg8::f32x2){fminf(g.x, 7.0f), fminf(g.y, 7.0f)}; up = (pg8::f32x2){__builtin_amdgcn_fmed3f(up.x, -7.0f, 7.0f), __builtin_amdgcn_fmed3f(up.y, -7.0f, 7.0f)};
                        const pg8::f32x2 t = g * (-2.4554669596f);
                        const pg8::f32x2 d = (pg8::f32x2){__builtin_amdgcn_exp2f(t.x), __builtin_amdgcn_exp2f(t.y)} * (1.0f / SC_ACT) + (1.0f / SC_ACT);
                        const pg8::f32x2 gs = g * (pg8::f32x2){__builtin_amdgcn_rcpf(d.x), __builtin_amdgcn_rcpf(d.y)};
                        o[p] = up * gs + gs; }
                    int w0 = __builtin_amdgcn_cvt_pk_fp8_f32(o[0].x, o[0].y, 0, false); w0 = __builtin_amdgcn_cvt_pk_fp8_f32(o[1].x, o[1].y, w0, true);
                    int w1 = __builtin_amdgcn_cvt_pk_fp8_f32(o[2].x, o[2].y, 0, false); w1 = __builtin_amdgcn_cvt_pk_fp8_f32(o[3].x, o[3].y, w1, true);
                    *(LAS pg8::u32x2*)(stg + (16 * mq + fr) * 48 + fq * 8) = (pg8::u32x2){(unsigned)w0, (unsigned)w1}; }
                asm volatile("" ::: "memory");
                const pg8::u32x4 r = *(const LAS pg8::u32x4*)(stg + (lane >> 1) * 48 + (lane & 1) * 16);
                *(GAS pg8::u32x4*)(obase + (size_t)(ai * 128 + mp * 32) * D) = r; }
    }
};
struct EpiDown {
    static constexpr bool PERM = true, BREMAP = true; static constexpr int NST = 8;
    unsigned char* wsb; const float* bd; const float* slot_w; int tile0; LAS unsigned char* lds_epi;
    __device__ __forceinline__ void prefetch(const pg8::Unit& u, int wid, int lane) const {
        if (wid == 0) __builtin_amdgcn_global_load_lds((const unsigned*)(bd + (size_t)u.e * D + u.pn * 256 + lane * 4), (LAS unsigned*)(lds_epi + 18432 + u.par * 3072), 16, 0, 0);
        if (wid == 1) __builtin_amdgcn_global_load_lds((const unsigned*)(slot_w + (size_t)u.pm * 256 + lane * 4), (LAS unsigned*)(lds_epi + 18432 + u.par * 3072 + 1024), 16, 0, 0);
    }
    __device__ __forceinline__ void operator()(const pg8::f32x4 (&acc)[2][2][4][2], const pg8::Unit& u, int wr, int wc, int fr, int fq) const {
        const int lane = fq * 16 + fr;
        unsigned char* obase = wsb + y_tile_off(u.pm) + (size_t)(wr * 64 + (lane >> 2)) * D + u.pn * 256 + wc * 64 + 16 * (lane & 3);
        const LAS float* bp = (const LAS float*)(lds_epi + 18432 + u.par * 3072) + wc * 64 + 8 * fq;
        const LAS float* swp = (const LAS float*)(lds_epi + 18432 + u.par * 3072 + 1024) + wr * 64 + fr;
        LAS unsigned char* stg = EPI_STG();
        pg8::f32x4 bv[2][2];
#pragma unroll
        for (int bj = 0; bj < 2; ++bj) { bv[bj][0] = *(const LAS pg8::f32x4*)(bp + bj * 32); bv[bj][1] = *(const LAS pg8::f32x4*)(bp + bj * 32 + 4); }
#pragma unroll
        for (int ai = 0; ai < 2; ++ai)
#pragma unroll
            for (int m = 0; m < 4; ++m) { const float sw = swp[ai * 128 + m * 16] * SC_Y;
#pragma unroll
                for (int bj = 0; bj < 2; ++bj) { constexpr float SA = 1.0f / (SC_ACT * SC_W); const pg8::f32x4 v0 = (acc[ai][bj][m][0] * SA + bv[bj][0]) * sw, v1 = (acc[ai][bj][m][1] * SA + bv[bj][1]) * sw;
                    *(LAS pg8::u32x2*)(stg + fr * 80 + bj * 32 + fq * 8) = (pg8::u32x2){pk4_fp8(v0[0], v0[1], v0[2], v0[3]), pk4_fp8(v1[0], v1[1], v1[2], v1[3])}; }
                asm volatile("" ::: "memory");
                const pg8::u32x4 r = *(const LAS pg8::u32x4*)(stg + (lane >> 2) * 80 + (lane & 3) * 16);
                *(pg8::u32x4*)(obase + (size_t)(ai * 128 + m * 16) * D) = r; }
    }
};

__device__ __forceinline__ void transpose_item(const float* W, int ldn, int K, int k0, int n0, bf16* WT, int drow0, LAS float* scr, int lane) {
    float tv_[32];
#pragma unroll
    for (int i = 0; i < 32; ++i) tv_[i] = W[(size_t)(k0 + 2 * i + (lane >> 5)) * ldn + n0 + (lane & 31)];
#pragma unroll
    for (int i = 0; i < 32; ++i) scr[(2 * i + (lane >> 5)) * 33 + (lane & 31)] = tv_[i];
    LDS_WAIT(); asm volatile("" ::: "memory");
    const int c = lane & 7;
#pragma unroll
    for (int j = 0; j < 4; ++j) { const int n = (lane >> 3) + 8 * j; const LAS float* s = scr + (8 * c) * 33 + n;
        v4u o; o.x = pk2(s[0 * 33], s[1 * 33]); o.y = pk2(s[2 * 33], s[3 * 33]); o.z = pk2(s[4 * 33], s[5 * 33]); o.w = pk2(s[6 * 33], s[7 * 33]);
        *(GAS v4u*)(WT + (size_t)(drow0 + n) * K + k0 + 8 * c) = o; }
    LDS_WAIT(); asm volatile("" ::: "memory");
}

__device__ __forceinline__ void transpose_item_f8(const float* W, int ldn, int K, int k0, int n0, unsigned char* WT8, int drow0, LAS float* scr, int lane, float sc) {
    float tv_[32];
#pragma unroll
    for (int i = 0; i < 32; ++i) tv_[i] = W[(size_t)(k0 + 2 * i + (lane >> 5)) * ldn + n0 + (lane & 31)];
#pragma unroll
    for (int i = 0; i < 32; ++i) scr[(2 * i + (lane >> 5)) * 33 + (lane & 31)] = tv_[i] * sc;
    LDS_WAIT(); asm volatile("" ::: "memory");
    const int c = lane & 7;
#pragma unroll
    for (int j = 0; j < 4; ++j) { const int n = (lane >> 3) + 8 * j; const LAS float* s = scr + (8 * c) * 33 + n;
        v2u o; o.x = pk4_fp8(s[0 * 33], s[1 * 33], s[2 * 33], s[3 * 33]); o.y = pk4_fp8(s[4 * 33], s[5 * 33], s[6 * 33], s[7 * 33]);
        *(GAS v2u*)(WT8 + (size_t)(drow0 + n) * K + k0 + 8 * c) = o; }
    LDS_WAIT(); asm volatile("" ::: "memory");
}

struct Args {
    const float* in[28]; float* out; unsigned char* ws; int ph_lo, ph_hi, li, pad;
};
enum { I_X = 0, I_C, I_ADAW, I_ADAB, I_N1G, I_WIN, I_CONVW, I_CONVB, I_LWA, I_LBA, I_LWX, I_LBX, I_LAM, I_SGLNG, I_SGLNB, I_SGWS, I_SGBS, I_WBRR, I_WBRS, I_WOUT, I_N2G, I_WR, I_BR, I_WGU, I_BGU, I_WDN, I_BDN, I_FG };

__global__ void __launch_bounds__(NWAVES * 64, 2) mega_fwd(Args args) {
    extern __shared__ __attribute__((aligned(16))) unsigned char lds_raw[];
    LAS unsigned char* lds = (LAS unsigned char*)lds_raw;
    volatile LAS unsigned* MISC = (volatile LAS unsigned*)(lds + MISC_OFF);
    const int tid = threadIdx.x, lane = tid & 63, wave = __builtin_amdgcn_readfirstlane(tid >> 6);
    const int G = gridDim.x; const int bx = blockIdx.x;
    const int vcu = (G % 8 == 0) ? (bx % 8) * (G / 8) + bx / 8 : bx;
    unsigned char* ws = args.ws;
    gu32* ctl = (gu32*)(ws + WS_CTL);
    for (int u = tid; u < (LDS_BYTES - RING_BYTES) / 4; u += NWAVES * 64) ((LAS unsigned*)(lds + RING_BYTES))[u] = 0u;
    __syncthreads();
#if MK_PER_PHASE
    XcdBarrier bar; bar.bar = (unsigned*)(ctl + CW_BAR); bar.x = 0; bar.st = nullptr;
#define GRID_BAR() do { if (tid == 0) __hip_atomic_store(ctl + CW_TMO, 0xBADBA0u, RLX_AGENT); } while (0)
#else
    XcdBarrier bar = xcd_barrier_post((unsigned*)(ctl + CW_BAR), MISC + 8);
#define GRID_BAR() xcd_barrier(bar)
#endif
    const int lo = args.ph_lo, hi = args.ph_hi;
#define IN(k) (lo <= (k) && (k) < hi)
#ifdef DIAG_A_LO
#define STAMP(k) do { if (bx == 0 && threadIdx.x == 0) __hip_atomic_store(ctl + 64 + (k), (unsigned)__builtin_amdgcn_s_memrealtime(), RLX_AGENT); } while (0)
#else
#define STAMP(k) do { } while (0)
#endif
#define BOTH(k) (IN(k) && IN((k) + 1))

    const float* x_in = args.in[I_X];
    float* modv = (float*)(ws + WS_MOD);
    bf16* Hb = (bf16*)(ws + WS_H);
    bf16* X1b = (bf16*)(ws + WS_X1B);
    bf16* H2b = (bf16*)(ws + WS_H2);
    bf16* Zb = (bf16*)(ws + WS_Z);
    bf16* Z0 = Zb, *Z1 = Zb + (size_t)NTOK * D, *Z2 = Zb + 2 * (size_t)NTOK * D, *Z3 = Zb + 3 * (size_t)NTOK * D, *Z4 = Zb + 4 * (size_t)NTOK * D, *Z5 = Zb + 5 * (size_t)NTOK * D;
    int* top_idx = (int*)(ws + WS_TOPI); float* top_w = (float*)(ws + WS_TOPW); int* tok_slot = (int*)(ws + WS_TSLOT);
    int* slot_tok = (int*)(ws + WS_SLOTTOK); float* slot_w = (float*)(ws + WS_SLOTW); int* blkcnt = (int*)(ws + WS_BLKCNT); int* tile_exp = (int*)(ws + WS_TILEEXP);
    const int gw = vcu * NWAVES + wave, NGW = G * NWAVES;

    STAMP(0);
    if (IN(0)) {
        int tid_l = threadIdx.x; asm volatile("" : "+v"(tid_l)); const int tid = tid_l, lane = tid & 63;
        if (bx < 96) {
            LAS float* sc = (LAS float*)lds;
            LAS float* part = (LAS float*)(lds + 65536);
            const float* cin = args.in[I_C];
            { float cv[32];
#pragma unroll
                for (int q = 0; q < 32; ++q) cv[q] = cin[(q >> 1) * D + tid + 512 * (q & 1)];
#pragma unroll
                for (int q = 0; q < 32; ++q) { const float v = cv[q]; sc[(tid + 512 * (q & 1)) * 16 + (q >> 1)] = v * fast_sigmoid(v); } }
            __syncthreads();
            for (int task = bx; task < 96; task += G) {
                const int j0 = task * 64; const float* aw = args.in[I_ADAW];
                float a16[16];
#pragma unroll
                for (int b = 0; b < 16; ++b) a16[b] = 0.f;
                {
                    float wa[32], wb[32];
                    const float* pw = aw + (size_t)(wave * 128) * DIN + j0 + lane;
#define P0_LD(w_, k0_) do { _Pragma("unroll") for (int q = 0; q < 32; ++q) { w_[q] = *pw; pw += DIN; asm volatile("" : "+v"(pw)); } } while (0)
#define P0_FMA(w_, k0_) do { _Pragma("unroll") for (int q = 0; q < 32; ++q) { const int k = wave * 128 + (k0_) + q; const float wv = w_[q]; \
                        _Pragma("unroll") for (int b4 = 0; b4 < 4; ++b4) { const f32x4 s4 = *(const LAS f32x4*)(sc + k * 16 + b4 * 4); \
                            a16[b4 * 4 + 0] += s4[0] * wv; a16[b4 * 4 + 1] += s4[1] * wv; a16[b4 * 4 + 2] += s4[2] * wv; a16[b4 * 4 + 3] += s4[3] * wv; } } } while (0)
                    P0_LD(wa, 0); P0_LD(wb, 32);
                    P0_FMA(wa, 0); P0_LD(wa, 64);
                    P0_FMA(wb, 32); P0_LD(wb, 96);
                    P0_FMA(wa, 64); P0_FMA(wb, 96);
#undef P0_LD
#undef P0_FMA
                }
#pragma unroll
                for (int b = 0; b < 16; ++b) part[(wave * 16 + b) * 64 + lane] = a16[b];
                __syncthreads();
                for (int q = 0; q < 2; ++q) { const int o = tid + 512 * q, b = o >> 6, col = o & 63; float s = args.in[I_ADAB][j0 + col];
#pragma unroll
                    for (int w = 0; w < 8; ++w) s += part[(w * 16 + b) * 64 + col];
                    modv[b * DIN + j0 + col] = s; }
                __syncthreads();
            }
        }
        __syncthreads();
        {
            LAS float* scr = (LAS float*)(lds + wave * 16384);
            constexpr int I_IN = 16 * (DIN / 32), I_SQ = 16 * (D / 32);
            const int cw = (bx >= 96 ? (bx - 96) : 0) * NWAVES + wave, NCW = (G > 96 ? (G - 96) : 1) * NWAVES;
            for (int it = (bx >= 96 || G <= 96) ? cw : I_IN + 3 * I_SQ; it < I_IN + 3 * I_SQ; it += NCW) {
                int r = it;
                if (r < I_IN) { const int nblk = DIN / 32, kb = r / nblk, nb = r % nblk;
                    if (nb >= 32 && nb < 128) transpose_item(args.in[I_WIN], DIN, D, 64 * kb, 32 * nb, (bf16*)(ws + WS_WIN), 32 * nb, scr, lane);
                    else transpose_item_f8(args.in[I_WIN], DIN, D, 64 * kb, 32 * nb, ws + WS_WIN8, nb < 32 ? 32 * nb : 32 * (nb - 96), scr, lane, SC_W);
                    continue; } r -= I_IN;
                const int which = r / I_SQ; r -= which * I_SQ; const int nblk = D / 32, kb = r / nblk, nb = r % nblk;
                const float* W = which == 0 ? args.in[I_WBRR] : (which == 1 ? args.in[I_WBRS] : args.in[I_WOUT]);
                bf16* WT = (bf16*)(ws + (which == 0 ? WS_WBRR : (which == 1 ? WS_WBRS : WS_WOUT)));
                transpose_item(W, D, D, 64 * kb, 32 * nb, WT, 32 * nb, scr, lane);
            }
        }
        { bf16* sgw = (bf16*)(ws + WS_SGW);
            for (int idx = gw * 64 + lane; idx < 8 * 128 * 128; idx += NGW * 64) { const int t = (idx >> 7) & 127, s2 = idx & 127; sgw[idx] = (bf16)(s2 <= t ? f2bf(args.in[I_SGWS][idx]) : 0u); } }
        if (BOTH(0)) GRID_BAR();
    }

    STAMP(1);
    if (IN(1)) {
        int tid_l = threadIdx.x; asm volatile("" : "+v"(tid_l)); const int tid = tid_l, lane = tid & 63;
        for (int rb = gw; rb < NTOK / 32; rb += NGW) {
            const int b = (rb * 32) / SEQ;
            f32x4 A4[4], B4[4];
#pragma unroll
            for (int j = 0; j < 4; ++j) { const int c = 4 * lane + 256 * j; const f32x4 g = *(const f32x4*)(args.in[I_N1G] + c), s = *(const f32x4*)(modv + b * DIN + 1024 + c);
                A4[j] = g * (1.0f + s); B4[j] = *(const f32x4*)(modv + b * DIN + c); }
            f32x4 v0[4], v1[4], n0[4], n1[4];
#define P1_LOAD(r_, d_) do { const GAS f32x4* xr_ = (const GAS f32x4*)(x_in + ((size_t)rb * 32 + (r_)) * D) + lane; _Pragma("unroll") for (int j = 0; j < 4; ++j) d_[j] = xr_[64 * j]; } while (0)
#define P1_ROW(r_, d_) do { float ss = 0.f; _Pragma("unroll") for (int j = 0; j < 4; ++j) ss += (d_[j].x * d_[j].x + d_[j].y * d_[j].y) + (d_[j].z * d_[j].z + d_[j].w * d_[j].w); \
                const float rstd = 1.0f / sqrtf(wave_sum(ss) * (1.f / D) + EPS); GAS v2u* o8 = (GAS v2u*)(Hb + ((size_t)rb * 32 + (r_)) * D) + lane; \
                GAS unsigned* o4 = (GAS unsigned*)(ws + WS_H8 + ((size_t)rb * 32 + (r_)) * D) + lane; \
                _Pragma("unroll") for (int j = 0; j < 4; ++j) { const f32x4 y = d_[j] * rstd * A4[j] + B4[j]; v2u o; o.x = pg8::cvt_pk_bf16(y.x, y.y); o.y = pg8::cvt_pk_bf16(y.z, y.w); o8[64 * j] = o; \
                    o4[64 * j] = pk4_fp8(y.x * SC_H2, y.y * SC_H2, y.z * SC_H2, y.w * SC_H2); } } while (0)
            P1_LOAD(0, v0); P1_LOAD(1, v1);
            for (int r = 0; r < 32; r += 2) {
                const int rn = (r < 30) ? r + 2 : r;
                P1_LOAD(rn, n0); P1_LOAD(rn + 1, n1);
                P1_ROW(r, v0); P1_ROW(r + 1, v1);
#pragma unroll
                for (int j = 0; j < 4; ++j) { v0[j] = n0[j]; v1[j] = n1[j]; }
            }
#undef P1_LOAD
#undef P1_ROW
        }
        if (BOTH(1)) GRID_BAR();
    }

    STAMP(2);
    if (IN(2)) {
        { pg8::PlainOrder S; S.init(Hb, (const bf16*)(ws + WS_WIN) + (size_t)1024 * D, NTOK, 3072, G, bx);
            EpiZT<false> E{Zb, lds + AUX_OFF, 4, (float*)(ws + WS_SGST)};
            pg8::gemm_phase<EpiZT<false>, pg8::PlainOrder, true>(lds, S, E); }
        { pg8::PlainOrderT<true> S; S.init((const bf16*)(ws + WS_H8), (const bf16*)(ws + WS_WIN8), NTOK, 3072, G, bx);
            EpiZT<true> E{Zb, lds + AUX_OFF, 0, (float*)(ws + WS_SGST)};
            pg8::gemm_phase<EpiZT<true>, pg8::PlainOrderT<true>, true>(lds, S, E); }
        if (BOTH(2)) GRID_BAR();
    }

    STAMP(3);
    if (IN(3)) {
        int tid_l = threadIdx.x; asm volatile("" : "+v"(tid_l)); const int tid = tid_l, lane = tid & 63;
        typedef float f32x16 __attribute__((ext_vector_type(16)));
        for (int unit = bx; unit < BATCH * 16; unit += G) {
            const int b = unit >> 4, hd = unit & 15, ch0 = hd * 64;
            LAS unsigned char* xb0 = lds + wave * 10240;
            LAS unsigned char* gb = lds + 81920 + wave * 4096;
            LAS unsigned char* wfr = lds + 114688;
            LAS unsigned char* ifr = lds + AUX_OFF;
            LAS float* cwl = (LAS float*)(lds + AUX_OFF + 8192);
            typedef float f32x2l __attribute__((ext_vector_type(2)));
            LAS f32x2l* tot = (LAS f32x2l*)(lds + AUX_OFF + 8192 + 2048);
            __syncthreads();
            for (int q = 0; q < 2; ++q) { const int fid = tid + 512 * q; const int mat = fid >> 9, nt = (fid >> 8) & 1, ks = (fid >> 6) & 3, l = fid & 63, r = l & 31, h = l >> 5;
                const float* W = (mat ? args.in[I_LWX] : args.in[I_LWA]) + (size_t)hd * 4096 + (size_t)(16 * ks + 8 * h) * 64 + 32 * nt + r;
                v4u o; o.x = pk2(W[0], W[64]); o.y = pk2(W[128], W[192]); o.z = pk2(W[256], W[320]); o.w = pk2(W[384], W[448]);
                *(LAS v4u*)(wfr + fid * 16) = o; }
            { const int nt = tid >> 8, ks = (tid >> 6) & 3, l = tid & 63; const int pos = 32 * nt + (l & 31) - 16 * ks - 8 * (l >> 5);
                v4u o; o.x = (pos == 0 ? 0x3F80u : 0u) | (pos == 1 ? 0x3F800000u : 0u); o.y = (pos == 2 ? 0x3F80u : 0u) | (pos == 3 ? 0x3F800000u : 0u);
                o.z = (pos == 4 ? 0x3F80u : 0u) | (pos == 5 ? 0x3F800000u : 0u); o.w = (pos == 6 ? 0x3F80u : 0u) | (pos == 7 ? 0x3F800000u : 0u);
                *(LAS v4u*)(ifr + tid * 16) = o; }
            if (tid < 256) cwl[tid] = args.in[I_CONVW][(tid >> 6) * D + ch0 + (tid & 63)];
            else if (tid < 320) cwl[tid] = args.in[I_CONVB][ch0 + tid - 256];
            float cba[2], cbx[2], csp[2], carry[2];
#pragma unroll
            for (int nt = 0; nt < 2; ++nt) { const int c = ch0 + 32 * nt + (lane & 31); cba[nt] = -1.4426950409f * args.in[I_LBA][c]; cbx[nt] = -1.4426950409f * args.in[I_LBX][c];
                const float lm = args.in[I_LAM][c]; csp[nt] = 8.0f * log1pf(expf(-lm)) * 1.4426950409f; carry[nt] = 0.f; }
            __syncthreads();
            const int r31 = lane & 31, hh = lane >> 5;
            const int tokA = 16 * ((r31 >> 2) & 1) + 4 * (r31 >> 3) + (r31 & 3);
            const int dchunk = (lane & 7) ^ ((lane >> 3) & 7), drow = lane >> 3;
            const bf16* zx = Z0 + (size_t)b * SEQ * D + ch0 + 8 * dchunk;
            const bf16* zg = Z1 + (size_t)b * SEQ * D + ch0 + 8 * dchunk;
#define P3_DMA_X(Tw_, buf_) do { _Pragma("unroll") for (int n_ = 0; n_ < 5; ++n_) { int tk_ = (Tw_) - 8 + 8 * n_ + drow; tk_ = tk_ < 0 ? 0 : tk_; \
                __builtin_amdgcn_global_load_lds((const unsigned*)(zx + (size_t)tk_ * D), (LAS unsigned*)(xb0 + (buf_) * 5120 + n_ * 1024), 16, 0, 0); } } while (0)
#define P3_DMA_G(Tw_) do { _Pragma("unroll") for (int n_ = 0; n_ < 4; ++n_) { const int tk_ = (Tw_) + 8 * n_ + drow; \
                __builtin_amdgcn_global_load_lds((const unsigned*)(zg + (size_t)tk_ * D), (LAS unsigned*)(gb + n_ * 1024), 16, 0, 0); } } while (0)
            P3_DMA_X(wave * 32, 0);
            for (int st = 0; st < 16; ++st) {
                const int Tw = st * 256 + wave * 32, cur = st & 1;
                const int Tn = (st < 15) ? Tw + 256 : Tw;
                P3_DMA_G(Tw);
                P3_DMA_X(Tn, cur ^ 1);
                if (st == 0) asm volatile("s_waitcnt vmcnt(9)" ::: "memory");
                else asm volatile("s_waitcnt vmcnt(13)" ::: "memory");
                LAS unsigned char* xb = xb0 + cur * 5120;
                if (Tw == 0) { if (lane < 24) *(LAS v4u*)(xb + (5 + (lane >> 3)) * 128 + (lane & 7) * 16) = (v4u){0u, 0u, 0u, 0u}; }
                asm volatile("s_waitcnt lgkmcnt(0)" ::: "memory");
                pg8::bf16x8 xa[4];
#pragma unroll
                for (int ks = 0; ks < 4; ++ks) {
                    const f32x4 b0 = *(const LAS f32x4*)(cwl + 256 + 16 * ks + 8 * hh), b1 = *(const LAS f32x4*)(cwl + 256 + 16 * ks + 8 * hh + 4);
                    typedef float f32x2q __attribute__((ext_vector_type(2)));
                    f32x2q xq[4] = {(f32x2q){b0[0], b0[1]}, (f32x2q){b0[2], b0[3]}, (f32x2q){b1[0], b1[1]}, (f32x2q){b1[2], b1[3]}};
#pragma unroll
                    for (int k = 0; k < 4; ++k) { const int rho = tokA + 5 + k; const int pos = (2 * ks + hh) ^ (rho & 7);
                        const v4u w = *(const LAS v4u*)(xb + rho * 128 + pos * 16);
                        const f32x4 c0 = *(const LAS f32x4*)(cwl + k * 64 + 16 * ks + 8 * hh), c1 = *(const LAS f32x4*)(cwl + k * 64 + 16 * ks + 8 * hh + 4);
                        xq[0] += (f32x2q){c0[0], c0[1]} * (f32x2q){pg8::bf_lo(w.x), pg8::bf_hi(w.x)}; xq[1] += (f32x2q){c0[2], c0[3]} * (f32x2q){pg8::bf_lo(w.y), pg8::bf_hi(w.y)};
                        xq[2] += (f32x2q){c1[0], c1[1]} * (f32x2q){pg8::bf_lo(w.z), pg8::bf_hi(w.z)}; xq[3] += (f32x2q){c1[2], c1[3]} * (f32x2q){pg8::bf_lo(w.w), pg8::bf_hi(w.w)}; }
                    v4u p; p.x = pg8::cvt_pk_bf16(xq[0].x, xq[0].y); p.y = pg8::cvt_pk_bf16(xq[1].x, xq[1].y); p.z = pg8::cvt_pk_bf16(xq[2].x, xq[2].y); p.w = pg8::cvt_pk_bf16(xq[3].x, xq[3].y);
                    xa[ks] = __builtin_bit_cast(pg8::bf16x8, p); }
                float hl[2][16], cp[2][16];
#pragma unroll
                for (int nt = 0; nt < 2; ++nt) {
                    f32x16 ar, ai, ax;
#pragma unroll
                    for (int i = 0; i < 16; ++i) { ar[i] = 0.f; ai[i] = 0.f; ax[i] = 0.f; }
#pragma unroll
                    for (int ks = 0; ks < 4; ++ks) {
                        const pg8::bf16x8 fa = *(const LAS pg8::bf16x8*)(wfr + (((0 * 2 + nt) * 4 + ks) * 64 + lane) * 16);
                        const pg8::bf16x8 fx = *(const LAS pg8::bf16x8*)(wfr + (((1 * 2 + nt) * 4 + ks) * 64 + lane) * 16);
                        const pg8::bf16x8 fi = *(const LAS pg8::bf16x8*)(ifr + ((nt * 4 + ks) * 64 + lane) * 16);
                        ar = __builtin_amdgcn_mfma_f32_32x32x16_bf16(xa[ks], fa, ar, 0, 0, 0);
                        ai = __builtin_amdgcn_mfma_f32_32x32x16_bf16(xa[ks], fx, ai, 0, 0, 0);
                        ax = __builtin_amdgcn_mfma_f32_32x32x16_bf16(xa[ks], fi, ax, 0, 0, 0); }
                    float P = 1.f, H = 0.f;
#pragma unroll
                    for (int i = 0; i < 16; i += 2) {
                        typedef float f32x2p __attribute__((ext_vector_type(2)));
                        const f32x2p tr = (f32x2p){ar[i], ar[i + 1]} * (-1.4426950409f) + cba[nt], ti2 = (f32x2p){ai[i], ai[i + 1]} * (-1.4426950409f) + cbx[nt];
                        const f32x2p dr = (f32x2p){__builtin_amdgcn_exp2f(tr.x), __builtin_amdgcn_exp2f(tr.y)} + 1.0f, di = (f32x2p){__builtin_amdgcn_exp2f(ti2.x), __builtin_amdgcn_exp2f(ti2.y)} + 1.0f;
                        const f32x2p rg = (f32x2p){__builtin_amdgcn_rcpf(dr.x), __builtin_amdgcn_rcpf(dr.y)}, ig = (f32x2p){__builtin_amdgcn_rcpf(di.x), __builtin_amdgcn_rcpf(di.y)};
                        const f32x2p la = rg * (-csp[nt]);
                        const f32x2p av = (f32x2p){__builtin_amdgcn_exp2f(la.x), __builtin_amdgcn_exp2f(la.y)};
                        const f32x2p m2 = 1.0f - av * av;
                        const f32x2p uu = (f32x2p){__builtin_amdgcn_sqrtf(m2.x), __builtin_amdgcn_sqrtf(m2.y)} * ig * (f32x2p){ax[i], ax[i + 1]};
                        H = av.x * H + uu.x; P = P * av.x; hl[nt][i] = H; cp[nt][i] = P;
                        H = av.y * H + uu.y; P = P * av.y; hl[nt][i + 1] = H; cp[nt][i + 1] = P; }
                    const float Ho = __shfl_xor(H, 32), Po = __shfl_xor(P, 32);
                    const float H0 = hh ? Ho : 0.f, P0 = hh ? Po : 1.f;
#pragma unroll
                    for (int i = 0; i < 16; i += 2) { typedef float f32x2r __attribute__((ext_vector_type(2))); const f32x2r c2 = (f32x2r){cp[nt][i], cp[nt][i + 1]}; const f32x2r h2 = (f32x2r){hl[nt][i], hl[nt][i + 1]} + c2 * H0; const f32x2r c3 = c2 * P0;
                        hl[nt][i] = h2.x; hl[nt][i + 1] = h2.y; cp[nt][i] = c3.x; cp[nt][i + 1] = c3.y; }
                    if (hh) tot[(cur * 8 + wave) * 64 + 32 * nt + r31] = (f32x2l){cp[nt][15], hl[nt][15]};
                }
                asm volatile("s_waitcnt vmcnt(5)" ::: "memory");
                {
                    pg8::bf16x8 ga[4];
#pragma unroll
                    for (int ks = 0; ks < 4; ++ks) { const int pos = (2 * ks + hh) ^ (tokA & 7); ga[ks] = *(const LAS pg8::bf16x8*)(gb + tokA * 128 + pos * 16); }
#pragma unroll
                    for (int nt = 0; nt < 2; ++nt) { f32x16 ag;
#pragma unroll
                        for (int i = 0; i < 16; ++i) ag[i] = 0.f;
#pragma unroll
                        for (int ks = 0; ks < 4; ++ks) { const pg8::bf16x8 fi = *(const LAS pg8::bf16x8*)(ifr + ((nt * 4 + ks) * 64 + lane) * 16);
                            ag = __builtin_amdgcn_mfma_f32_32x32x16_bf16(ga[ks], fi, ag, 0, 0, 0); }
#pragma unroll
                        for (int i = 0; i < 16; i += 2) { typedef float f32x2r __attribute__((ext_vector_type(2))); const f32x2r g2 = (f32x2r){ag[i], ag[i + 1]}; const f32x2r h2 = (f32x2r){hl[nt][i], hl[nt][i + 1]} * g2, c2 = (f32x2r){cp[nt][i], cp[nt][i + 1]} * g2;
                            hl[nt][i] = h2.x; hl[nt][i + 1] = h2.y; cp[nt][i] = c2.x; cp[nt][i + 1] = c2.y; } }
                }
                asm volatile("s_waitcnt lgkmcnt(0)" ::: "memory"); __builtin_amdgcn_s_barrier(); asm volatile("" ::: "memory");
#pragma unroll
                for (int nt = 0; nt < 2; ++nt) { float s = carry[nt], cin = 0.f;
#pragma unroll
                    for (int w2 = 0; w2 < 8; ++w2) { const f32x2l ph = tot[(cur * 8 + w2) * 64 + 32 * nt + r31]; cin = (w2 == wave) ? s : cin; s = ph.x * s + ph.y; }
                    carry[nt] = s;
                    LAS bf16* yl = (LAS bf16*)(gb + (16 * hh) * 128 + (32 * nt + r31) * 2);
#pragma unroll
                    for (int i = 0; i < 16; i += 2) { typedef float f32x2r __attribute__((ext_vector_type(2))); const f32x2r y2 = (f32x2r){hl[nt][i], hl[nt][i + 1]} + (f32x2r){cp[nt][i], cp[nt][i + 1]} * cin;
                        const unsigned pk = pg8::cvt_pk_bf16(y2.x, y2.y); yl[i * 64] = (bf16)(pk & 0xffffu); yl[(i + 1) * 64] = (bf16)(pk >> 16); } }
                asm volatile("" ::: "memory");
                { bf16* yo = Z1 + ((size_t)b * SEQ + Tw + (lane >> 3)) * D + ch0 + 8 * (lane & 7);
                    v4u o[4];
#pragma unroll
                    for (int q = 0; q < 4; ++q) o[q] = *(const LAS v4u*)(gb + ((lane >> 3) + 8 * q) * 128 + (lane & 7) * 16);
#pragma unroll
                    for (int q = 0; q < 4; ++q) *(v4u*)(yo + (size_t)(8 * q) * D) = o[q]; }
                asm volatile("" ::: "memory");
            }
            asm volatile("s_waitcnt vmcnt(0)" ::: "memory");
#undef P3_DMA_X
#undef P3_DMA_G
        }
        __syncthreads();
        STAMP(15);
        LAS float* c_lng = (LAS float*)(lds + AUX_OFF + 1024); LAS float* c_lnb = (LAS float*)(lds + AUX_OFF + 5120); LAS float* c_bs = (LAS float*)(lds + AUX_OFF + 9216);
        for (int q = 0; q < 2; ++q) { c_lng[tid + 512 * q] = args.in[I_SGLNG][tid + 512 * q]; c_lnb[tid + 512 * q] = args.in[I_SGLNB][tid + 512 * q]; c_bs[tid + 512 * q] = args.in[I_SGBS][tid + 512 * q]; }
        for (int chunk = bx; chunk < NTOK / 128; chunk += G) {
            const size_t row0 = (size_t)chunk * 128;
            LAS float* st = (LAS float*)(lds + AUX_OFF);
            const bf16* sgw = (const bf16*)(ws + WS_SGW);
            __syncthreads();
            if (tid < 128) {
                const f32x4* pp = (const f32x4*)(ws + WS_SGST) + (row0 + tid) * 8; float sa = 0.f, sb = 0.f;
                f32x4 p4[8];
#pragma unroll
                for (int i = 0; i < 8; ++i) p4[i] = pp[i];
#pragma unroll
                for (int i = 0; i < 8; ++i) { sa += p4[i].x; sb += p4[i].y; sa += p4[i].z; sb += p4[i].w; }
                const float mean = sa * (1.f / D); const float var = fmaxf(sb * (1.f / D) - mean * mean, 0.f);
                st[2 * tid] = mean; st[2 * tid + 1] = 1.0f / sqrtf(var + EPS); }
            __syncthreads();
            const int r31 = lane & 31, hh = lane >> 5;
            const int ti = wave >> 1, ci0 = 2 * (wave & 1);
            const int bch = tid & 15, bs0 = tid >> 4;
#define SG_BUILD_LOAD(g_, wv_) do { _Pragma("unroll") for (int q = 0; q < 4; ++q) wv_[q] = *(const v4u*)(Z3 + (row0 + bs0 + 32 * q) * D + (g_) * 128 + 8 * bch); } while (0)
#define SG_BUILD_STORE(g_, wv_) do { const int col = (g_) * 128 + 8 * bch; LAS unsigned char* vt_ = lds + ((g_) & 1) * 32768; \
                const f32x4 g0 = *(const LAS f32x4*)(c_lng + col), g1 = *(const LAS f32x4*)(c_lng + col + 4), b0 = *(const LAS f32x4*)(c_lnb + col), b1 = *(const LAS f32x4*)(c_lnb + col + 4); \
                _Pragma("unroll") for (int q = 0; q < 4; ++q) { const int s = bs0 + 32 * q; const v4u w = wv_[q]; const float mean = st[2 * s], rstd = st[2 * s + 1]; v4u o; \
                    o.x = pg8::cvt_pk_bf16((pg8::bf_lo(w.x) - mean) * rstd * g0[0] + b0[0], (pg8::bf_hi(w.x) - mean) * rstd * g0[1] + b0[1]); \
                    o.y = pg8::cvt_pk_bf16((pg8::bf_lo(w.y) - mean) * rstd * g0[2] + b0[2], (pg8::bf_hi(w.y) - mean) * rstd * g0[3] + b0[3]); \
                    o.z = pg8::cvt_pk_bf16((pg8::bf_lo(w.z) - mean) * rstd * g1[0] + b1[0], (pg8::bf_hi(w.z) - mean) * rstd * g1[1] + b1[1]); \
                    o.w = pg8::cvt_pk_bf16((pg8::bf_lo(w.w) - mean) * rstd * g1[2] + b1[2], (pg8::bf_hi(w.w) - mean) * rstd * g1[3] + b1[3]); \
                    *(LAS v4u*)(vt_ + 256 * s + 16 * (bch ^ (((s & 3) << 2) | ((s >> 2) & 3)))) = o; } } while (0)
            const int nks = 2 * (ti + 1);
            pg8::bf16x8 afc[8];
#define SG_LOAD_A(g_, af_) do { const bf16* wrow_ = sgw + ((size_t)(g_) * 128 + 32 * ti + r31) * 128 + 8 * hh; _Pragma("unroll") for (int ks = 0; ks < 8; ++ks) if (ks < nks) af_[ks] = *(const pg8::bf16x8*)(wrow_ + 16 * ks); } while (0)
            v4u wvA[4], wvB[4], guvC[4], guvN[4];
#define SG_GU_LOAD(g_, gv_) do { const bf16* gb_ = Z2 + (row0 + 32 * ti + (lane >> 3)) * D + (g_) * 128 + 32 * ci0 + 8 * (lane & 7); _Pragma("unroll") for (int q = 0; q < 4; ++q) gv_[q] = *(const v4u*)(gb_ + (size_t)(8 * q) * D); } while (0)
            SG_BUILD_LOAD(0, wvA); SG_LOAD_A(0, afc); SG_GU_LOAD(0, guvC); SG_BUILD_STORE(0, wvA); SG_BUILD_LOAD(1, wvA);
            __syncthreads();
#pragma nounroll
            for (int g = 0; g < 8; ++g) {
                float bsv[16];
#pragma unroll
                for (int i = 0; i < 16; ++i) bsv[i] = c_bs[g * 128 + 32 * ti + 4 * hh + (i & 3) + 8 * (i >> 2)];
                bf16* obase = Z2 + (row0 + 32 * ti + (lane >> 3)) * D + g * 128 + 32 * ci0 + 8 * (lane & 7);
                const int gn = (g < 7) ? g + 1 : g, gn2 = (g < 6) ? g + 2 : 7;
                SG_GU_LOAD(gn, guvN); SG_BUILD_LOAD(gn2, wvB);
                f32x16 acc0, acc1;
#pragma unroll
                for (int i = 0; i < 16; ++i) { acc0[i] = 0.f; acc1[i] = 0.f; }
                const unsigned vbase = (unsigned)(size_t)(lds + (g & 1) * 32768);
                const unsigned blk = (lane >> 4) & 1, qq = (lane & 15) >> 2, pp = lane & 3;
#pragma unroll
                for (int kp = 0; kp < 4; ++kp) if (2 * kp < nks) {
                    unsigned ad[2][2][2];
#pragma unroll
                    for (int kk = 0; kk < 2; ++kk)
#pragma unroll
                        for (int cc = 0; cc < 2; ++cc)
#pragma unroll
                            for (int t2 = 0; t2 < 2; ++t2) { const unsigned row = 16 * (2 * kp + kk) + 8 * hh + 4 * t2 + qq, chn = 4 * (ci0 + cc) + 2 * blk + (pp >> 1);
                                ad[kk][cc][t2] = vbase + 256u * row + 16u * (chn ^ (((row & 3) << 2) | ((row >> 2) & 3))) + 8u * (pp & 1); }
                    v2u f[2][2][2];
                    asm volatile("ds_read_b64_tr_b16 %0, %8\n\tds_read_b64_tr_b16 %1, %9\n\tds_read_b64_tr_b16 %2, %10\n\tds_read_b64_tr_b16 %3, %11\n\t"
                                 "ds_read_b64_tr_b16 %4, %12\n\tds_read_b64_tr_b16 %5, %13\n\tds_read_b64_tr_b16 %6, %14\n\tds_read_b64_tr_b16 %7, %15\n\ts_waitcnt lgkmcnt(0)"
                                 : "=&v"(f[0][0][0]), "=&v"(f[0][0][1]), "=&v"(f[0][1][0]), "=&v"(f[0][1][1]), "=&v"(f[1][0][0]), "=&v"(f[1][0][1]), "=&v"(f[1][1][0]), "=&v"(f[1][1][1])
                                 : "v"(ad[0][0][0]), "v"(ad[0][0][1]), "v"(ad[0][1][0]), "v"(ad[0][1][1]), "v"(ad[1][0][0]), "v"(ad[1][0][1]), "v"(ad[1][1][0]), "v"(ad[1][1][1]) : "memory");
#pragma unroll
                    for (int kk = 0; kk < 2; ++kk) {
                        const v4u b0v = (v4u){f[kk][0][0].x, f[kk][0][0].y, f[kk][0][1].x, f[kk][0][1].y}, b1v = (v4u){f[kk][1][0].x, f[kk][1][0].y, f[kk][1][1].x, f[kk][1][1].y};
                        acc0 = __builtin_amdgcn_mfma_f32_32x32x16_bf16(afc[2 * kp + kk], __builtin_bit_cast(pg8::bf16x8, b0v), acc0, 0, 0, 0);
                        acc1 = __builtin_amdgcn_mfma_f32_32x32x16_bf16(afc[2 * kp + kk], __builtin_bit_cast(pg8::bf16x8, b1v), acc1, 0, 0, 0); }
                }
                { LAS float* ep = (LAS float*)(lds + 65536 + wave * 8192);
#pragma unroll
                    for (int i = 0; i < 16; ++i) { const int tl = (i & 3) + 8 * (i >> 2) + 4 * hh; ep[tl * 64 + r31] = acc0[i] + bsv[i]; ep[tl * 64 + 32 + r31] = acc1[i] + bsv[i]; }
#pragma unroll
                    for (int q = 0; q < 4; ++q) { const LAS f32x4* sp = (const LAS f32x4*)(ep + ((lane >> 3) + 8 * q) * 64 + 8 * (lane & 7)); const f32x4 s0 = sp[0], s1 = sp[1]; const v4u gu = guvC[q];
                        v4u o; o.x = pg8::cvt_pk_bf16(pg8::bf_lo(gu.x) * s0[0], pg8::bf_hi(gu.x) * s0[1]); o.y = pg8::cvt_pk_bf16(pg8::bf_lo(gu.y) * s0[2], pg8::bf_hi(gu.y) * s0[3]);
                        o.z = pg8::cvt_pk_bf16(pg8::bf_lo(gu.z) * s1[0], pg8::bf_hi(gu.z) * s1[1]); o.w = pg8::cvt_pk_bf16(pg8::bf_lo(gu.w) * s1[2], pg8::bf_hi(gu.w) * s1[3]);
                        *(v4u*)(obase + (size_t)(8 * q) * D) = o; } }
                SG_LOAD_A(gn, afc);
                if (g < 7) SG_BUILD_STORE(gn, wvA);
#pragma unroll
                for (int q = 0; q < 4; ++q) { wvA[q] = wvB[q]; guvC[q] = guvN[q]; }
                __syncthreads();
            }
#undef SG_BUILD_LOAD
#undef SG_GU_LOAD
#undef SG_BUILD_STORE
#undef SG_LOAD_A
        }
        if (BOTH(3)) GRID_BAR();
    }

    STAMP(4);
    if (IN(4)) {
        int tid_l = threadIdx.x; asm volatile("" : "+v"(tid_l)); const int tid = tid_l, lane = tid & 63;
        { const int panel = bx;
            { pg8::PanelOrder S{Z1, (const bf16*)(ws + WS_WBRR), panel, 4}; EpiMergeT<false> E{Z4, nullptr, Z0, lds + AUX_OFF}; pg8::gemm_phase<EpiMergeT<false>, pg8::PanelOrder, true>(lds, S, E); asm volatile("s_waitcnt vmcnt(0)" ::: "memory"); __syncthreads(); }
            { pg8::PanelOrder S{Z2, (const bf16*)(ws + WS_WBRS), panel, 4}; EpiMergeT<true> E{Z5, Z0, Z3, lds + AUX_OFF}; pg8::gemm_phase<EpiMergeT<true>, pg8::PanelOrder, true>(lds, S, E); asm volatile("s_waitcnt vmcnt(0)" ::: "memory"); __syncthreads(); }
            { pg8::PanelOrder S{Z3, (const bf16*)(ws + WS_WOUT), panel, 4}; EpiResid E{x_in, modv + 2048, X1b, lds + AUX_OFF}; pg8::gemm_phase<EpiResid, pg8::PanelOrder, true>(lds, S, E); asm volatile("s_waitcnt vmcnt(0)\n\tbuffer_inv sc0\n\ts_waitcnt vmcnt(0)" ::: "memory"); __syncthreads(); }
            typedef float f32x16 __attribute__((ext_vector_type(16)));
            LAS unsigned* hist = (LAS unsigned*)(lds + AUX_OFF);
            __syncthreads();
            for (int q = 0; q < 8; ++q) { const int fid = tid + 512 * q; const int ks = fid >> 6, l = fid & 63; const float* W = args.in[I_WR] + (size_t)(16 * ks + 8 * (l >> 5)) * NE + (l & 31);
                float w[8]; unsigned hi[8], lo[8];
#pragma unroll
                for (int j = 0; j < 8; ++j) { w[j] = W[j * NE]; hi[j] = f2bf(w[j]); lo[j] = f2bf(w[j] - __uint_as_float(hi[j] << 16)); }
                *(LAS v4u*)(lds + ((ks * 2 + 0) * 64 + l) * 16) = (v4u){hi[0] | (hi[1] << 16), hi[2] | (hi[3] << 16), hi[4] | (hi[5] << 16), hi[6] | (hi[7] << 16)};
                *(LAS v4u*)(lds + ((ks * 2 + 1) * 64 + l) * 16) = (v4u){lo[0] | (lo[1] << 16), lo[2] | (lo[3] << 16), lo[4] | (lo[5] << 16), lo[6] | (lo[7] << 16)}; }
            __syncthreads();
            { const int tb = panel;
                if (tid < 32) hist[tid] = 0u;
                const int m0 = tb * 256 + wave * 32; const int b = m0 / SEQ;
                {
                    f32x4 A4[2][2], B4[2][2];
#pragma unroll
                    for (int j = 0; j < 2; ++j)
#pragma unroll
                        for (int q = 0; q < 2; ++q) { const int c = 8 * lane + 512 * j + 4 * q; const f32x4 g = *(const f32x4*)(args.in[I_N2G] + c), s = *(const f32x4*)(modv + b * DIN + 4096 + c);
                            A4[j][q] = g * (1.0f + s); B4[j][q] = *(const f32x4*)(modv + b * DIN + 3072 + c); }
                    f32x4 v[2][2]; v4u xw[2], xn[2];
                    { const GAS v4u* xr = (const GAS v4u*)(X1b + (size_t)m0 * D) + lane; xw[0] = xr[0]; xw[1] = xr[64]; }
                    for (int r = 0; r < 32; ++r) {
                        const size_t m = (size_t)m0 + r;
                        { const size_t mn = (r < 31) ? m + 1 : m; const GAS v4u* xr = (const GAS v4u*)(X1b + mn * D) + lane; xn[0] = xr[0]; xn[1] = xr[64]; }
#pragma unroll
                        for (int j = 0; j < 2; ++j) { v[j][0] = (f32x4){pg8::bf_lo(xw[j].x), pg8::bf_hi(xw[j].x), pg8::bf_lo(xw[j].y), pg8::bf_hi(xw[j].y)}; v[j][1] = (f32x4){pg8::bf_lo(xw[j].z), pg8::bf_hi(xw[j].z), pg8::bf_lo(xw[j].w), pg8::bf_hi(xw[j].w)}; }
                        float ss = 0.f;
#pragma unroll
                        for (int j = 0; j < 2; ++j)
#pragma unroll
                            for (int q = 0; q < 2; ++q) ss += (v[j][q].x * v[j][q].x + v[j][q].y * v[j][q].y) + (v[j][q].z * v[j][q].z + v[j][q].w * v[j][q].w);
                        const float rstd = 1.0f / sqrtf(wave_sum(ss) * (1.f / D) + EPS);
                        GAS v4u* o16 = (GAS v4u*)(H2b + m * D) + lane; GAS v2u* o8 = (GAS v2u*)(ws + WS_H2Q + m * D) + lane;
#pragma unroll
                        for (int j = 0; j < 2; ++j) { const f32x4 y0 = v[j][0] * rstd * A4[j][0] + B4[j][0], y1 = v[j][1] * rstd * A4[j][1] + B4[j][1];
                            v4u o; o.x = pg8::cvt_pk_bf16(y0.x, y0.y); o.y = pg8::cvt_pk_bf16(y0.z, y0.w); o.z = pg8::cvt_pk_bf16(y1.x, y1.y); o.w = pg8::cvt_pk_bf16(y1.z, y1.w); o16[64 * j] = o;
                            o8[64 * j] = (v2u){pk4_fp8(y0.x * SC_H2, y0.y * SC_H2, y0.z * SC_H2, y0.w * SC_H2), pk4_fp8(y1.x * SC_H2, y1.y * SC_H2, y1.z * SC_H2, y1.w * SC_H2)}; }
                        xw[0] = xn[0]; xw[1] = xn[1];
                    }
                }
                asm volatile("s_waitcnt vmcnt(0)" ::: "memory");
                asm volatile("buffer_inv sc0\n\ts_waitcnt vmcnt(0)" ::: "memory");
                __syncthreads();
                {
                    const int n = lane & 31, h = lane >> 5;
                    f32x16 acc;
#pragma unroll
                    for (int i = 0; i < 16; ++i) acc[i] = 0.f;
                    const bf16* hrow = H2b + (size_t)(m0 + n) * D + 8 * h;
                    {
                        pg8::bf16x8 ha[16], hq[16];
#define RB_LD(dst_, b_) do { _Pragma("unroll") for (int i = 0; i < 16; ++i) dst_[i] = *(const pg8::bf16x8*)(hrow + 16 * ((b_) * 16 + i)); } while (0)
#define RB_MM(src_, b_) do { _Pragma("unroll") for (int i = 0; i < 16; ++i) { const int ks = (b_) * 16 + i; \
                            const pg8::bf16x8 wh = *(const LAS pg8::bf16x8*)(lds + ((ks * 2 + 0) * 64 + lane) * 16), wl = *(const LAS pg8::bf16x8*)(lds + ((ks * 2 + 1) * 64 + lane) * 16); \
                            acc = __builtin_amdgcn_mfma_f32_32x32x16_bf16(wh, src_[i], acc, 0, 0, 0); \
                            acc = __builtin_amdgcn_mfma_f32_32x32x16_bf16(wl, src_[i], acc, 0, 0, 0); } } while (0)
                        RB_LD(ha, 0); RB_LD(hq, 1);
                        asm volatile("s_waitcnt vmcnt(16)" ::: "memory");
                        RB_MM(ha, 0); RB_LD(ha, 2);
                        asm volatile("s_waitcnt vmcnt(16)" ::: "memory");
                        RB_MM(hq, 1); RB_LD(hq, 3);
                        asm volatile("s_waitcnt vmcnt(16)" ::: "memory");
                        RB_MM(ha, 2);
                        asm volatile("s_waitcnt vmcnt(0)" ::: "memory");
                        RB_MM(hq, 3);
#undef RB_LD
#undef RB_MM
                    }
                    float p[16];
#pragma unroll
                    for (int i = 0; i < 16; ++i) p[i] = acc[i] + args.in[I_BR][(i & 3) + 8 * (i >> 2) + 4 * h];
                    float cv[8]; int ce[8];
#pragma unroll
                    for (int k = 0; k < 4; ++k) { float best = -3.0e38f; int bi = 0;
#pragma unroll
                        for (int i = 0; i < 16; ++i) { if (p[i] > best) { best = p[i]; bi = i; } }
                        cv[k] = best; ce[k] = (bi & 3) + 8 * (bi >> 2) + 4 * h;
#pragma unroll
                        for (int i = 0; i < 16; ++i) p[i] = (i == bi) ? -3.0e38f : p[i]; }
#pragma unroll
                    for (int k = 0; k < 4; ++k) { cv[4 + k] = __shfl_xor(cv[k], 32); ce[4 + k] = __shfl_xor(ce[k], 32); }
                    float tv[4]; int ti[4];
#pragma unroll
                    for (int k = 0; k < 4; ++k) { float best = -3.0e38f; int be = 64, bs = 0;
#pragma unroll
                        for (int s = 0; s < 8; ++s) { const bool better = (cv[s] > best) || (cv[s] == best && ce[s] < be); if (better) { best = cv[s]; be = ce[s]; bs = s; } }
                        tv[k] = best; ti[k] = be;
#pragma unroll
                        for (int s = 0; s < 8; ++s) cv[s] = (s == bs) ? -3.0e38f : cv[s]; }
                    const float e1 = expf(tv[1] - tv[0]), e2 = expf(tv[2] - tv[0]), e3 = expf(tv[3] - tv[0]); const float inv = 1.0f / (1.0f + e1 + e2 + e3);
                    if (h == 0) { const size_t m = (size_t)m0 + n;
                        *(int4*)(top_idx + m * 4) = make_int4(ti[0], ti[1], ti[2], ti[3]);
                        *(float4*)(top_w + m * 4) = make_float4(inv, e1 * inv, e2 * inv, e3 * inv);
#pragma unroll
                        for (int k = 0; k < 4; ++k) atomicAdd((unsigned*)&hist[ti[k]], 1u); }
                }
                __syncthreads();
                if (tid < 32) blkcnt[tb * 32 + tid] = (int)hist[tid];
                __syncthreads();
            }
        }
        __syncthreads();
        {
            LAS float* scr = (LAS float*)(lds + wave * 16384);
            constexpr int I_GU = 16 * 64, I_DN = 16 * 32;
            for (int it = gw; it < NE * (I_GU + I_DN); it += NGW) {
                const int e = it / (I_GU + I_DN); int r = it % (I_GU + I_DN);
                if (r < I_GU) { const int kb = r / 64, nb = r % 64; const int n0 = 32 * nb; const int cidx = n0 & 1023; const int drow = (cidx >> 7) * 256 + (n0 >= 1024 ? 128 : 0) + (cidx & 127);
                    transpose_item_f8(args.in[I_WGU] + (size_t)e * D * 2048, 2048, D, 64 * kb, n0, ws + WS_WGU + (size_t)e * 2048 * D, drow, scr, lane, SC_W); }
                else { r -= I_GU; const int kb = r / 32, nb = r % 32;
                    transpose_item_f8(args.in[I_WDN] + (size_t)e * D * D, D, D, 64 * kb, 32 * nb, ws + WS_WDN + (size_t)e * D * D, 32 * nb, scr, lane, SC_W); }
            }
        }
        if (BOTH(4)) GRID_BAR();
    }
    STAMP(5); STAMP(6); STAMP(7);


    STAMP(8);
    if (IN(8)) {
        int tid_l = threadIdx.x; asm volatile("" : "+v"(tid_l)); const int tid = tid_l, lane = tid & 63;
        LAS int* sp_tot = (LAS int*)(lds);
        LAS int* sp_pre = sp_tot + 512;
        LAS int* tot = sp_pre + 512;
        LAS int* myoff = tot + 32;
        LAS int* pstart = myoff + 32;
        LAS unsigned* cursor = (LAS unsigned*)(pstart + 64);
        for (int tb = bx; tb < NTOK / 256; tb += G) {
            __syncthreads();
            { const int e = tid & 31, part = tid >> 5; int s_tot = 0, s_pre = 0;
                for (int B = part; B < 256; B += 16) { const int cn = blkcnt[B * 32 + e]; s_tot += cn; if (B < tb) s_pre += cn; }
                sp_tot[part * 32 + e] = s_tot; sp_pre[part * 32 + e] = s_pre; }
            __syncthreads();
            if (tid < 32) { int a = 0, p = 0; for (int q = 0; q < 16; ++q) { a += sp_tot[q * 32 + tid]; p += sp_pre[q * 32 + tid]; } tot[tid] = a; myoff[tid] = p; cursor[tid] = 0u; }
            __syncthreads();
            if (tid == 0) { int acc = 0; for (int e = 0; e < 32; ++e) { pstart[e] = acc; acc += ((tot[e] + 255) >> 8) << 8; } pstart[32] = acc; }
            __syncthreads();
            for (int q = 0; q < 2; ++q) { const int a = tid + 512 * q; const int tok = tb * 256 + (a >> 2);
                const int e = top_idx[(size_t)tok * 4 + (a & 3)]; const unsigned rnk = atomicAdd((unsigned*)&cursor[e], 1u);
                const int slot = pstart[e] + myoff[e] + (int)rnk;
                slot_tok[slot] = tok; slot_w[slot] = top_w[(size_t)tok * 4 + (a & 3)]; tok_slot[(size_t)tok * 4 + (a & 3)] = slot; }
            if (tb < 32) { const int e = tb; const int nt_e = (tot[e] + 255) >> 8;
                for (int r = tot[e] + tid; r < nt_e * 256; r += 512) { slot_tok[pstart[e] + r] = 0; slot_w[pstart[e] + r] = 0.f; }
                for (int i = tid; i < nt_e; i += 512) tile_exp[(pstart[e] >> 8) + i] = e;
                if (e == 0 && tid == 0) tile_exp[NTILE_MAX] = pstart[32] >> 8; }
        }
        if (BOTH(8)) GRID_BAR();
    }

    {
        const int pgu = 9, pdn = 10;
        if (IN(pgu) || IN(pdn)) {
            const int ntiles = tile_exp[NTILE_MAX];
            const int tile0 = 0;
            int ntc = ntiles; if (ntc < 0) ntc = 0; if (ntc > NTILE_MAX) ntc = NTILE_MAX;
            bf16* actb = (bf16*)(ws + WS_ACT);
            asm volatile("" : "+s"(actb));
            STAMP(pgu);
            if (IN(pgu)) {
                pg8::MoeOrder<true> S{(const bf16*)(ws + WS_H2Q), (const bf16*)(ws + WS_WGU), tile_exp, slot_tok, tile0, ntc, 8, G, vcu, lds + AUX_OFF + 18432};
                EpiGu E{(unsigned char*)actb, args.in[I_BGU], tile0, lds + AUX_OFF};
                pg8::gemm_phase<EpiGu, pg8::MoeOrder<true>, true>(lds, S, E);
                if (BOTH(pgu)) GRID_BAR();
            }
            STAMP(pdn);
            if (IN(pdn)) {
                pg8::MoeOrder<false> S{actb, (const bf16*)(ws + WS_WDN), tile_exp, slot_tok, tile0, ntc, 4, G, vcu, lds + AUX_OFF + 18432};
                EpiDown E{ws, args.in[I_BDN], slot_w, tile0, lds + AUX_OFF};
                pg8::gemm_phase<EpiDown, pg8::MoeOrder<false>, true>(lds, S, E);
                if (BOTH(pdn)) GRID_BAR();
            }
        }
    }

    STAMP(13);
    if (IN(13)) {
        int tid_l = threadIdx.x; asm volatile("" : "+v"(tid_l)); const int tid = tid_l, lane = tid & 63;
        for (int rb = gw; rb < NTOK / 32; rb += NGW) {
            const int b = (rb * 32) / SEQ;
            f32x4 G4[2][2], F4[2][2];
#pragma unroll
            for (int j = 0; j < 2; ++j)
#pragma unroll
                for (int q = 0; q < 2; ++q) { const int c = 8 * lane + 512 * j + 4 * q; G4[j][q] = *(const f32x4*)(modv + b * DIN + 5120 + c) * (1.0f / SC_Y); F4[j][q] = *(const f32x4*)(args.in[I_FG] + c); }
            const v2u sl = *(const v2u*)(tok_slot + (size_t)rb * 128 + 2 * lane);
            f32x4 v[2][2]; v4u xv[2], xn[2], xm[2]; v2u yv[4][2], yn[4][2], ym[4][2];
#define P13_LOAD(r_, xv_, yy_) do { const size_t m_ = (size_t)rb * 32 + (r_); const GAS v4u* xr_ = (const GAS v4u*)(X1b + m_ * D) + lane; \
                _Pragma("unroll") for (int j = 0; j < 2; ++j) xv_[j] = xr_[64 * j]; \
                _Pragma("unroll") for (int k = 0; k < 4; ++k) { const int slot_ = (int)__builtin_amdgcn_readlane((k & 1) ? sl.y : sl.x, 2 * (r_) + (k >> 1)); \
                    const GAS v2u* y8_ = (const GAS v2u*)(ws + y_tile_off(slot_ >> 8) + (size_t)(slot_ & 255) * D) + lane; \
                    _Pragma("unroll") for (int j = 0; j < 2; ++j) yy_[k][j] = y8_[64 * j]; } } while (0)
            P13_LOAD(0, xv, yv); P13_LOAD(1, xn, yn);
            for (int r = 0; r < 32; ++r) {
                const int rn = (r < 30) ? r + 2 : 31;
                P13_LOAD(rn, xm, ym);
                float ss = 0.f;
#pragma unroll
                for (int j = 0; j < 2; ++j) { typedef float f32x2c __attribute__((ext_vector_type(2)));
                    f32x2c s01 = (f32x2c){0.f, 0.f}, s23 = s01, s45 = s01, s67 = s01;
#pragma unroll
                    for (int k = 0; k < 4; ++k) { const v2u w = yv[k][j];
                        s01 += __builtin_amdgcn_cvt_pk_f32_fp8((int)w.x, false); s23 += __builtin_amdgcn_cvt_pk_f32_fp8((int)w.x, true);
                        s45 += __builtin_amdgcn_cvt_pk_f32_fp8((int)w.y, false); s67 += __builtin_amdgcn_cvt_pk_f32_fp8((int)w.y, true); }
                    v[j][0] = (f32x4){pg8::bf_lo(xv[j].x), pg8::bf_hi(xv[j].x), pg8::bf_lo(xv[j].y), pg8::bf_hi(xv[j].y)} + G4[j][0] * (f32x4){s01.x, s01.y, s23.x, s23.y};
                    v[j][1] = (f32x4){pg8::bf_lo(xv[j].z), pg8::bf_hi(xv[j].z), pg8::bf_lo(xv[j].w), pg8::bf_hi(xv[j].w)} + G4[j][1] * (f32x4){s45.x, s45.y, s67.x, s67.y};
#pragma unroll
                    for (int q = 0; q < 2; ++q) ss += (v[j][q].x * v[j][q].x + v[j][q].y * v[j][q].y) + (v[j][q].z * v[j][q].z + v[j][q].w * v[j][q].w); }
                const float rstd = 1.0f / sqrtf(wave_sum(ss) * (1.f / D) + EPS);
                GAS f32x4* xo = (GAS f32x4*)(args.out + ((size_t)rb * 32 + r) * D) + 2 * lane;
#pragma unroll
                for (int j = 0; j < 2; ++j)
#pragma unroll
                    for (int q = 0; q < 2; ++q) xo[128 * j + q] = v[j][q] * rstd * F4[j][q];
#pragma unroll
                for (int j = 0; j < 2; ++j) { xv[j] = xn[j]; xn[j] = xm[j];
#pragma unroll
                    for (int k = 0; k < 4; ++k) { yv[k][j] = yn[k][j]; yn[k][j] = ym[k][j]; } }
            }
#undef P13_LOAD
        }
    }
#ifdef DIAG_A_LO
    {
        GRID_BAR(); STAMP(14); GRID_BAR();
        const float us_a = (float)(__hip_atomic_load(ctl + 64 + DIAG_A_HI, RLX_AGENT) - __hip_atomic_load(ctl + 64 + DIAG_A_LO, RLX_AGENT)) * 0.01f;
        const float us_b = (float)(__hip_atomic_load(ctl + 64 + DIAG_B_HI, RLX_AGENT) - __hip_atomic_load(ctl + 64 + DIAG_B_LO, RLX_AGENT)) * 0.01f;
        const float sc = 1.0f + 1e-4f * (10.0f * rintf(us_a * 0.1f)); const float us_bq = 10.0f * rintf(us_b * 0.1f);
        for (size_t i = (size_t)bx * 512 + threadIdx.x; i < (size_t)NTOK * D; i += (size_t)G * 512) { float v = args.out[i] * sc; if (i == 0) v += us_bq * 0.25f; args.out[i] = v; }
    }
#endif
#undef IN
#undef BOTH
}

extern "C" void kernel_launch(void* const* d_in, const int* in_sizes, int n_in, void* d_out, int out_size, void* d_ws, size_t ws_size, hipStream_t stream) {
    static int grid = 0;
    if (grid == 0) {
        if (n_in != 28 || out_size != NTOK * D || ws_size < WS_TOTAL) { fprintf(stderr, "kernel_launch: unexpected shapes (n_in %d out %d ws %zu)\n", n_in, out_size, ws_size); grid = -1; return; }
        int dev = 0, cus = 0, per_cu = 0;
        if (hipGetDevice(&dev) != hipSuccess || hipDeviceGetAttribute(&cus, hipDeviceAttributeMultiprocessorCount, dev) != hipSuccess) { grid = -1; return; }
        if (hipFuncSetAttribute((const void*)mega_fwd, hipFuncAttributeMaxDynamicSharedMemorySize, LDS_BYTES) != hipSuccess) { fprintf(stderr, "kernel_launch: hipFuncSetAttribute failed\n"); grid = -1; return; }
        if (hipOccupancyMaxActiveBlocksPerMultiprocessor(&per_cu, (const void*)mega_fwd, NWAVES * 64, LDS_BYTES) != hipSuccess || per_cu < 1)
            fprintf(stderr, "kernel_launch: occupancy query reports %d workgroups per CU\n", per_cu);
        (void)hipGetLastError();
        grid = cus;
        if (grid != NTOK / 256) { fprintf(stderr, "kernel_launch: built for %d CUs, device has %d\n", NTOK / 256, cus); grid = -1; return; }
    }
    if (grid < 0) return;
    (void)hipMemsetAsync((char*)d_ws + WS_CTL, 0, CTL_ZERO_BYTES, stream);
    Args a{};
    for (int i = 0; i < 28; ++i) a.in[i] = (const float*)d_in[i];
    a.out = (float*)d_out; a.ws = (unsigned char*)d_ws;
#if MK_PER_PHASE
    for (int p = 0; p < N_PHASES; ++p) { a.ph_lo = p; a.ph_hi = p + 1; a.li = p; a.pad = 0; hipLaunchKernelGGL(mega_fwd, dim3(grid), dim3(NWAVES * 64), LDS_BYTES, stream, a); }
#else
    a.ph_lo = 0; a.ph_hi = N_PHASES; a.li = 0; a.pad = 0;
    hipLaunchKernelGGL(mega_fwd, dim3(grid), dim3(NWAVES * 64), LDS_BYTES, stream, a);
#endif
}
```

```cpp
#include <hip/hip_runtime.h>
#include <cstdio>
#include <cstdint>

#ifndef MK_PER_PHASE
#define MK_PER_PHASE 0
#endif

namespace pg8 {
#define PG8_LAS __attribute__((address_space(3)))
typedef unsigned short bf16_t;
typedef short bf16x8 __attribute__((ext_vector_type(8)));
typedef float f32x4 __attribute__((ext_vector_type(4)));
typedef float f32x2 __attribute__((ext_vector_type(2)));
typedef unsigned u32x4 __attribute__((ext_vector_type(4)));
typedef unsigned u32x2 __attribute__((ext_vector_type(2)));
constexpr int BM = 256, BK = 64, HALF = 128, HTB = HALF * BK * 2, STAGE_BYTES = 8 * HTB, NXCD = 8, WGM = 8, KD = 1024;

__host__ __device__ __forceinline__ int lds_byte(int r, int c) { const int st = (r >> 4) * 2 + (c >> 5), rr = r & 15, cc = c & 31, ob = rr * 64 + cc * 2; return st * 1024 + (ob ^ (((ob >> 9) & 1) << 5)); }
__host__ __device__ __forceinline__ void stage_rc(int b, int& R, int& C) { const int st = b / 1024, sb = b % 1024, swz = sb ^ (((sb >> 9) & 1) << 5); R = (st >> 1) * 16 + swz / 64; C = (st & 1) * 32 + (swz % 64) / 2; }
__host__ __device__ __forceinline__ int perm32(int rho) { const int n = rho >> 4, i = rho & 15; return 8 * (i >> 2) + 4 * n + (i & 3); }

struct Unit { int pm, pn, e, par; };

template <bool FP8_> struct PlainOrderT {
    static constexpr bool GATHER = false, FP8 = FP8_; static constexpr int KB = FP8_ ? KD : KD * 2;
    const bf16_t* A; const bf16_t* Bt; int nM, nN, nwg, G, c;
    __device__ void init(const bf16_t* A_, const bf16_t* Bt_, int M, int N, int G_, int c_) { A = A_; Bt = Bt_; nM = M / BM; nN = N / BM; nwg = nM * nN; G = G_; c = c_; }
    __device__ __forceinline__ bool next(int i, Unit& u) const {
        const long L = (long)i * G + c; if (L >= nwg) return false;
        int wgid = (int)L; { const int q = nwg / NXCD, r = nwg % NXCD, xcd = wgid % NXCD, off = wgid / NXCD; wgid = (xcd < r ? xcd * (q + 1) : r * (q + 1) + (xcd - r) * q) + off; }
        const int nig = WGM * nN, gid = wgid / nig, fm = gid * WGM, gsz = (nM - fm) < WGM ? (nM - fm) : WGM;
        u.pm = fm + ((wgid % nig) % gsz); u.pn = (wgid % nig) / gsz; u.e = 0; return true;
    }
    __device__ __forceinline__ const char* a_base(const Unit& u) const { return (const char*)A + (size_t)u.pm * ((size_t)BM * KB); }
    __device__ __forceinline__ const char* b_base(const Unit& u) const { return (const char*)Bt + (size_t)u.pn * ((size_t)BM * KB); }
    __device__ __forceinline__ void load_rows(const Unit&, unsigned (&)[2][2]) const {}
    __device__ __forceinline__ void load_rows_lds(const Unit&, unsigned (&)[2][2]) const {}
    __device__ __forceinline__ void prefetch_rows(const Unit&, int, int) const {}
    __device__ __forceinline__ void init_lds(int) const {}
};
typedef PlainOrderT<false> PlainOrder;
struct PanelOrder {
    static constexpr bool GATHER = false, FP8 = false; static constexpr int KB = KD * 2;
    const bf16_t* A; const bf16_t* Bt; int panel, nN;
    __device__ __forceinline__ bool next(int i, Unit& u) const { if (i >= nN) return false; u.pm = panel; u.pn = (i + panel) & (nN - 1); u.e = 0; return true; }
    __device__ __forceinline__ const char* a_base(const Unit& u) const { return (const char*)A + (size_t)u.pm * ((size_t)BM * KD * 2); }
    __device__ __forceinline__ const char* b_base(const Unit& u) const { return (const char*)Bt + (size_t)u.pn * ((size_t)BM * KD * 2); }
    __device__ __forceinline__ void load_rows(const Unit&, unsigned (&)[2][2]) const {}
    __device__ __forceinline__ void load_rows_lds(const Unit&, unsigned (&)[2][2]) const {}
    __device__ __forceinline__ void prefetch_rows(const Unit&, int, int) const {}
    __device__ __forceinline__ void init_lds(int) const {}
};
template <bool GATHER_> struct MoeOrder {
    static constexpr bool GATHER = GATHER_, FP8 = true; static constexpr int KB = KD;
    const bf16_t* A; const bf16_t* Bt; const int* tile_exp; const int* slot_tok; int tile0, ntile, nN, G, c; PG8_LAS unsigned char* aux;
    __device__ __forceinline__ bool next(int i, Unit& u) const {
        const int L = i * G + c; if (L >= ntile * nN) return false;
        const int sh = (nN == 8) ? 3 : 2; const int pl = L >> sh; u.pn = L & (nN - 1); u.pm = tile0 + pl; u.e = ((const PG8_LAS int*)(aux + 6144))[u.pm]; return true;
    }
    __device__ __forceinline__ const char* a_base(const Unit& u) const { return GATHER ? (const char*)A : (const char*)A + (size_t)(u.pm - tile0) * ((size_t)BM * KB); }
    __device__ __forceinline__ const char* b_base(const Unit& u) const { return (const char*)Bt + ((size_t)u.e * nN + u.pn) * ((size_t)BM * KB); }
    __device__ __forceinline__ void load_rows(const Unit& u, unsigned (&out)[2][2]) const {
#pragma unroll
        for (int i = 0; i < 2; ++i) { int R, C; stage_rc((int)threadIdx.x * 16 + i * 8192, R, C);
#pragma unroll
            for (int h = 0; h < 2; ++h) out[h][i] = (unsigned)slot_tok[u.pm * BM + h * HALF + R] * (unsigned)KB + (unsigned)C * 2u; }
    }
    __device__ __forceinline__ void load_rows_lds(const Unit& u, unsigned (&out)[2][2]) const {
        const PG8_LAS int* idx = (const PG8_LAS int*)(aux + u.par * 3072 + 2048);
#pragma unroll
        for (int i = 0; i < 2; ++i) { int R, C; stage_rc((int)threadIdx.x * 16 + i * 8192, R, C);
#pragma unroll
            for (int h = 0; h < 2; ++h) out[h][i] = (unsigned)idx[h * HALF + R] * (unsigned)KB + (unsigned)C * 2u; }
    }
    __device__ __forceinline__ void init_lds(int tid) const { for (int i = tid; i < 1056; i += 512) ((PG8_LAS int*)(aux + 6144))[i] = tile_exp[i]; __syncthreads(); }
    __device__ __forceinline__ void prefetch_rows(const Unit& nx, int wid, int lane) const {
        if (GATHER && wid == 2) __builtin_amdgcn_global_load_lds((const unsigned*)(slot_tok + nx.pm * BM + lane * 4), (PG8_LAS unsigned*)(aux + nx.par * 3072 + 2048), 16, 0, 0);
    }
};

typedef __bf16 bf16x2_n __attribute__((ext_vector_type(2)));
__device__ __forceinline__ unsigned cvt_pk_bf16(float lo, float hi) { const f32x2 v = {lo, hi}; const bf16x2_n r = __builtin_convertvector(v, bf16x2_n); return __builtin_bit_cast(unsigned, r); }
__device__ __forceinline__ float bf_lo(unsigned w) { return __uint_as_float(w << 16); }
__device__ __forceinline__ float bf_hi(unsigned w) { return __uint_as_float(w & 0xffff0000u); }

template <class Epi, class Sched, bool ALIGN_EPI>
__device__ __forceinline__ void gemm_phase(PG8_LAS unsigned char* lds, const Sched& S, const Epi& E) {
    static_assert(ALIGN_EPI, "the store-tolerant waits below assume aligned epilogues");
    int tid_ = threadIdx.x; asm volatile("" : "+v"(tid_));
    const int tid = tid_, wid = __builtin_amdgcn_readfirstlane(tid >> 6), lane = tid & 63, wr = wid >> 2, wc = wid & 3, fr = lane & 15, fq = lane >> 4;
    constexpr int KB = Sched::KB, nt = KB / (BK * 2);
    unsigned voffA[2], voffB[2];
#pragma unroll
    for (int i = 0; i < 2; ++i) { int R, C; stage_rc(tid * 16 + i * 8192, R, C); const int Rb = Epi::BREMAP ? (64 * (R >> 5) + perm32(R & 31)) : ((R & ~31) + perm32(R & 31));
        voffA[i] = (unsigned)(R * KB + C * 2); voffB[i] = (unsigned)(Rb * KB + C * 2); }
    constexpr size_t kstep = (size_t)(BK * 2);
    constexpr size_t hstep = (size_t)HALF * KB;
    constexpr size_t hstepB = Epi::BREMAP ? (size_t)32 * KB : hstep;
    const unsigned ldsw = (unsigned)wid * 1024u;
    const int aoff = lds_byte(wr * 64 + fr, fq * 8), boff = lds_byte(wc * 32 + fr, fq * 8);
#define PG8_SA(b, h) (((b) * 2 + (h)) * HTB)
#define PG8_SB(b, h) ((4 + (b) * 2 + (h)) * HTB)
#define PG8_STAGE(bufoff, gbase, voff) do { _Pragma("unroll") for (int _i = 0; _i < 2; ++_i) \
        __builtin_amdgcn_global_load_lds((const unsigned*)((const char*)(gbase) + (voff)[_i]), (PG8_LAS unsigned*)(lds + (bufoff) + ldsw + _i * 8192), 16, 0, 0); } while (0)
#define PG8_STAGE_B(b, h, base) PG8_STAGE(PG8_SB(b, h), (base) + (h) * hstepB, voffB)
#define PG8_STAGE_A(b, h, base, GO) do { if constexpr (Sched::GATHER) { PG8_STAGE(PG8_SA(b, h), (base), GO[h]); } else { PG8_STAGE(PG8_SA(b, h), (base) + (h) * hstep, voffA); } } while (0)
#define PG8_LDA(dst, b, h) do { _Pragma("unroll") for (int m = 0; m < 4; ++m) _Pragma("unroll") for (int k = 0; k < 2; ++k) dst[m][k] = *(const PG8_LAS bf16x8*)(lds + PG8_SA(b, h) + aoff + m * 2048 + k * 1024); } while (0)
#define PG8_LDB(dst, b, h) do { _Pragma("unroll") for (int n = 0; n < 2; ++n) _Pragma("unroll") for (int k = 0; k < 2; ++k) dst[n][k] = *(const PG8_LAS bf16x8*)(lds + PG8_SB(b, h) + boff + n * 2048 + k * 1024); } while (0)
#define PG8_MMA(ai, bj, At, Bt) do { __builtin_amdgcn_s_setprio(1); _Pragma("unroll") for (int m = 0; m < 4; ++m) _Pragma("unroll") for (int n = 0; n < 2; ++n) { \
        if constexpr (Sched::FP8) { typedef int v4i_ __attribute__((ext_vector_type(4))); \
            acc[ai][bj][m][n] = __builtin_amdgcn_mfma_scale_f32_16x16x128_f8f6f4(__builtin_shufflevector(__builtin_bit_cast(v4i_, Bt[n][0]), __builtin_bit_cast(v4i_, Bt[n][1]), 0, 1, 2, 3, 4, 5, 6, 7), \
                __builtin_shufflevector(__builtin_bit_cast(v4i_, At[m][0]), __builtin_bit_cast(v4i_, At[m][1]), 0, 1, 2, 3, 4, 5, 6, 7), acc[ai][bj][m][n], 0, 0, 0, 0, 0, 0); } \
        else { _Pragma("unroll") for (int k = 0; k < 2; ++k) acc[ai][bj][m][n] = __builtin_amdgcn_mfma_f32_16x16x32_bf16(Bt[n][k], At[m][k], acc[ai][bj][m][n], 0, 0, 0); } } \
        __builtin_amdgcn_s_setprio(0); } while (0)
#define PG8_WAIT_V(n) asm volatile("s_waitcnt vmcnt(" #n ")" ::: "memory")
#define PG8_WAIT_L(n) asm volatile("s_waitcnt lgkmcnt(" #n ")" ::: "memory")
#define PG8_BAR __builtin_amdgcn_s_barrier()
#define PG8_SCHED __builtin_amdgcn_sched_barrier(0)
    Unit cur, nxt; int ui = 0;
    S.init_lds(tid);
    if (!S.next(0, cur)) return;
    f32x4 acc[2][2][4][2];
#pragma unroll
    for (int a = 0; a < 2; ++a)
#pragma unroll
        for (int b = 0; b < 2; ++b)
#pragma unroll
            for (int m = 0; m < 4; ++m)
#pragma unroll
                for (int n = 0; n < 2; ++n) acc[a][b][m][n] = (f32x4){0.f, 0.f, 0.f, 0.f};
    bf16x8 At[4][2], B0[2][2], B1[2][2];
    unsigned gA[2][2] = {{0u, 0u}, {0u, 0u}};
    const char* cA = S.a_base(cur); const char* cB = S.b_base(cur);
    if constexpr (Sched::GATHER) S.load_rows(cur, gA);
    PG8_STAGE_B(0, 0, cB); PG8_STAGE_B(0, 1, cB); PG8_STAGE_A(0, 0, cA, gA); PG8_STAGE_A(0, 1, cA, gA);
    if (wr == 1) PG8_BAR;
    PG8_WAIT_V(2); PG8_BAR;
    PG8_STAGE_B(1, 0, cB + kstep); PG8_STAGE_A(1, 0, cA + kstep, gA); PG8_STAGE_B(1, 1, cB + kstep);
    PG8_WAIT_V(6); PG8_BAR;
    cur.par = 0;
    for (;;) {
        const bool has_next = S.next(ui + 1, nxt); nxt.par = (ui + 1) & 1;
        if (has_next) S.prefetch_rows(nxt, wid, lane);
        E.prefetch(cur, wid, lane);
        const char* nA = has_next ? S.a_base(nxt) : cA; const char* nB = has_next ? S.b_base(nxt) : cB;
#define PG8_TRIP(t, last, WV, SKIP11) do { \
            const char* a1 = cA + (size_t)((t) + 1) * kstep; \
            const char* a2 = (last) ? nA : cA + (size_t)((t) + 2) * kstep; const char* b2 = (last) ? nB : cB + (size_t)((t) + 2) * kstep; \
            const char* a3 = a2 + kstep; const char* b3 = b2 + kstep; \
            PG8_LDB(B0, 0, 0); PG8_LDB(B1, 0, 1); PG8_SCHED; PG8_LDA(At, 0, 0); if (!(SKIP11)) PG8_STAGE_A(1, 1, a1, gA); \
            if constexpr (Sched::GATHER) { if ((last) && has_next) S.load_rows_lds(nxt, gA); } \
            WV; PG8_WAIT_L(0); PG8_BAR; PG8_MMA(0, 0, At, B0); PG8_MMA(0, 1, At, B1); PG8_BAR; PG8_SCHED; \
            PG8_LDA(At, 0, 1); PG8_STAGE_B(0, 0, b2); PG8_STAGE_B(0, 1, b2); PG8_STAGE_A(0, 0, a2, gA); \
            WV; PG8_WAIT_L(0); PG8_BAR; PG8_MMA(1, 0, At, B0); PG8_MMA(1, 1, At, B1); PG8_BAR; PG8_SCHED; \
            PG8_LDB(B0, 1, 0); PG8_LDB(B1, 1, 1); PG8_SCHED; PG8_LDA(At, 1, 0); PG8_STAGE_A(0, 1, a2, gA); \
            WV; PG8_WAIT_L(0); PG8_BAR; PG8_MMA(0, 0, At, B0); PG8_MMA(0, 1, At, B1); PG8_BAR; PG8_SCHED; \
            PG8_LDA(At, 1, 1); PG8_STAGE_B(1, 0, b3); PG8_STAGE_B(1, 1, b3); PG8_STAGE_A(1, 0, a3, gA); \
            PG8_WAIT_V(8); PG8_WAIT_L(0); PG8_BAR; PG8_MMA(1, 0, At, B0); PG8_MMA(1, 1, At, B1); PG8_BAR; PG8_SCHED; } while (0)
        int rl = __builtin_amdgcn_readfirstlane((ui > 0) ? 1 : 0); asm volatile("" : "+s"(rl));
#define PG8_WV() do { if (rl) { if constexpr (Epi::NST >= 16) PG8_WAIT_V(24); else if constexpr (Epi::NST >= 8) PG8_WAIT_V(16); else PG8_WAIT_V(12); } else PG8_WAIT_V(8); } while (0)
#pragma nounroll
        for (int t = 0; t < nt; t += 2) { const bool last = (t == nt - 2); PG8_TRIP(t, last, PG8_WV(), rl); rl = 0; asm volatile("" : "+s"(rl)); }
#undef PG8_WV
#undef PG8_TRIP
        if constexpr (ALIGN_EPI) { if (wr == 0) PG8_BAR; }
        if (has_next) { const char* nA1 = nA + kstep; asm volatile("" : "+s"(nA1));
            PG8_STAGE_A(1, 1, nA1, gA); }
        E(acc, cur, wr, wc, fr, fq);
        if (!has_next) break;
#pragma unroll
        for (int a = 0; a < 2; ++a)
#pragma unroll
            for (int b = 0; b < 2; ++b)
#pragma unroll
                for (int m = 0; m < 4; ++m)
#pragma unroll
                    for (int n = 0; n < 2; ++n) acc[a][b][m][n] = (f32x4){0.f, 0.f, 0.f, 0.f};
        cur = nxt; cA = nA; cB = nB; ++ui;
        if constexpr (ALIGN_EPI) { if (wr == 1) PG8_BAR; }
    }
    PG8_WAIT_V(0);
    if constexpr (!ALIGN_EPI) { if (wr == 0) PG8_BAR; }
    PG8_BAR;
#undef PG8_SA
#undef PG8_SB
#undef PG8_STAGE
#undef PG8_STAGE_A
#undef PG8_STAGE_B
#undef PG8_LDA
#undef PG8_LDB
#undef PG8_MMA
#undef PG8_WAIT_V
#undef PG8_WAIT_L
#undef PG8_BAR
#undef PG8_SCHED
}
}

constexpr int NWAVES = 8;
constexpr int BATCH = 16, SEQ = 4096, D = 1024, NTOK = BATCH * SEQ, DIN = 6144, NE = 32, TOPK = 4;
constexpr int CAPROWS = NTOK * TOPK + NE * 256, NTILE_MAX = CAPROWS / 256;
constexpr int TILES_A = 512, TILES_B_MAX = NTILE_MAX - TILES_A;
constexpr float EPS = 1e-6f;
constexpr int N_PHASES = 14;

constexpr size_t MiB = 1u << 20;
constexpr size_t WS_CTL = 0, CTL_ZERO_BYTES = 32768;
constexpr size_t WS_MOD = 1 * MiB;
constexpr size_t WS_WIN = 2 * MiB;
constexpr size_t WS_WBRR = 14 * MiB, WS_WBRS = 16 * MiB, WS_WOUT = 18 * MiB;
constexpr size_t WS_SGW = 20 * MiB;
constexpr size_t WS_TOPI = 21 * MiB, WS_TOPW = 22 * MiB, WS_TSLOT = 23 * MiB;
constexpr size_t WS_SLOTTOK = 24 * MiB;
constexpr size_t WS_SLOTW = 26 * MiB;
constexpr size_t WS_BLKCNT = 28 * MiB;
constexpr size_t WS_TILEEXP = 28 * MiB + 65536;
constexpr size_t WS_H = 32 * MiB;
constexpr size_t WS_H8 = 928 * MiB;
constexpr size_t WS_SGST = 992 * MiB;
constexpr size_t WS_WIN8 = 29 * MiB;
constexpr size_t WS_Z = 160 * MiB;
constexpr size_t ZREG = (size_t)NTOK * D * 2;
constexpr size_t WS_X1B = WS_Z;
constexpr size_t WS_H2 = WS_Z + ZREG;
constexpr size_t WS_WGU = 32 * MiB;
constexpr size_t WS_H2Q = 96 * MiB;
constexpr size_t WS_ACT = 416 * MiB;
constexpr size_t WS_YLO = 688 * MiB;
constexpr size_t WS_WDN = 944 * MiB;
constexpr size_t WS_YX = 1008 * MiB;
constexpr size_t WS_TOTAL = 1024 * MiB;
static_assert(WS_Z + 6 * ZREG <= 1024 * MiB, "z fits");
static_assert(WS_ACT + (size_t)NTILE_MAX * 256 * D <= WS_YLO && WS_YLO + (size_t)TILES_A * 256 * D * 2 <= WS_WDN && WS_WDN + (size_t)NE * D * D * 2 <= WS_YX && WS_YX + (size_t)32 * 256 * D * 2 <= WS_TOTAL && WS_ACT >= WS_H2 + ZREG, "moe map");
__host__ __device__ __forceinline__ size_t y_tile_off(int tile) {
    return tile < 512 ? WS_YLO + (size_t)tile * (256 * D * 2) : (tile < 768 ? WS_H2 + (size_t)(tile - 512) * (256 * D * 2) : (tile < 1024 ? WS_WGU + (size_t)(tile - 768) * (256 * D * 2) : WS_YX + (size_t)(tile - 1024) * (256 * D * 2)));
}
constexpr int CW_TMO = 0;
constexpr int CW_BAR = 4096;

constexpr int RING_BYTES = 131072;
constexpr int MISC_OFF = RING_BYTES + 320;
constexpr int AUX_OFF = RING_BYTES + 1024;
constexpr int LDS_BYTES = 163840;

#define GAS __attribute__((address_space(1)))
#define LAS __attribute__((address_space(3)))
typedef unsigned short bf16;
typedef unsigned v4u __attribute__((ext_vector_type(4)));
typedef unsigned v2u __attribute__((ext_vector_type(2)));
typedef float f32x4 __attribute__((ext_vector_type(4)));
typedef GAS unsigned gu32;
#define RLX_AGENT __ATOMIC_RELAXED, __HIP_MEMORY_SCOPE_AGENT
#define LDS_WAIT() asm volatile("s_waitcnt lgkmcnt(0)" ::: "memory")
#define VM_WAIT() asm volatile("s_waitcnt vmcnt(0)" ::: "memory")
__device__ __forceinline__ unsigned f2bf(float f) { unsigned u = __builtin_bit_cast(unsigned, f); return (u + 0x7fffu + ((u >> 16) & 1u)) >> 16; }
__device__ __forceinline__ unsigned pk2(float lo, float hi) { return f2bf(lo) | (f2bf(hi) << 16); }
__device__ __forceinline__ float bf2f(bf16 b) { return __uint_as_float(((unsigned)b) << 16); }
__device__ __forceinline__ unsigned pk4_fp8(float a, float b, float c, float d) {
    a = __builtin_amdgcn_fmed3f(a, -448.0f, 448.0f); b = __builtin_amdgcn_fmed3f(b, -448.0f, 448.0f); c = __builtin_amdgcn_fmed3f(c, -448.0f, 448.0f); d = __builtin_amdgcn_fmed3f(d, -448.0f, 448.0f);
    int w = __builtin_amdgcn_cvt_pk_fp8_f32(a, b, 0, false); w = __builtin_amdgcn_cvt_pk_fp8_f32(c, d, w, true); return (unsigned)w;
}
constexpr float SC_H2 = 8.0f, SC_W = 128.0f, SC_ACT = 4.0f, SC_Y = 32.0f;

#define XB_TMO      128
#define XB_XCNT(j)  (256  + 64 * (j))
#define XB_XSUB(j)  (1280 + 64 * (j))
#define XB_XGEN(j)  (2304 + 64 * (j))
#define XB_TOP      3328
#define XB_TOPGEN   3392
#define XCD_BAR_WORDS 3456
#define XB_SPIN_CAP (1u << 18)
__device__ __forceinline__ unsigned xb_ld(unsigned* p)              { return __hip_atomic_load(p, __ATOMIC_RELAXED, __HIP_MEMORY_SCOPE_AGENT); }
__device__ __forceinline__ unsigned xb_add(unsigned* p, unsigned v) { return __hip_atomic_fetch_add(p, v, __ATOMIC_RELAXED, __HIP_MEMORY_SCOPE_AGENT); }
__device__ __forceinline__ unsigned xb_xcc_id() { return (unsigned)__builtin_amdgcn_s_getreg((3 << 11) | 20) & 0xFu; }
#define XB_SPIN(cond, bar) do { unsigned _sp = 0; while (cond) { __builtin_amdgcn_s_sleep(1); \
    if ((++_sp & 255u) == 0u) { if (xb_ld(&(bar)[XB_TMO])) break; if (_sp > XB_SPIN_CAP) { atomicAdd(&(bar)[XB_TMO], 1u); break; } } } } while (0)
struct XcdBarrier { unsigned* bar; unsigned x; volatile LAS unsigned* st; };
__device__ __forceinline__ XcdBarrier xcd_barrier_post(unsigned* bar, volatile LAS unsigned* st) {
    XcdBarrier b; b.bar = bar; b.x = xb_xcc_id(); b.st = st;
    if (threadIdx.x == 0) (void)xb_add(&bar[XB_XCNT(b.x)], 1u);
    return b;
}
__device__ __forceinline__ void xcd_barrier_complete(unsigned* bar, unsigned x, unsigned& nloc, unsigned& nx) {
    const unsigned G = gridDim.x * gridDim.y * gridDim.z;
    unsigned sum, cnt, mine, sp = 0u;
    for (;;) {
        sum = 0u; cnt = 0u; mine = 0u;
#pragma unroll
        for (unsigned j = 0; j < 16; ++j) { const unsigned c = xb_ld(&bar[XB_XCNT(j)]); sum += c; cnt += (c > 0u) ? 1u : 0u; mine = (j == x) ? c : mine; }
        if (sum == G) break;
        __builtin_amdgcn_s_sleep(1);
        if ((++sp & 255u) == 0u) { if (xb_ld(&bar[XB_TMO])) break; if (sp > XB_SPIN_CAP) { atomicAdd(&bar[XB_TMO], 1u); break; } }
    }
    nloc = mine > 0u ? mine : 1u; nx = cnt > 0u ? cnt : 1u;
}
__device__ __forceinline__ void xcd_barrier(const XcdBarrier& b) {
    asm volatile("s_waitcnt vmcnt(0)" ::: "memory");
    __syncthreads();
    if (threadIdx.x == 0) {
        unsigned* bar = b.bar;
        __builtin_amdgcn_s_waitcnt(0);
        unsigned nloc = b.st[0], nx = b.st[1];
        if (nloc == 0u) { xcd_barrier_complete(bar, b.x, nloc, nx); b.st[0] = nloc; b.st[1] = nx; }
        const unsigned old = xb_add(&bar[XB_XSUB(b.x)], 1u);
        const unsigned gen = old / nloc;
        if (old + 1u == (gen + 1u) * nloc) {
            __builtin_amdgcn_fence(__ATOMIC_RELEASE, "agent");
            asm volatile("s_waitcnt vmcnt(0)" ::: "memory");
            const unsigned og = xb_add(&bar[XB_TOP], 1u);
            const unsigned tg = og / nx;
            if (og + 1u == (tg + 1u) * nx) xb_add(&bar[XB_TOPGEN], 1u);
            else XB_SPIN(xb_ld(&bar[XB_TOPGEN]) == tg, bar);
            __builtin_amdgcn_fence(__ATOMIC_ACQUIRE, "agent");
            xb_add(&bar[XB_XGEN(b.x)], 1u);
            asm volatile("s_waitcnt vmcnt(0)" ::: "memory");
        } else {
            XB_SPIN(xb_ld(&bar[XB_XGEN(b.x)]) == gen, bar);
            __builtin_amdgcn_fence(__ATOMIC_ACQUIRE, "agent");
            asm volatile("s_waitcnt vmcnt(0)" ::: "memory");
        }
    }
    __syncthreads();
}

__device__ __forceinline__ float wave_sum(float v) {
#pragma unroll
    for (int o = 1; o < 64; o <<= 1) v += __shfl_xor(v, o);
    return v;
}
__device__ __forceinline__ float fast_sigmoid(float x) { return __builtin_amdgcn_rcpf(1.0f + __builtin_amdgcn_exp2f(-1.4426950409f * x)); }
__device__ __forceinline__ float gelu_tanh(float x) { const float a = x * (1.5957691216f + 0.0713548163f * x * x); return x * fast_sigmoid(a); }

__device__ __forceinline__ void stage_store128(LAS unsigned char* stg, int lane, int fr, int fq, pg8::u32x4 w0, pg8::u32x4 w1, bf16* gp, size_t ld8) {
    *(LAS pg8::u32x4*)(stg + fr * 144 + fq * 16) = w0; *(LAS pg8::u32x4*)(stg + fr * 144 + 64 + fq * 16) = w1;
    const pg8::u32x4 r0 = *(const LAS pg8::u32x4*)(stg + (lane >> 3) * 144 + (lane & 7) * 16), r1 = *(const LAS pg8::u32x4*)(stg + ((lane >> 3) + 8) * 144 + (lane & 7) * 16);
    *(pg8::u32x4*)gp = r0; *(pg8::u32x4*)(gp + ld8) = r1;
}
__device__ __forceinline__ void stage_store64(LAS unsigned char* stg, int lane, int fr, int fq, pg8::u32x4 w, bf16* gp) {
    *(LAS pg8::u32x4*)(stg + fr * 80 + fq * 16) = w;
    const pg8::u32x4 r = *(const LAS pg8::u32x4*)(stg + (lane >> 2) * 80 + (lane & 3) * 16);
    *(pg8::u32x4*)gp = r;
}
#define EPI_STG() (lds_epi + (wr * 4 + wc) * 2304)

template <bool F8> struct EpiZT {
    static constexpr bool PERM = true, BREMAP = true; static constexpr int NST = 16;
    bf16* Z; LAS unsigned char* lds_epi; int pn0; float* sgst;
    __device__ __forceinline__ void prefetch(const pg8::Unit&, int, int) const {}
    template <int MODE, bool ST> __device__ __forceinline__ void body(const pg8::f32x4 (&acc)[2][2][4][2], bf16* base, int lane, int wr, int wc, int fr, int fq, float* stp) const {
#pragma unroll
        for (int ai = 0; ai < 2; ++ai)
#pragma unroll
            for (int m = 0; m < 4; ++m) { pg8::u32x4 w[2]; pg8::f32x2 s1 = (pg8::f32x2){0.f, 0.f}, s2 = s1;
#pragma unroll
                for (int bj = 0; bj < 2; ++bj) { unsigned pk[4];
#pragma unroll
                    for (int q = 0; q < 4; ++q) { const pg8::f32x4 a4 = acc[ai][bj][m][q >> 1]; pg8::f32x2 x = (pg8::f32x2){a4[2 * (q & 1)], a4[2 * (q & 1) + 1]}; if constexpr (F8) x = x * (1.0f / (SC_H2 * SC_W)); pg8::f32x2 v;
                        if constexpr (MODE == 0) v = x;
                        else if constexpr (MODE == 1) {
                            const pg8::f32x2 t = x * ((x * x) * (-0.10294324f) + (-2.3022082f));
                            const pg8::f32x2 d = (pg8::f32x2){__builtin_amdgcn_exp2f(t.x), __builtin_amdgcn_exp2f(t.y)} + 1.0f;
                            v = x * (pg8::f32x2){__builtin_amdgcn_rcpf(d.x), __builtin_amdgcn_rcpf(d.y)}; }
                        else { const pg8::f32x2 t = x * (-1.4426950409f);
                            const pg8::f32x2 d = (pg8::f32x2){__builtin_amdgcn_exp2f(t.x), __builtin_amdgcn_exp2f(t.y)} + 1.0f;
                            v = (pg8::f32x2){__builtin_amdgcn_rcpf(d.x), __builtin_amdgcn_rcpf(d.y)}; }
                        if constexpr (ST) { s1 += v; s2 += v * v; }
                        pk[q] = pg8::cvt_pk_bf16(v.x, v.y); }
                    w[bj] = (pg8::u32x4){pk[0], pk[1], pk[2], pk[3]}; }
                if constexpr (ST) { float a = s1.x + s1.y, b = s2.x + s2.y; a += __shfl_xor(a, 16); b += __shfl_xor(b, 16); a += __shfl_xor(a, 32); b += __shfl_xor(b, 32);
                    if (fq == 0) *(pg8::f32x2*)(stp + (size_t)(ai * 128 + m * 16) * 32) = (pg8::f32x2){a, b}; }
                stage_store128(EPI_STG(), lane, fr, fq, w[0], w[1], base + (size_t)(ai * 128 + m * 16) * D, (size_t)8 * D); }
    }
    __device__ __forceinline__ void operator()(const pg8::f32x4 (&acc)[2][2][4][2], const pg8::Unit& u, int wr, int wc, int fr, int fq) const {
        const int pnz = F8 ? (u.pn < 4 ? u.pn : u.pn + 12) : u.pn + pn0; const int region = pnz >> 2; const int lane = fq * 16 + fr;
        bf16* base = Z + (size_t)region * ((size_t)NTOK * D) + (size_t)(u.pm * 256 + wr * 64 + (lane >> 3)) * D + (pnz & 3) * 256 + wc * 64 + 8 * (lane & 7);
        float* stp = sgst + ((size_t)(u.pm * 256 + wr * 64 + fr) * 16 + (pnz & 3) * 4 + wc) * 2;
        if (region == 0) body<0, false>(acc, base, lane, wr, wc, fr, fq, stp);
        else if (region < 3) body<1, false>(acc, base, lane, wr, wc, fr, fq, stp);
        else if (region == 3) body<1, true>(acc, base, lane, wr, wc, fr, fq, stp);
        else body<2, false>(acc, base, lane, wr, wc, fr, fq, stp);
    }
};
template <bool HAS_ADD> struct EpiMergeT {
    static constexpr bool PERM = true, BREMAP = true; static constexpr int NST = 16;
    const bf16* gate; const bf16* addend; bf16* out; LAS unsigned char* lds_epi;
    __device__ __forceinline__ void prefetch(const pg8::Unit&, int, int) const {}
    __device__ __forceinline__ void operator()(const pg8::f32x4 (&acc)[2][2][4][2], const pg8::Unit& u, int wr, int wc, int fr, int fq) const {
        const int lane = fq * 16 + fr; const int row0 = u.pm * 256 + wr * 64 + fr, col0 = u.pn * 256 + wc * 64 + 8 * fq;
        bf16* obase = out + (size_t)(u.pm * 256 + wr * 64 + (lane >> 3)) * D + u.pn * 256 + wc * 64 + 8 * (lane & 7);
        const size_t off0 = (size_t)row0 * D + col0;
        if constexpr (!HAS_ADD) {
            pg8::u32x4 g[2][4][2];
#pragma unroll
            for (int ai = 0; ai < 2; ++ai)
#pragma unroll
                for (int m = 0; m < 4; ++m)
#pragma unroll
                    for (int bj = 0; bj < 2; ++bj) g[ai][m][bj] = *(const pg8::u32x4*)(gate + off0 + (size_t)(ai * 128 + m * 16) * D + bj * 32);
#pragma unroll
            for (int ai = 0; ai < 2; ++ai)
#pragma unroll
                for (int m = 0; m < 4; ++m) { pg8::u32x4 w[2];
#pragma unroll
                    for (int bj = 0; bj < 2; ++bj) { const pg8::u32x4 gg = g[ai][m][bj]; const pg8::f32x4 a0 = acc[ai][bj][m][0], a1 = acc[ai][bj][m][1];
                        w[bj].x = pg8::cvt_pk_bf16(pg8::bf_lo(gg.x) * a0[0], pg8::bf_hi(gg.x) * a0[1]); w[bj].y = pg8::cvt_pk_bf16(pg8::bf_lo(gg.y) * a0[2], pg8::bf_hi(gg.y) * a0[3]);
                        w[bj].z = pg8::cvt_pk_bf16(pg8::bf_lo(gg.z) * a1[0], pg8::bf_hi(gg.z) * a1[1]); w[bj].w = pg8::cvt_pk_bf16(pg8::bf_lo(gg.w) * a1[2], pg8::bf_hi(gg.w) * a1[3]); }
                    stage_store128(EPI_STG(), lane, fr, fq, w[0], w[1], obase + (size_t)(ai * 128 + m * 16) * D, (size_t)8 * D); }
        } else {
            pg8::u32x4 g[4][2], ad[4][2], wq[4][2];
#define EM_LOAD(ai_) do { _Pragma("unroll") for (int m = 0; m < 4; ++m) _Pragma("unroll") for (int bj = 0; bj < 2; ++bj) { const size_t off = off0 + (size_t)((ai_) * 128 + m * 16) * D + bj * 32; g[m][bj] = *(const pg8::u32x4*)(gate + off); ad[m][bj] = *(const pg8::u32x4*)(addend + off); } } while (0)
#define EM_CALC(ai_) do { _Pragma("unroll") for (int m = 0; m < 4; ++m) _Pragma("unroll") for (int bj = 0; bj < 2; ++bj) { const pg8::u32x4 gg = g[m][bj], aa = ad[m][bj]; const pg8::f32x4 a0 = acc[ai_][bj][m][0], a1 = acc[ai_][bj][m][1]; \
                wq[m][bj].x = pg8::cvt_pk_bf16(pg8::bf_lo(aa.x) + pg8::bf_lo(gg.x) * a0[0], pg8::bf_hi(aa.x) + pg8::bf_hi(gg.x) * a0[1]); \
                wq[m][bj].y = pg8::cvt_pk_bf16(pg8::bf_lo(aa.y) + pg8::bf_lo(gg.y) * a0[2], pg8::bf_hi(aa.y) + pg8::bf_hi(gg.y) * a0[3]); \
                wq[m][bj].z = pg8::cvt_pk_bf16(pg8::bf_lo(aa.z) + pg8::bf_lo(gg.z) * a1[0], pg8::bf_hi(aa.z) + pg8::bf_hi(gg.z) * a1[1]); \
                wq[m][bj].w = pg8::cvt_pk_bf16(pg8::bf_lo(aa.w) + pg8::bf_lo(gg.w) * a1[2], pg8::bf_hi(aa.w) + pg8::bf_hi(gg.w) * a1[3]); } } while (0)
#define EM_STORE(ai_) do { _Pragma("unroll") for (int m = 0; m < 4; ++m) stage_store128(EPI_STG(), lane, fr, fq, wq[m][0], wq[m][1], obase + (size_t)((ai_) * 128 + m * 16) * D, (size_t)8 * D); } while (0)
            EM_LOAD(0); EM_CALC(0);
            asm volatile("" ::: "memory");
            EM_LOAD(1);
            asm volatile("" ::: "memory");
            EM_STORE(0);
            EM_CALC(1); EM_STORE(1);
#undef EM_LOAD
#undef EM_CALC
#undef EM_STORE
        }
    }
};
struct EpiResid {
    static constexpr bool PERM = true, BREMAP = true; static constexpr int NST = 16;
    const float* x; const float* gt; bf16* out; LAS unsigned char* lds_epi;
    __device__ __forceinline__ void prefetch(const pg8::Unit&, int, int) const {}
    __device__ __forceinline__ void operator()(const pg8::f32x4 (&acc)[2][2][4][2], const pg8::Unit& u, int wr, int wc, int fr, int fq) const {
        const int lane = fq * 16 + fr; const int row0 = u.pm * 256 + wr * 64 + fr, col0 = u.pn * 256 + wc * 64 + 8 * fq; const int b = u.pm >> 4;
        bf16* obase = out + (size_t)(u.pm * 256 + wr * 64 + (lane >> 3)) * D + u.pn * 256 + wc * 64 + 8 * (lane & 7);
        pg8::f32x4 gv[2][2];
#pragma unroll
        for (int bj = 0; bj < 2; ++bj)
#pragma unroll
            for (int n = 0; n < 2; ++n) gv[bj][n] = *(const pg8::f32x4*)(gt + (size_t)b * DIN + col0 + bj * 32 + n * 4);
        pg8::f32x4 xv[4][2][2]; pg8::u32x4 wq[4][2];
#define ER_LOAD(ai_) do { _Pragma("unroll") for (int m = 0; m < 4; ++m) _Pragma("unroll") for (int bj = 0; bj < 2; ++bj) { const size_t off = (size_t)(row0 + (ai_) * 128 + m * 16) * D + col0 + bj * 32; xv[m][bj][0] = *(const pg8::f32x4*)(x + off); xv[m][bj][1] = *(const pg8::f32x4*)(x + off + 4); } } while (0)
#define ER_CALC(ai_) do { _Pragma("unroll") for (int m = 0; m < 4; ++m) _Pragma("unroll") for (int bj = 0; bj < 2; ++bj) { \
            const pg8::f32x4 y0 = xv[m][bj][0] + gv[bj][0] * acc[ai_][bj][m][0], y1 = xv[m][bj][1] + gv[bj][1] * acc[ai_][bj][m][1]; \
            wq[m][bj].x = pg8::cvt_pk_bf16(y0[0], y0[1]); wq[m][bj].y = pg8::cvt_pk_bf16(y0[2], y0[3]); wq[m][bj].z = pg8::cvt_pk_bf16(y1[0], y1[1]); wq[m][bj].w = pg8::cvt_pk_bf16(y1[2], y1[3]); } } while (0)
#define ER_STORE(ai_) do { _Pragma("unroll") for (int m = 0; m < 4; ++m) stage_store128(EPI_STG(), lane, fr, fq, wq[m][0], wq[m][1], obase + (size_t)((ai_) * 128 + m * 16) * D, (size_t)8 * D); } while (0)
        ER_LOAD(0); ER_CALC(0);
        asm volatile("" ::: "memory");
        ER_LOAD(1);
        asm volatile("" ::: "memory");
        ER_STORE(0);
        ER_CALC(1); ER_STORE(1);
#undef ER_LOAD
#undef ER_CALC
#undef ER_STORE
    }
};
struct EpiGu {
    static constexpr bool PERM = true, BREMAP = false; static constexpr int NST = 4;
    unsigned char* act; const float* bgu; int tile0; LAS unsigned char* lds_epi;
    __device__ __forceinline__ void prefetch(const pg8::Unit& u, int wid, int lane) const {
        if (wid == 0) __builtin_amdgcn_global_load_lds((const unsigned*)(bgu + (size_t)u.e * 2048 + (lane >> 5) * 1024 + u.pn * 128 + (lane & 31) * 4), (LAS unsigned*)(lds_epi + 18432 + u.par * 3072), 16, 0, 0);
    }
    __device__ __forceinline__ void operator()(const pg8::f32x4 (&acc)[2][2][4][2], const pg8::Unit& u, int wr, int wc, int fr, int fq) const {
        const int lane = fq * 16 + fr;
        unsigned char* obase = act + (size_t)((u.pm - tile0) * 256 + wr * 64 + (lane >> 1)) * D + u.pn * 128 + wc * 32 + 16 * (lane & 1);
        const LAS float* bg = (const LAS float*)(lds_epi + 18432 + u.par * 3072) + wc * 32 + 8 * fq;
        const pg8::f32x4 bg0 = *(const LAS pg8::f32x4*)(bg), bg1 = *(const LAS pg8::f32x4*)(bg + 4), bu0 = *(const LAS pg8::f32x4*)(bg + 128), bu1 = *(const LAS pg8::f32x4*)(bg + 132);
        LAS unsigned char* stg = EPI_STG();
        constexpr float SA = 1.0f / (SC_H2 * SC_W);
#pragma unroll
        for (int ai = 0; ai < 2; ++ai)
#pragma unroll
            for (int mp = 0; mp < 2; ++mp) {
#pragma unroll
                for (int mq = 0; mq < 2; ++mq) { const int m = 2 * mp + mq; pg8::f32x2 o[4];
#pragma unroll
                    for (int p = 0; p < 4; ++p) { const int n = p >> 1, j = 2 * (p & 1);
                        const pg8::f32x4 ag = acc[ai][0][m][n], au = acc[ai][1][m][n]; const pg8::f32x4 vbg = n ? bg1 : bg0, vbu = n ? bu1 : bu0;
                        pg8::f32x2 g = (pg8::f32x2){ag[j], ag[j + 1]} * SA + (pg8::f32x2){vbg[j], vbg[j + 1]};
                        pg8::f32x2 up = (pg8::f32x2){au[j], au[j + 1]} * SA + (pg8::f32x2){vbu[j], vbu[j + 1]};
                        g = (pg8::f32x2){fminf(g.x, 7.0f), fminf(g.y, 7.0f)}; up = (pg8::f32x2){__builtin_amdgcn_fmed3f(up.x, -7.0f, 7.0f), __builtin_amdgcn_fmed3f(up.y, -7.0f, 7.0f)};
                        const pg8::f32x2 t = g * (-2.4554669596f);
                        const pg8::f32x2 d = (pg8::f32x2){__builtin_amdgcn_exp2f(t.x), __builtin_amdgcn_exp2f(t.y)} * (1.0f / SC_ACT) + (1.0f / SC_ACT);
                        const pg8::f32x2 gs = g * (pg8::f32x2){__builtin_amdgcn_rcpf(d.x), __builtin_amdgcn_rcpf(d.y)};
                        o[p] = up * gs + gs; }
                    int w0 = __builtin_amdgcn_cvt_pk_fp8_f32(o[0].x, o[0].y, 0, false); w0 = __builtin_amdgcn_cvt_pk_fp8_f32(o[1].x, o[1].y, w0, true);
                    int w1 = __builtin_amdgcn_cvt_pk_fp8_f32(o[2].x, o[2].y, 0, false); w1 = __builtin_amdgcn_cvt_pk_fp8_f32(o[3].x, o[3].y, w1, true);
                    *(LAS pg8::u32x2*)(stg + (16 * mq + fr) * 48 + fq * 8) = (pg8::u32x2){(unsigned)w0, (unsigned)w1}; }
                asm volatile("" ::: "memory");
                const pg8::u32x4 r = *(const LAS pg8::u32x4*)(stg + (lane >> 1) * 48 + (lane & 1) * 16);
                *(GAS pg8::u32x4*)(obase + (size_t)(ai * 128 + mp * 32) * D) = r; }
    }
};
struct EpiDown {
    static constexpr bool PERM = true, BREMAP = true; static constexpr int NST = 8;
    unsigned char* wsb; const float* bd; const float* slot_w; int tile0; LAS unsigned char* lds_epi;
    __device__ __forceinline__ void prefetch(const pg8::Unit& u, int wid, int lane) const {
        if (wid == 0) __builtin_amdgcn_global_load_lds((const unsigned*)(bd + (size_t)u.e * D + u.pn * 256 + lane * 4), (LAS unsigned*)(lds_epi + 18432 + u.par * 3072), 16, 0, 0);
        if (wid == 1) __builtin_amdgcn_global_load_lds((const unsigned*)(slot_w + (size_t)u.pm * 256 + lane * 4), (LAS unsigned*)(lds_epi + 18432 + u.par * 3072 + 1024), 16, 0, 0);
    }
    __device__ __forceinline__ void operator()(const pg8::f32x4 (&acc)[2][2][4][2], const pg8::Unit& u, int wr, int wc, int fr, int fq) const {
        const int lane = fq * 16 + fr;
        unsigned char* obase = wsb + y_tile_off(u.pm) + (size_t)(wr * 64 + (lane >> 2)) * D + u.pn * 256 + wc * 64 + 16 * (lane & 3);
        const LAS float* bp = (const LAS float*)(lds_epi + 18432 + u.par * 3072) + wc * 64 + 8 * fq;
        const LAS float* swp = (const LAS float*)(lds_epi + 18432 + u.par * 3072 + 1024) + wr * 64 + fr;
        LAS unsigned char* stg = EPI_STG();
        pg8::f32x4 bv[2][2];
#pragma unroll
        for (int bj = 0; bj < 2; ++bj) { bv[bj][0] = *(const LAS pg8::f32x4*)(bp + bj * 32); bv[bj][1] = *(const LAS pg8::f32x4*)(bp + bj * 32 + 4); }
#pragma unroll
        for (int ai = 0; ai < 2; ++ai)
#pragma unroll
            for (int m = 0; m < 4; ++m) { const float sw = swp[ai * 128 + m * 16] * SC_Y;
#pragma unroll
                for (int bj = 0; bj < 2; ++bj) { constexpr float SA = 1.0f / (SC_ACT * SC_W); const pg8::f32x4 v0 = (acc[ai][bj][m][0] * SA + bv[bj][0]) * sw, v1 = (acc[ai][bj][m][1] * SA + bv[bj][1]) * sw;
                    *(LAS pg8::u32x2*)(stg + fr * 80 + bj * 32 + fq * 8) = (pg8::u32x2){pk4_fp8(v0[0], v0[1], v0[2], v0[3]), pk4_fp8(v1[0], v1[1], v1[2], v1[3])}; }
                asm volatile("" ::: "memory");
                const pg8::u32x4 r = *(const LAS pg8::u32x4*)(stg + (lane >> 2) * 80 + (lane & 3) * 16);
                *(pg8::u32x4*)(obase + (size_t)(ai * 128 + m * 16) * D) = r; }
    }
};

__device__ __forceinline__ void transpose_item(const float* W, int ldn, int K, int k0, int n0, bf16* WT, int drow0, LAS float* scr, int lane) {
    float tv_[32];
#pragma unroll
    for (int i = 0; i < 32; ++i) tv_[i] = W[(size_t)(k0 + 2 * i + (lane >> 5)) * ldn + n0 + (lane & 31)];
#pragma unroll
    for (int i = 0; i < 32; ++i) scr[(2 * i + (lane >> 5)) * 33 + (lane & 31)] = tv_[i];
    LDS_WAIT(); asm volatile("" ::: "memory");
    const int c = lane & 7;
#pragma unroll
    for (int j = 0; j < 4; ++j) { const int n = (lane >> 3) + 8 * j; const LAS float* s = scr + (8 * c) * 33 + n;
        v4u o; o.x = pk2(s[0 * 33], s[1 * 33]); o.y = pk2(s[2 * 33], s[3 * 33]); o.z = pk2(s[4 * 33], s[5 * 33]); o.w = pk2(s[6 * 33], s[7 * 33]);
        *(GAS v4u*)(WT + (size_t)(drow0 + n) * K + k0 + 8 * c) = o; }
    LDS_WAIT(); asm volatile("" ::: "memory");
}

__device__ __forceinline__ void transpose_item_f8(const float* W, int ldn, int K, int k0, int n0, unsigned char* WT8, int drow0, LAS float* scr, int lane, float sc) {
    float tv_[32];
#pragma unroll
    for (int i = 0; i < 32; ++i) tv_[i] = W[(size_t)(k0 + 2 * i + (lane >> 5)) * ldn + n0 + (lane & 31)];
#pragma unroll
    for (int i = 0; i < 32; ++i) scr[(2 * i + (lane >> 5)) * 33 + (lane & 31)] = tv_[i] * sc;
    LDS_WAIT(); asm volatile("" ::: "memory");
    const int c = lane & 7;
#pragma unroll
    for (int j = 0; j < 4; ++j) { const int n = (lane >> 3) + 8 * j; const LAS float* s = scr + (8 * c) * 33 + n;
        v2u o; o.x = pk4_fp8(s[0 * 33], s[1 * 33], s[2 * 33], s[3 * 33]); o.y = pk4_fp8(s[4 * 33], s[5 * 33], s[6 * 33], s[7 * 33]);
        *(GAS v2u*)(WT8 + (size_t)(drow0 + n) * K + k0 + 8 * c) = o; }
    LDS_WAIT(); asm volatile("" ::: "memory");
}

struct Args {
    const float* in[28]; float* out; unsigned char* ws; int ph_lo, ph_hi, li, pad;
};
enum { I_X = 0, I_C, I_ADAW, I_ADAB, I_N1G, I_WIN, I_CONVW, I_CONVB, I_LWA, I_LBA, I_LWX, I_LBX, I_LAM, I_SGLNG, I_SGLNB, I_SGWS, I_SGBS, I_WBRR, I_WBRS, I_WOUT, I_N2G, I_WR, I_BR, I_WGU, I_BGU, I_WDN, I_BDN, I_FG };

__global__ void __launch_bounds__(NWAVES * 64, 2) mega_fwd(Args args) {
    extern __shared__ __attribute__((aligned(16))) unsigned char lds_raw[];
    LAS unsigned char* lds = (LAS unsigned char*)lds_raw;
    volatile LAS unsigned* MISC = (volatile LAS unsigned*)(lds + MISC_OFF);
    const int tid = threadIdx.x, lane = tid & 63, wave = __builtin_amdgcn_readfirstlane(tid >> 6);
    const int G = gridDim.x; const int bx = blockIdx.x;
    const int vcu = (G % 8 == 0) ? (bx % 8) * (G / 8) + bx / 8 : bx;
    unsigned char* ws = args.ws;
    gu32* ctl = (gu32*)(ws + WS_CTL);
    for (int u = tid; u < (LDS_BYTES - RING_BYTES) / 4; u += NWAVES * 64) ((LAS unsigned*)(lds + RING_BYTES))[u] = 0u;
    __syncthreads();
#if MK_PER_PHASE
    XcdBarrier bar; bar.bar = (unsigned*)(ctl + CW_BAR); bar.x = 0; bar.st = nullptr;
#define GRID_BAR() do { if (tid == 0) __hip_atomic_store(ctl + CW_TMO, 0xBADBA0u, RLX_AGENT); } while (0)
#else
    XcdBarrier bar = xcd_barrier_post((unsigned*)(ctl + CW_BAR), MISC + 8);
#define GRID_BAR() xcd_barrier(bar)
#endif
    const int lo = args.ph_lo, hi = args.ph_hi;
#define IN(k) (lo <= (k) && (k) < hi)
#ifdef DIAG_A_LO
#define STAMP(k) do { if (bx == 0 && threadIdx.x == 0) __hip_atomic_store(ctl + 64 + (k), (unsigned)__builtin_amdgcn_s_memrealtime(), RLX_AGENT); } while (0)
#else
#define STAMP(k) do { } while (0)
#endif
#define BOTH(k) (IN(k) && IN((k) + 1))

    const float* x_in = args.in[I_X];
    float* modv = (float*)(ws + WS_MOD);
    bf16* Hb = (bf16*)(ws + WS_H);
    bf16* X1b = (bf16*)(ws + WS_X1B);
    bf16* H2b = (bf16*)(ws + WS_H2);
    bf16* Zb = (bf16*)(ws + WS_Z);
    bf16* Z0 = Zb, *Z1 = Zb + (size_t)NTOK * D, *Z2 = Zb + 2 * (size_t)NTOK * D, *Z3 = Zb + 3 * (size_t)NTOK * D, *Z4 = Zb + 4 * (size_t)NTOK * D, *Z5 = Zb + 5 * (size_t)NTOK * D;
    int* top_idx = (int*)(ws + WS_TOPI); float* top_w = (float*)(ws + WS_TOPW); int* tok_slot = (int*)(ws + WS_TSLOT);
    int* slot_tok = (int*)(ws + WS_SLOTTOK); float* slot_w = (float*)(ws + WS_SLOTW); int* blkcnt = (int*)(ws + WS_BLKCNT); int* tile_exp = (int*)(ws + WS_TILEEXP);
    const int gw = vcu * NWAVES + wave, NGW = G * NWAVES;

    STAMP(0);
    if (IN(0)) {
        int tid_l = threadIdx.x; asm volatile("" : "+v"(tid_l)); const int tid = tid_l, lane = tid & 63;
        if (bx < 96) {
            LAS float* sc = (LAS float*)lds;
            LAS float* part = (LAS float*)(lds + 65536);
            const float* cin = args.in[I_C];
            { float cv[32];
#pragma unroll
                for (int q = 0; q < 32; ++q) cv[q] = cin[(q >> 1) * D + tid + 512 * (q & 1)];
#pragma unroll
                for (int q = 0; q < 32; ++q) { const float v = cv[q]; sc[(tid + 512 * (q & 1)) * 16 + (q >> 1)] = v * fast_sigmoid(v); } }
            __syncthreads();
            for (int task = bx; task < 96; task += G) {
                const int j0 = task * 64; const float* aw = args.in[I_ADAW];
                float a16[16];
#pragma unroll
                for (int b = 0; b < 16; ++b) a16[b] = 0.f;
                {
                    float wa[32], wb[32];
                    const float* pw = aw + (size_t)(wave * 128) * DIN + j0 + lane;
#define P0_LD(w_, k0_) do { _Pragma("unroll") for (int q = 0; q < 32; ++q) { w_[q] = *pw; pw += DIN; asm volatile("" : "+v"(pw)); } } while (0)
#define P0_FMA(w_, k0_) do { _Pragma("unroll") for (int q = 0; q < 32; ++q) { const int k = wave * 128 + (k0_) + q; const float wv = w_[q]; \
                        _Pragma("unroll") for (int b4 = 0; b4 < 4; ++b4) { const f32x4 s4 = *(const LAS f32x4*)(sc + k * 16 + b4 * 4); \
                            a16[b4 * 4 + 0] += s4[0] * wv; a16[b4 * 4 + 1] += s4[1] * wv; a16[b4 * 4 + 2] += s4[2] * wv; a16[b4 * 4 + 3] += s4[3] * wv; } } } while (0)
                    P0_LD(wa, 0); P0_LD(wb, 32);
                    P0_FMA(wa, 0); P0_LD(wa, 64);
                    P0_FMA(wb, 32); P0_LD(wb, 96);
                    P0_FMA(wa, 64); P0_FMA(wb, 96);
#undef P0_LD
#undef P0_FMA
                }
#pragma unroll
                for (int b = 0; b < 16; ++b) part[(wave * 16 + b) * 64 + lane] = a16[b];
                __syncthreads();
                for (int q = 0; q < 2; ++q) { const int o = tid + 512 * q, b = o >> 6, col = o & 63; float s = args.in[I_ADAB][j0 + col];
#pragma unroll
                    for (int w = 0; w < 8; ++w) s += part[(w * 16 + b) * 64 + col];
                    modv[b * DIN + j0 + col] = s; }
                __syncthreads();
            }
        }
        __syncthreads();
        {
            LAS float* scr = (LAS float*)(lds + wave * 16384);
            constexpr int I_IN = 16 * (DIN / 32), I_SQ = 16 * (D / 32);
            const int cw = (bx >= 96 ? (bx - 96) : 0) * NWAVES + wave, NCW = (G > 96 ? (G - 96) : 1) * NWAVES;
            for (int it = (bx >= 96 || G <= 96) ? cw : I_IN + 3 * I_SQ; it < I_IN + 3 * I_SQ; it += NCW) {
                int r = it;
                if (r < I_IN) { const int nblk = DIN / 32, kb = r / nblk, nb = r % nblk;
                    if (nb >= 32 && nb < 128) transpose_item(args.in[I_WIN], DIN, D, 64 * kb, 32 * nb, (bf16*)(ws + WS_WIN), 32 * nb, scr, lane);
                    else transpose_item_f8(args.in[I_WIN], DIN, D, 64 * kb, 32 * nb, ws + WS_WIN8, nb < 32 ? 32 * nb : 32 * (nb - 96), scr, lane, SC_W);
                    continue; } r -= I_IN;
                const int which = r / I_SQ; r -= which * I_SQ; const int nblk = D / 32, kb = r / nblk, nb = r % nblk;
                const float* W = which == 0 ? args.in[I_WBRR] : (which == 1 ? args.in[I_WBRS] : args.in[I_WOUT]);
                bf16* WT = (bf16*)(ws + (which == 0 ? WS_WBRR : (which == 1 ? WS_WBRS : WS_WOUT)));
                transpose_item(W, D, D, 64 * kb, 32 * nb, WT, 32 * nb, scr, lane);
            }
        }
        { bf16* sgw = (bf16*)(ws + WS_SGW);
            for (int idx = gw * 64 + lane; idx < 8 * 128 * 128; idx += NGW * 64) { const int t = (idx >> 7) & 127, s2 = idx & 127; sgw[idx] = (bf16)(s2 <= t ? f2bf(args.in[I_SGWS][idx]) : 0u); } }
        if (BOTH(0)) GRID_BAR();
    }

    STAMP(1);
    if (IN(1)) {
        int tid_l = threadIdx.x; asm volatile("" : "+v"(tid_l)); const int tid = tid_l, lane = tid & 63;
        for (int rb = gw; rb < NTOK / 32; rb += NGW) {
            const int b = (rb * 32) / SEQ;
            f32x4 A4[4], B4[4];
#pragma unroll
            for (int j = 0; j < 4; ++j) { const int c = 4 * lane + 256 * j; const f32x4 g = *(const f32x4*)(args.in[I_N1G] + c), s = *(const f32x4*)(modv + b * DIN + 1024 + c);
                A4[j] = g * (1.0f + s); B4[j] = *(const f32x4*)(modv + b * DIN + c); }
            f32x4 v0[4], v1[4], n0[4], n1[4];
#define P1_LOAD(r_, d_) do { const GAS f32x4* xr_ = (const GAS f32x4*)(x_in + ((size_t)rb * 32 + (r_)) * D) + lane; _Pragma("unroll") for (int j = 0; j < 4; ++j) d_[j] = xr_[64 * j]; } while (0)
#define P1_ROW(r_, d_) do { float ss = 0.f; _Pragma("unroll") for (int j = 0; j < 4; ++j) ss += (d_[j].x * d_[j].x + d_[j].y * d_[j].y) + (d_[j].z * d_[j].z + d_[j].w * d_[j].w); \
                const float rstd = 1.0f / sqrtf(wave_sum(ss) * (1.f / D) + EPS); GAS v2u* o8 = (GAS v2u*)(Hb + ((size_t)rb * 32 + (r_)) * D) + lane; \
                GAS unsigned* o4 = (GAS unsigned*)(ws + WS_H8 + ((size_t)rb * 32 + (r_)) * D) + lane; \
                _Pragma("unroll") for (int j = 0; j < 4; ++j) { const f32x4 y = d_[j] * rstd * A4[j] + B4[j]; v2u o; o.x = pg8::cvt_pk_bf16(y.x, y.y); o.y = pg8::cvt_pk_bf16(y.z, y.w); o8[64 * j] = o; \
                    o4[64 * j] = pk4_fp8(y.x * SC_H2, y.y * SC_H2, y.z * SC_H2, y.w * SC_H2); } } while (0)
            P1_LOAD(0, v0); P1_LOAD(1, v1);
            for (int r = 0; r < 32; r += 2) {
                const int rn = (r < 30) ? r + 2 : r;
                P1_LOAD(rn, n0); P1_LOAD(rn + 1, n1);
                P1_ROW(r, v0); P1_ROW(r + 1, v1);
#pragma unroll
                for (int j = 0; j < 4; ++j) { v0[j] = n0[j]; v1[j] = n1[j]; }
            }
#undef P1_LOAD
#undef P1_ROW
        }
        if (BOTH(1)) GRID_BAR();
    }

    STAMP(2);
    if (IN(2)) {
        { pg8::PlainOrder S; S.init(Hb, (const bf16*)(ws + WS_WIN) + (size_t)1024 * D, NTOK, 3072, G, bx);
            EpiZT<false> E{Zb, lds + AUX_OFF, 4, (float*)(ws + WS_SGST)};
            pg8::gemm_phase<EpiZT<false>, pg8::PlainOrder, true>(lds, S, E); }
        { pg8::PlainOrderT<true> S; S.init((const bf16*)(ws + WS_H8), (const bf16*)(ws + WS_WIN8), NTOK, 3072, G, bx);
            EpiZT<true> E{Zb, lds + AUX_OFF, 0, (float*)(ws + WS_SGST)};
            pg8::gemm_phase<EpiZT<true>, pg8::PlainOrderT<true>, true>(lds, S, E); }
        if (BOTH(2)) GRID_BAR();
    }

    STAMP(3);
    if (IN(3)) {
        int tid_l = threadIdx.x; asm volatile("" : "+v"(tid_l)); const int tid = tid_l, lane = tid & 63;
        typedef float f32x16 __attribute__((ext_vector_type(16)));
        const int sgq = (bx >> 3) & 3; const int sg_before = sgq == 0 ? 0 : (sgq == 1 ? 3 : (sgq == 2 ? 1 : 2));
        auto sg_section = [&](const int cmask) __attribute__((always_inline)) {
        int tid_s = threadIdx.x; asm volatile("" : "+v"(tid_s)); const int tid = tid_s, lane = tid & 63;
        LAS float* c_lng = (LAS float*)(lds + AUX_OFF + 1024); LAS float* c_lnb = (LAS float*)(lds + AUX_OFF + 5120); LAS float* c_bs = (LAS float*)(lds + AUX_OFF + 9216);
        for (int q = 0; q < 2; ++q) { c_lng[tid + 512 * q] = args.in[I_SGLNG][tid + 512 * q]; c_lnb[tid + 512 * q] = args.in[I_SGLNB][tid + 512 * q]; c_bs[tid + 512 * q] = args.in[I_SGBS][tid + 512 * q]; }
        for (int chunk = bx, ci_ = 0; chunk < NTOK / 128; chunk += G, ++ci_) { if (((cmask >> (ci_ & 1)) & 1) == 0) continue;
            const size_t row0 = (size_t)chunk * 128;
            LAS float* st = (LAS float*)(lds + AUX_OFF);
            const bf16* sgw = (const bf16*)(ws + WS_SGW);
            __syncthreads();
            if (tid < 128) {
                const f32x4* pp = (const f32x4*)(ws + WS_SGST) + (row0 + tid) * 8; float sa = 0.f, sb = 0.f;
                f32x4 p4[8];
#pragma unroll
                for (int i = 0; i < 8; ++i) p4[i] = pp[i];
#pragma unroll
                for (int i = 0; i < 8; ++i) { sa += p4[i].x; sb += p4[i].y; sa += p4[i].z; sb += p4[i].w; }
                const float mean = sa * (1.f / D); const float var = fmaxf(sb * (1.f / D) - mean * mean, 0.f);
                const float rstd_ = 1.0f / sqrtf(var + EPS); st[2 * tid] = -mean * rstd_; st[2 * tid + 1] = rstd_; }
            __syncthreads();
            const int r31 = lane & 31, hh = lane >> 5;
            const int ti = (wave < 4) ? (wave >> 1) : 3 - ((wave - 4) >> 1), ci0 = 2 * (wave & 1);
            const int bch = tid & 15, bs0 = tid >> 4;
#define SG_BUILD_LOAD(g_, wv_) do { _Pragma("unroll") for (int q = 0; q < 4; ++q) wv_[q] = *(const v4u*)(Z3 + (row0 + bs0 + 32 * q) * D + (g_) * 128 + 8 * bch); } while (0)
#define SG_BUILD_STORE(g_, wv_) do { const int col = (g_) * 128 + 8 * bch; LAS unsigned char* vt_ = lds + ((g_) & 1) * 32768; \
                const f32x4 g0 = *(const LAS f32x4*)(c_lng + col), g1 = *(const LAS f32x4*)(c_lng + col + 4), b0 = *(const LAS f32x4*)(c_lnb + col), b1 = *(const LAS f32x4*)(c_lnb + col + 4); \
                _Pragma("unroll") for (int q = 0; q < 4; ++q) { const int s = bs0 + 32 * q; const v4u w = wv_[q]; const float mr = st[2 * s], rs = st[2 * s + 1]; v4u o;        \
                    { const pg8::f32x2 t0 = (pg8::f32x2){pg8::bf_lo(w.x), pg8::bf_hi(w.x)} * rs + mr, t1 = (pg8::f32x2){pg8::bf_lo(w.y), pg8::bf_hi(w.y)} * rs + mr, t2 = (pg8::f32x2){pg8::bf_lo(w.z), pg8::bf_hi(w.z)} * rs + mr, t3 = (pg8::f32x2){pg8::bf_lo(w.w), pg8::bf_hi(w.w)} * rs + mr; \
                      const pg8::f32x2 y0 = t0 * (pg8::f32x2){g0[0], g0[1]} + (pg8::f32x2){b0[0], b0[1]}, y1 = t1 * (pg8::f32x2){g0[2], g0[3]} + (pg8::f32x2){b0[2], b0[3]}, y2 = t2 * (pg8::f32x2){g1[0], g1[1]} + (pg8::f32x2){b1[0], b1[1]}, y3 = t3 * (pg8::f32x2){g1[2], g1[3]} + (pg8::f32x2){b1[2], b1[3]}; \
                      o.x = pg8::cvt_pk_bf16(y0.x, y0.y); o.y = pg8::cvt_pk_bf16(y1.x, y1.y); o.z = pg8::cvt_pk_bf16(y2.x, y2.y); o.w = pg8::cvt_pk_bf16(y3.x, y3.y); } \
                    *(LAS v4u*)(vt_ + 256 * s + 16 * (bch ^ (((s & 3) << 2) | ((s >> 2) & 3)))) = o; } } while (0)
            const int nks = 2 * (ti + 1);
            pg8::bf16x8 afc[8];
#define SG_LOAD_A(g_, af_) do { const bf16* wrow_ = sgw + ((size_t)(g_) * 128 + 32 * ti + r31) * 128 + 8 * hh; _Pragma("unroll") for (int ks = 0; ks < 8; ++ks) if (ks < nks) af_[ks] = *(const pg8::bf16x8*)(wrow_ + 16 * ks); } while (0)
            v4u wvA[4], wvB[4], guvC[4], guvN[4];
#define SG_GU_LOAD(g_, gv_) do { const bf16* gb_ = Z2 + (row0 + 32 * ti + (lane >> 3)) * D + (g_) * 128 + 32 * ci0 + 8 * (lane & 7); _Pragma("unroll") for (int q = 0; q < 4; ++q) gv_[q] = *(const v4u*)(gb_ + (size_t)(8 * q) * D); } while (0)
            SG_BUILD_LOAD(0, wvA); SG_LOAD_A(0, afc); SG_GU_LOAD(0, guvC); SG_BUILD_STORE(0, wvA); SG_BUILD_LOAD(1, wvA);
            __syncthreads();
#pragma nounroll
            for (int g = 0; g < 8; ++g) {
                float bsv[16];
#pragma unroll
                for (int i = 0; i < 16; ++i) bsv[i] = c_bs[g * 128 + 32 * ti + 4 * hh + (i & 3) + 8 * (i >> 2)];
                bf16* obase = Z2 + (row0 + 32 * ti + (lane >> 3)) * D + g * 128 + 32 * ci0 + 8 * (lane & 7);
                const int gn = (g < 7) ? g + 1 : g, gn2 = (g < 6) ? g + 2 : 7;
                SG_GU_LOAD(gn, guvN); SG_BUILD_LOAD(gn2, wvB);
                f32x16 acc0, acc1;
#pragma unroll
                for (int i = 0; i < 16; ++i) { acc0[i] = 0.f; acc1[i] = 0.f; }
                const unsigned vbase = (unsigned)(size_t)(lds + (g & 1) * 32768);
                const unsigned blk = (lane >> 4) & 1, qq = (lane & 15) >> 2, pp = lane & 3;
#pragma unroll
                for (int kp = 0; kp < 4; ++kp) if (2 * kp < nks) {
                    unsigned ad[2][2][2];
#pragma unroll
                    for (int kk = 0; kk < 2; ++kk)
#pragma unroll
                        for (int cc = 0; cc < 2; ++cc)
#pragma unroll
                            for (int t2 = 0; t2 < 2; ++t2) { const unsigned row = 16 * (2 * kp + kk) + 8 * hh + 4 * t2 + qq, chn = 4 * (ci0 + cc) + 2 * blk + (pp >> 1);
                                ad[kk][cc][t2] = vbase + 256u * row + 16u * (chn ^ (((row & 3) << 2) | ((row >> 2) & 3))) + 8u * (pp & 1); }
                    v2u f[2][2][2];
                    asm volatile("ds_read_b64_tr_b16 %0, %8\n\tds_read_b64_tr_b16 %1, %9\n\tds_read_b64_tr_b16 %2, %10\n\tds_read_b64_tr_b16 %3, %11\n\t"
                                 "ds_read_b64_tr_b16 %4, %12\n\tds_read_b64_tr_b16 %5, %13\n\tds_read_b64_tr_b16 %6, %14\n\tds_read_b64_tr_b16 %7, %15\n\ts_waitcnt lgkmcnt(0)"
                                 : "=&v"(f[0][0][0]), "=&v"(f[0][0][1]), "=&v"(f[0][1][0]), "=&v"(f[0][1][1]), "=&v"(f[1][0][0]), "=&v"(f[1][0][1]), "=&v"(f[1][1][0]), "=&v"(f[1][1][1])
                                 : "v"(ad[0][0][0]), "v"(ad[0][0][1]), "v"(ad[0][1][0]), "v"(ad[0][1][1]), "v"(ad[1][0][0]), "v"(ad[1][0][1]), "v"(ad[1][1][0]), "v"(ad[1][1][1]) : "memory");
#pragma unroll
                    for (int kk = 0; kk < 2; ++kk) {
                        const v4u b0v = (v4u){f[kk][0][0].x, f[kk][0][0].y, f[kk][0][1].x, f[kk][0][1].y}, b1v = (v4u){f[kk][1][0].x, f[kk][1][0].y, f[kk][1][1].x, f[kk][1][1].y};
                        acc0 = __builtin_amdgcn_mfma_f32_32x32x16_bf16(afc[2 * kp + kk], __builtin_bit_cast(pg8::bf16x8, b0v), acc0, 0, 0, 0);
                        acc1 = __builtin_amdgcn_mfma_f32_32x32x16_bf16(afc[2 * kp + kk], __builtin_bit_cast(pg8::bf16x8, b1v), acc1, 0, 0, 0); }
                }
                SG_LOAD_A(gn, afc);
                { LAS float* ep = (LAS float*)(lds + 65536 + wave * 8192);
#pragma unroll
                    for (int i = 0; i < 16; ++i) { const int tl = (i & 3) + 8 * (i >> 2) + 4 * hh; ep[tl * 64 + r31] = acc0[i] + bsv[i]; ep[tl * 64 + 32 + r31] = acc1[i] + bsv[i]; }
#pragma unroll
                    for (int q = 0; q < 4; ++q) { const LAS f32x4* sp = (const LAS f32x4*)(ep + ((lane >> 3) + 8 * q) * 64 + 8 * (lane & 7)); const f32x4 s0 = sp[0], s1 = sp[1]; const v4u gu = guvC[q];
                        v4u o; o.x = pg8::cvt_pk_bf16(pg8::bf_lo(gu.x) * s0[0], pg8::bf_hi(gu.x) * s0[1]); o.y = pg8::cvt_pk_bf16(pg8::bf_lo(gu.y) * s0[2], pg8::bf_hi(gu.y) * s0[3]);
                        o.z = pg8::cvt_pk_bf16(pg8::bf_lo(gu.z) * s1[0], pg8::bf_hi(gu.z) * s1[1]); o.w = pg8::cvt_pk_bf16(pg8::bf_lo(gu.w) * s1[2], pg8::bf_hi(gu.w) * s1[3]);
                        *(v4u*)(obase + (size_t)(8 * q) * D) = o; } }
                if (g < 7) SG_BUILD_STORE(gn, wvA);
#pragma unroll
                for (int q = 0; q < 4; ++q) { wvA[q] = wvB[q]; guvC[q] = guvN[q]; }
                __syncthreads();
            }
#undef SG_BUILD_LOAD
#undef SG_GU_LOAD
#undef SG_BUILD_STORE
#undef SG_LOAD_A
        }
        };
        if (sg_before != 0) { sg_section(sg_before); __syncthreads(); }
        for (int unit = bx; unit < BATCH * 16; unit += G) {
            const int b = unit >> 4, hd = unit & 15, ch0 = hd * 64;
            LAS unsigned char* xb0 = lds + wave * 10240;
            LAS unsigned char* gb = lds + 81920 + wave * 4096;
            LAS unsigned char* wfr = lds + 114688;
            LAS unsigned char* ifr = lds + AUX_OFF;
            LAS float* cwl = (LAS float*)(lds + AUX_OFF + 8192);
            typedef float f32x2l __attribute__((ext_vector_type(2)));
            LAS f32x2l* tot = (LAS f32x2l*)(lds + AUX_OFF + 8192 + 2048);
            __syncthreads();
            for (int q = 0; q < 2; ++q) { const int fid = tid + 512 * q; const int mat = fid >> 9, nt = (fid >> 8) & 1, ks = (fid >> 6) & 3, l = fid & 63, r = l & 31, h = l >> 5;
                const float* W = (mat ? args.in[I_LWX] : args.in[I_LWA]) + (size_t)hd * 4096 + (size_t)(16 * ks + 8 * h) * 64 + 32 * nt + r;
                v4u o; o.x = pk2(W[0], W[64]); o.y = pk2(W[128], W[192]); o.z = pk2(W[256], W[320]); o.w = pk2(W[384], W[448]);
                *(LAS v4u*)(wfr + fid * 16) = o; }
            { const int nt = tid >> 8, ks = (tid >> 6) & 3, l = tid & 63; const int pos = 32 * nt + (l & 31) - 16 * ks - 8 * (l >> 5);
                v4u o; o.x = (pos == 0 ? 0x3F80u : 0u) | (pos == 1 ? 0x3F800000u : 0u); o.y = (pos == 2 ? 0x3F80u : 0u) | (pos == 3 ? 0x3F800000u : 0u);
                o.z = (pos == 4 ? 0x3F80u : 0u) | (pos == 5 ? 0x3F800000u : 0u); o.w = (pos == 6 ? 0x3F80u : 0u) | (pos == 7 ? 0x3F800000u : 0u);
                *(LAS v4u*)(ifr + tid * 16) = o; }
            if (tid < 256) cwl[tid] = args.in[I_CONVW][(tid >> 6) * D + ch0 + (tid & 63)];
            else if (tid < 320) cwl[tid] = args.in[I_CONVB][ch0 + tid - 256];
            float cba[2], cbx[2], csp[2], carry[2];
#pragma unroll
            for (int nt = 0; nt < 2; ++nt) { const int c = ch0 + 32 * nt + (lane & 31); cba[nt] = -1.4426950409f * args.in[I_LBA][c]; cbx[nt] = -1.4426950409f * args.in[I_LBX][c];
                const float lm = args.in[I_LAM][c]; csp[nt] = 8.0f * log1pf(expf(-lm)) * 1.4426950409f; carry[nt] = 0.f; }
            __syncthreads();
            const int r31 = lane & 31, hh = lane >> 5;
            const int tokA = 16 * ((r31 >> 2) & 1) + 4 * (r31 >> 3) + (r31 & 3);
            const int dchunk = (lane & 7) ^ ((lane >> 3) & 7), drow = lane >> 3;
            const bf16* zx = Z0 + (size_t)b * SEQ * D + ch0 + 8 * dchunk;
            const bf16* zg = Z1 + (size_t)b * SEQ * D + ch0 + 8 * dchunk;
#define P3_DMA_X(Tw_, buf_) do { _Pragma("unroll") for (int n_ = 0; n_ < 5; ++n_) { int tk_ = (Tw_) - 8 + 8 * n_ + drow; tk_ = tk_ < 0 ? 0 : tk_; \
                __builtin_amdgcn_global_load_lds((const unsigned*)(zx + (size_t)tk_ * D), (LAS unsigned*)(xb0 + (buf_) * 5120 + n_ * 1024), 16, 0, 0); } } while (0)
#define P3_DMA_G(Tw_) do { _Pragma("unroll") for (int n_ = 0; n_ < 4; ++n_) { const int tk_ = (Tw_) + 8 * n_ + drow; \
                __builtin_amdgcn_global_load_lds((const unsigned*)(zg + (size_t)tk_ * D), (LAS unsigned*)(gb + n_ * 1024), 16, 0, 0); } } while (0)
            P3_DMA_X(wave * 32, 0);
            for (int st = 0; st < 16; ++st) {
                const int Tw = st * 256 + wave * 32, cur = st & 1;
                const int Tn = (st < 15) ? Tw + 256 : Tw;
                P3_DMA_G(Tw);
                P3_DMA_X(Tn, cur ^ 1);
                if (st == 0) asm volatile("s_waitcnt vmcnt(9)" ::: "memory");
                else asm volatile("s_waitcnt vmcnt(13)" ::: "memory");
                LAS unsigned char* xb = xb0 + cur * 5120;
                if (Tw == 0) { if (lane < 24) *(LAS v4u*)(xb + (5 + (lane >> 3)) * 128 + (lane & 7) * 16) = (v4u){0u, 0u, 0u, 0u}; }
                asm volatile("s_waitcnt lgkmcnt(0)" ::: "memory");
                pg8::bf16x8 xa[4];
#pragma unroll
                for (int ks = 0; ks < 4; ++ks) {
                    const f32x4 b0 = *(const LAS f32x4*)(cwl + 256 + 16 * ks + 8 * hh), b1 = *(const LAS f32x4*)(cwl + 256 + 16 * ks + 8 * hh + 4);
                    typedef float f32x2q __attribute__((ext_vector_type(2)));
                    f32x2q xq[4] = {(f32x2q){b0[0], b0[1]}, (f32x2q){b0[2], b0[3]}, (f32x2q){b1[0], b1[1]}, (f32x2q){b1[2], b1[3]}};
#pragma unroll
                    for (int k = 0; k < 4; ++k) { const int rho = tokA + 5 + k; const int pos = (2 * ks + hh) ^ (rho & 7);
                        const v4u w = *(const LAS v4u*)(xb + rho * 128 + pos * 16);
                        const f32x4 c0 = *(const LAS f32x4*)(cwl + k * 64 + 16 * ks + 8 * hh), c1 = *(const LAS f32x4*)(cwl + k * 64 + 16 * ks + 8 * hh + 4);
                        xq[0] += (f32x2q){c0[0], c0[1]} * (f32x2q){pg8::bf_lo(w.x), pg8::bf_hi(w.x)}; xq[1] += (f32x2q){c0[2], c0[3]} * (f32x2q){pg8::bf_lo(w.y), pg8::bf_hi(w.y)};
                        xq[2] += (f32x2q){c1[0], c1[1]} * (f32x2q){pg8::bf_lo(w.z), pg8::bf_hi(w.z)}; xq[3] += (f32x2q){c1[2], c1[3]} * (f32x2q){pg8::bf_lo(w.w), pg8::bf_hi(w.w)}; }
                    v4u p; p.x = pg8::cvt_pk_bf16(xq[0].x, xq[0].y); p.y = pg8::cvt_pk_bf16(xq[1].x, xq[1].y); p.z = pg8::cvt_pk_bf16(xq[2].x, xq[2].y); p.w = pg8::cvt_pk_bf16(xq[3].x, xq[3].y);
                    xa[ks] = __builtin_bit_cast(pg8::bf16x8, p); }
                float hl[2][16], cp[2][16];
#pragma unroll
                for (int nt = 0; nt < 2; ++nt) {
                    f32x16 ar, ai, ax;
#pragma unroll
                    for (int i = 0; i < 16; ++i) { ar[i] = 0.f; ai[i] = 0.f; ax[i] = 0.f; }
#pragma unroll
                    for (int ks = 0; ks < 4; ++ks) {
                        const pg8::bf16x8 fa = *(const LAS pg8::bf16x8*)(wfr + (((0 * 2 + nt) * 4 + ks) * 64 + lane) * 16);
                        const pg8::bf16x8 fx = *(const LAS pg8::bf16x8*)(wfr + (((1 * 2 + nt) * 4 + ks) * 64 + lane) * 16);
                        const pg8::bf16x8 fi = *(const LAS pg8::bf16x8*)(ifr + ((nt * 4 + ks) * 64 + lane) * 16);
                        ar = __builtin_amdgcn_mfma_f32_32x32x16_bf16(xa[ks], fa, ar, 0, 0, 0);
                        ai = __builtin_amdgcn_mfma_f32_32x32x16_bf16(xa[ks], fx, ai, 0, 0, 0);
                        ax = __builtin_amdgcn_mfma_f32_32x32x16_bf16(xa[ks], fi, ax, 0, 0, 0); }
                    float P = 1.f, H = 0.f;
#pragma unroll
                    for (int i = 0; i < 16; i += 2) {
                        typedef float f32x2p __attribute__((ext_vector_type(2)));
                        const f32x2p tr = (f32x2p){ar[i], ar[i + 1]} * (-1.4426950409f) + cba[nt], ti2 = (f32x2p){ai[i], ai[i + 1]} * (-1.4426950409f) + cbx[nt];
                        const f32x2p dr = (f32x2p){__builtin_amdgcn_exp2f(tr.x), __builtin_amdgcn_exp2f(tr.y)} + 1.0f, di = (f32x2p){__builtin_amdgcn_exp2f(ti2.x), __builtin_amdgcn_exp2f(ti2.y)} + 1.0f;
                        const f32x2p rg = (f32x2p){__builtin_amdgcn_rcpf(dr.x), __builtin_amdgcn_rcpf(dr.y)}, ig = (f32x2p){__builtin_amdgcn_rcpf(di.x), __builtin_amdgcn_rcpf(di.y)};
                        const f32x2p la = rg * (-csp[nt]);
                        const f32x2p av = (f32x2p){__builtin_amdgcn_exp2f(la.x), __builtin_amdgcn_exp2f(la.y)};
                        const f32x2p m2 = 1.0f - av * av;
                        const f32x2p uu = (f32x2p){__builtin_amdgcn_sqrtf(m2.x), __builtin_amdgcn_sqrtf(m2.y)} * ig * (f32x2p){ax[i], ax[i + 1]};
                        H = av.x * H + uu.x; P = P * av.x; hl[nt][i] = H; cp[nt][i] = P;
                        H = av.y * H + uu.y; P = P * av.y; hl[nt][i + 1] = H; cp[nt][i + 1] = P; }
                    const float Ho = __shfl_xor(H, 32), Po = __shfl_xor(P, 32);
                    const float H0 = hh ? Ho : 0.f, P0 = hh ? Po : 1.f;
#pragma unroll
                    for (int i = 0; i < 16; i += 2) { typedef float f32x2r __attribute__((ext_vector_type(2))); const f32x2r c2 = (f32x2r){cp[nt][i], cp[nt][i + 1]}; const f32x2r h2 = (f32x2r){hl[nt][i], hl[nt][i + 1]} + c2 * H0; const f32x2r c3 = c2 * P0;
                        hl[nt][i] = h2.x; hl[nt][i + 1] = h2.y; cp[nt][i] = c3.x; cp[nt][i + 1] = c3.y; }
                    if (hh) tot[(cur * 8 + wave) * 64 + 32 * nt + r31] = (f32x2l){cp[nt][15], hl[nt][15]};
                }
                asm volatile("s_waitcnt vmcnt(5)" ::: "memory");
                {
                    pg8::bf16x8 ga[4];
#pragma unroll
                    for (int ks = 0; ks < 4; ++ks) { const int pos = (2 * ks + hh) ^ (tokA & 7); ga[ks] = *(const LAS pg8::bf16x8*)(gb + tokA * 128 + pos * 16); }
#pragma unroll
                    for (int nt = 0; nt < 2; ++nt) { f32x16 ag;
#pragma unroll
                        for (int i = 0; i < 16; ++i) ag[i] = 0.f;
#pragma unroll
                        for (int ks = 0; ks < 4; ++ks) { const pg8::bf16x8 fi = *(const LAS pg8::bf16x8*)(ifr + ((nt * 4 + ks) * 64 + lane) * 16);
                            ag = __builtin_amdgcn_mfma_f32_32x32x16_bf16(ga[ks], fi, ag, 0, 0, 0); }
#pragma unroll
                        for (int i = 0; i < 16; i += 2) { typedef float f32x2r __attribute__((ext_vector_type(2))); const f32x2r g2 = (f32x2r){ag[i], ag[i + 1]}; const f32x2r h2 = (f32x2r){hl[nt][i], hl[nt][i + 1]} * g2, c2 = (f32x2r){cp[nt][i], cp[nt][i + 1]} * g2;
                            hl[nt][i] = h2.x; hl[nt][i + 1] = h2.y; cp[nt][i] = c2.x; cp[nt][i + 1] = c2.y; } }
                }
                asm volatile("s_waitcnt lgkmcnt(0)" ::: "memory"); __builtin_amdgcn_s_barrier(); asm volatile("" ::: "memory");
#pragma unroll
                for (int nt = 0; nt < 2; ++nt) { float s = carry[nt], cin = 0.f;
#pragma unroll
                    for (int w2 = 0; w2 < 8; ++w2) { const f32x2l ph = tot[(cur * 8 + w2) * 64 + 32 * nt + r31]; cin = (w2 == wave) ? s : cin; s = ph.x * s + ph.y; }
                    carry[nt] = s;
                    LAS bf16* yl = (LAS bf16*)(gb + (16 * hh) * 128 + (32 * nt + r31) * 2);
#pragma unroll
                    for (int i = 0; i < 16; i += 2) { typedef float f32x2r __attribute__((ext_vector_type(2))); const f32x2r y2 = (f32x2r){hl[nt][i], hl[nt][i + 1]} + (f32x2r){cp[nt][i], cp[nt][i + 1]} * cin;
                        const unsigned pk = pg8::cvt_pk_bf16(y2.x, y2.y); yl[i * 64] = (bf16)(pk & 0xffffu); yl[(i + 1) * 64] = (bf16)(pk >> 16); } }
                asm volatile("" ::: "memory");
                { bf16* yo = Z1 + ((size_t)b * SEQ + Tw + (lane >> 3)) * D + ch0 + 8 * (lane & 7);
                    v4u o[4];
#pragma unroll
                    for (int q = 0; q < 4; ++q) o[q] = *(const LAS v4u*)(gb + ((lane >> 3) + 8 * q) * 128 + (lane & 7) * 16);
#pragma unroll
                    for (int q = 0; q < 4; ++q) *(v4u*)(yo + (size_t)(8 * q) * D) = o[q]; }
                asm volatile("" ::: "memory");
            }
            asm volatile("s_waitcnt vmcnt(0)" ::: "memory");
#undef P3_DMA_X
#undef P3_DMA_G
        }
        __syncthreads();
        STAMP(15);
        if (sg_before != 3) sg_section(3 ^ sg_before);
        if (BOTH(3)) GRID_BAR();
    }

    STAMP(4);
    if (IN(4)) {
        int tid_l = threadIdx.x; asm volatile("" : "+v"(tid_l)); const int tid = tid_l, lane = tid & 63;
        const int copy_slot = (bx >> 3) & 3;
        auto weight_copies = [&]() __attribute__((always_inline)) {
        int tid_c = threadIdx.x; asm volatile("" : "+v"(tid_c)); const int lane = tid_c & 63;
        {
            LAS float* scr = (LAS float*)(lds + wave * 16384);
            constexpr int I_GU = 16 * 64, I_DN = 16 * 32;
            for (int it = gw; it < NE * (I_GU + I_DN); it += NGW) {
                const int e = it / (I_GU + I_DN); int r = it % (I_GU + I_DN);
                const bool isgu = r < I_GU; if (!isgu) r -= I_GU;
                const int kb = isgu ? (r >> 6) : (r >> 5), nb = isgu ? (r & 63) : (r & 31); const int n0 = 32 * nb; const int cidx = n0 & 1023;
                const int drow = isgu ? (cidx >> 7) * 256 + (n0 >= 1024 ? 128 : 0) + (cidx & 127) : n0;
                const float* Wsrc = isgu ? args.in[I_WGU] + (size_t)e * D * 2048 : args.in[I_WDN] + (size_t)e * D * D;
                unsigned char* Wdst = isgu ? ws + WS_WGU + (size_t)e * 2048 * D : ws + WS_WDN + (size_t)e * D * D;
                transpose_item_f8(Wsrc, isgu ? 2048 : D, D, 64 * kb, n0, Wdst, drow, scr, lane, SC_W);
            }
        }
        };
        if (copy_slot == 0) { weight_copies(); __syncthreads(); }
        { const int panel = bx;
            { pg8::PanelOrder S{Z1, (const bf16*)(ws + WS_WBRR), panel, 4}; EpiMergeT<false> E{Z4, nullptr, Z0, lds + AUX_OFF}; pg8::gemm_phase<EpiMergeT<false>, pg8::PanelOrder, true>(lds, S, E); asm volatile("s_waitcnt vmcnt(0)" ::: "memory"); __syncthreads(); }
            if (copy_slot == 1) { weight_copies(); __syncthreads(); }
            { pg8::PanelOrder S{Z2, (const bf16*)(ws + WS_WBRS), panel, 4}; EpiMergeT<true> E{Z5, Z0, Z3, lds + AUX_OFF}; pg8::gemm_phase<EpiMergeT<true>, pg8::PanelOrder, true>(lds, S, E); asm volatile("s_waitcnt vmcnt(0)" ::: "memory"); __syncthreads(); }
            if (copy_slot == 2) { weight_copies(); __syncthreads(); }
            { pg8::PanelOrder S{Z3, (const bf16*)(ws + WS_WOUT), panel, 4}; EpiResid E{x_in, modv + 2048, X1b, lds + AUX_OFF}; pg8::gemm_phase<EpiResid, pg8::PanelOrder, true>(lds, S, E); asm volatile("s_waitcnt vmcnt(0)\n\tbuffer_inv sc0\n\ts_waitcnt vmcnt(0)" ::: "memory"); __syncthreads(); }
            typedef float f32x16 __attribute__((ext_vector_type(16)));
            LAS unsigned* hist = (LAS unsigned*)(lds + AUX_OFF);
            __syncthreads();
            const int pb = (panel * 256) / SEQ;
            LAS float* cbt = (LAS float*)(lds + AUX_OFF + 128);
            LAS float* cpart = (LAS float*)(lds + AUX_OFF + 256);
            LAS float* rsd = (LAS float*)(lds + AUX_OFF + 256 + 2048);
            { const int e = tid & 31, part = tid >> 5; float s = 0.f;
#pragma unroll 4
                for (int kk = 0; kk < 64; ++kk) { const int k = part * 64 + kk; s += modv[pb * DIN + 3072 + k] * args.in[I_WR][(size_t)k * NE + e]; }
                cpart[part * 32 + e] = s; }
            for (int q = 0; q < 8; ++q) { const int fid = tid + 512 * q; const int ks = fid >> 6, l = fid & 63; const int k0 = 16 * ks + 8 * (l >> 5); const float* W = args.in[I_WR] + (size_t)k0 * NE + (l & 31);
                const f32x4 g0 = *(const f32x4*)(args.in[I_N2G] + k0), g1 = *(const f32x4*)(args.in[I_N2G] + k0 + 4), s0 = *(const f32x4*)(modv + pb * DIN + 4096 + k0), s1 = *(const f32x4*)(modv + pb * DIN + 4096 + k0 + 4);
                const f32x4 a0 = g0 * (1.0f + s0), a1 = g1 * (1.0f + s1);
                float w[8]; unsigned hi[8], lo[8];
#pragma unroll
                for (int j = 0; j < 8; ++j) { w[j] = W[j * NE] * (j < 4 ? a0[j & 3] : a1[j & 3]); hi[j] = f2bf(w[j]); lo[j] = f2bf(w[j] - __uint_as_float(hi[j] << 16)); }
                *(LAS v4u*)(lds + ((ks * 2 + 0) * 64 + l) * 16) = (v4u){hi[0] | (hi[1] << 16), hi[2] | (hi[3] << 16), hi[4] | (hi[5] << 16), hi[6] | (hi[7] << 16)};
                *(LAS v4u*)(lds + ((ks * 2 + 1) * 64 + l) * 16) = (v4u){lo[0] | (lo[1] << 16), lo[2] | (lo[3] << 16), lo[4] | (lo[5] << 16), lo[6] | (lo[7] << 16)}; }
            __syncthreads();
            if (tid < 32) { float s = args.in[I_BR][tid];
#pragma unroll
                for (int q = 0; q < 16; ++q) s += cpart[q * 32 + tid];
                cbt[tid] = s; }
            { const int tb = panel;
                if (tid < 32) hist[tid] = 0u;
                const int m0 = tb * 256 + wave * 32; const int b = m0 / SEQ;
                {
                    f32x4 A4[2][2], B4[2][2];
#pragma unroll
                    for (int j = 0; j < 2; ++j)
#pragma unroll
                        for (int q = 0; q < 2; ++q) { const int c = 8 * lane + 512 * j + 4 * q; const f32x4 g = *(const f32x4*)(args.in[I_N2G] + c), s = *(const f32x4*)(modv + b * DIN + 4096 + c);
                            A4[j][q] = g * (1.0f + s); B4[j][q] = *(const f32x4*)(modv + b * DIN + 3072 + c); }
                    f32x4 v[2][2]; v4u xw[2], xn[2];
                    { const GAS v4u* xr = (const GAS v4u*)(X1b + (size_t)m0 * D) + lane; xw[0] = xr[0]; xw[1] = xr[64]; }
                    for (int r = 0; r < 32; ++r) {
                        const size_t m = (size_t)m0 + r;
                        { const size_t mn = (r < 31) ? m + 1 : m; const GAS v4u* xr = (const GAS v4u*)(X1b + mn * D) + lane; xn[0] = xr[0]; xn[1] = xr[64]; }
#pragma unroll
                        for (int j = 0; j < 2; ++j) { v[j][0] = (f32x4){pg8::bf_lo(xw[j].x), pg8::bf_hi(xw[j].x), pg8::bf_lo(xw[j].y), pg8::bf_hi(xw[j].y)}; v[j][1] = (f32x4){pg8::bf_lo(xw[j].z), pg8::bf_hi(xw[j].z), pg8::bf_lo(xw[j].w), pg8::bf_hi(xw[j].w)}; }
                        float ss = 0.f;
#pragma unroll
                        for (int j = 0; j < 2; ++j)
#pragma unroll
                            for (int q = 0; q < 2; ++q) ss += (v[j][q].x * v[j][q].x + v[j][q].y * v[j][q].y) + (v[j][q].z * v[j][q].z + v[j][q].w * v[j][q].w);
                        const float rstd = 1.0f / sqrtf(wave_sum(ss) * (1.f / D) + EPS);
                        if (lane == 0) rsd[wave * 32 + r] = rstd;
                        GAS v2u* o8 = (GAS v2u*)(ws + WS_H2Q + m * D) + lane;
#pragma unroll
                        for (int j = 0; j < 2; ++j) { const f32x4 y0 = v[j][0] * rstd * A4[j][0] + B4[j][0], y1 = v[j][1] * rstd * A4[j][1] + B4[j][1];
                            o8[64 * j] = (v2u){pk4_fp8(y0.x * SC_H2, y0.y * SC_H2, y0.z * SC_H2, y0.w * SC_H2), pk4_fp8(y1.x * SC_H2, y1.y * SC_H2, y1.z * SC_H2, y1.w * SC_H2)}; }
                        xw[0] = xn[0]; xw[1] = xn[1];
                    }
                }
                __syncthreads();
                {
                    const int n = lane & 31, h = lane >> 5;
                    f32x16 acc;
#pragma unroll
                    for (int i = 0; i < 16; ++i) acc[i] = 0.f;
                    const bf16* hrow = X1b + (size_t)(m0 + n) * D + 8 * h;
                    {
                        pg8::bf16x8 ha[16], hq[16];
#define RB_LD(dst_, b_) do { _Pragma("unroll") for (int i = 0; i < 16; ++i) dst_[i] = *(const pg8::bf16x8*)(hrow + 16 * ((b_) * 16 + i)); } while (0)
#define RB_MM(src_, b_) do { _Pragma("unroll") for (int i = 0; i < 16; ++i) { const int ks = (b_) * 16 + i; \
                            const pg8::bf16x8 wh = *(const LAS pg8::bf16x8*)(lds + ((ks * 2 + 0) * 64 + lane) * 16), wl = *(const LAS pg8::bf16x8*)(lds + ((ks * 2 + 1) * 64 + lane) * 16); \
                            acc = __builtin_amdgcn_mfma_f32_32x32x16_bf16(wh, src_[i], acc, 0, 0, 0); \
                            acc = __builtin_amdgcn_mfma_f32_32x32x16_bf16(wl, src_[i], acc, 0, 0, 0); } } while (0)
                        RB_LD(ha, 0); RB_LD(hq, 1);
                        asm volatile("s_waitcnt vmcnt(16)" ::: "memory");
                        RB_MM(ha, 0); RB_LD(ha, 2);
                        asm volatile("s_waitcnt vmcnt(16)" ::: "memory");
                        RB_MM(hq, 1); RB_LD(hq, 3);
                        asm volatile("s_waitcnt vmcnt(16)" ::: "memory");
                        RB_MM(ha, 2);
                        asm volatile("s_waitcnt vmcnt(0)" ::: "memory");
                        RB_MM(hq, 3);
#undef RB_LD
#undef RB_MM
                    }
                    float p[16];
#pragma unroll
                    for (int i = 0; i < 16; ++i) p[i] = acc[i] * rsd[wave * 32 + n] + cbt[(i & 3) + 8 * (i >> 2) + 4 * h];
                    float cv[8]; int ce[8];
#pragma unroll
                    for (int k = 0; k < 4; ++k) { float best = -3.0e38f; int bi = 0;
#pragma unroll
                        for (int i = 0; i < 16; ++i) { if (p[i] > best) { best = p[i]; bi = i; } }
                        cv[k] = best; ce[k] = (bi & 3) + 8 * (bi >> 2) + 4 * h;
#pragma unroll
                        for (int i = 0; i < 16; ++i) p[i] = (i == bi) ? -3.0e38f : p[i]; }
#pragma unroll
                    for (int k = 0; k < 4; ++k) { cv[4 + k] = __shfl_xor(cv[k], 32); ce[4 + k] = __shfl_xor(ce[k], 32); }
                    float tv[4]; int ti[4];
#pragma unroll
                    for (int k = 0; k < 4; ++k) { float best = -3.0e38f; int be = 64, bs = 0;
#pragma unroll
                        for (int s = 0; s < 8; ++s) { const bool better = (cv[s] > best) || (cv[s] == best && ce[s] < be); if (better) { best = cv[s]; be = ce[s]; bs = s; } }
                        tv[k] = best; ti[k] = be;
#pragma unroll
                        for (int s = 0; s < 8; ++s) cv[s] = (s == bs) ? -3.0e38f : cv[s]; }
                    const float e1 = expf(tv[1] - tv[0]), e2 = expf(tv[2] - tv[0]), e3 = expf(tv[3] - tv[0]); const float inv = 1.0f / (1.0f + e1 + e2 + e3);
                    if (h == 0) { const size_t m = (size_t)m0 + n;
                        *(int4*)(top_idx + m * 4) = make_int4(ti[0], ti[1], ti[2], ti[3]);
                        *(float4*)(top_w + m * 4) = make_float4(inv, e1 * inv, e2 * inv, e3 * inv);
#pragma unroll
                        for (int k = 0; k < 4; ++k) atomicAdd((unsigned*)&hist[ti[k]], 1u); }
                }
                __syncthreads();
                if (tid < 32) blkcnt[tb * 32 + tid] = (int)hist[tid];
                __syncthreads();
            }
        }
        __syncthreads();
        if (copy_slot == 3) weight_copies();
        if (BOTH(4)) GRID_BAR();
    }
    STAMP(5); STAMP(6); STAMP(7);


    STAMP(8);
    if (IN(8)) {
        int tid_l = threadIdx.x; asm volatile("" : "+v"(tid_l)); const int tid = tid_l, lane = tid & 63;
        LAS int* sp_tot = (LAS int*)(lds);
        LAS int* sp_pre = sp_tot + 512;
        LAS int* tot = sp_pre + 512;
        LAS int* myoff = tot + 32;
        LAS int* pstart = myoff + 32;
        LAS unsigned* cursor = (LAS unsigned*)(pstart + 64);
        for (int tb = bx; tb < NTOK / 256; tb += G) {
            __syncthreads();
            { const int e = tid & 31, part = tid >> 5; int s_tot = 0, s_pre = 0;
                for (int B = part; B < 256; B += 16) { const int cn = blkcnt[B * 32 + e]; s_tot += cn; if (B < tb) s_pre += cn; }
                sp_tot[part * 32 + e] = s_tot; sp_pre[part * 32 + e] = s_pre; }
            __syncthreads();
            if (tid < 32) { int a = 0, p = 0; for (int q = 0; q < 16; ++q) { a += sp_tot[q * 32 + tid]; p += sp_pre[q * 32 + tid]; } tot[tid] = a; myoff[tid] = p; cursor[tid] = 0u; }
            __syncthreads();
            if (tid == 0) { int acc = 0; for (int e = 0; e < 32; ++e) { pstart[e] = acc; acc += ((tot[e] + 255) >> 8) << 8; } pstart[32] = acc; }
            __syncthreads();
            for (int q = 0; q < 2; ++q) { const int a = tid + 512 * q; const int tok = tb * 256 + (a >> 2);
                const int e = top_idx[(size_t)tok * 4 + (a & 3)]; const unsigned rnk = atomicAdd((unsigned*)&cursor[e], 1u);
                const int slot = pstart[e] + myoff[e] + (int)rnk;
                slot_tok[slot] = tok; slot_w[slot] = top_w[(size_t)tok * 4 + (a & 3)]; tok_slot[(size_t)tok * 4 + (a & 3)] = slot; }
            if (tb < 32) { const int e = tb; const int nt_e = (tot[e] + 255) >> 8;
                for (int r = tot[e] + tid; r < nt_e * 256; r += 512) { slot_tok[pstart[e] + r] = 0; slot_w[pstart[e] + r] = 0.f; }
                for (int i = tid; i < nt_e; i += 512) tile_exp[(pstart[e] >> 8) + i] = e;
                if (e == 0 && tid == 0) tile_exp[NTILE_MAX] = pstart[32] >> 8; }
        }
        if (BOTH(8)) GRID_BAR();
    }

    {
        const int pgu = 9, pdn = 10;
        if (IN(pgu) || IN(pdn)) {
            const int ntiles = tile_exp[NTILE_MAX];
            const int tile0 = 0;
            int ntc = ntiles; if (ntc < 0) ntc = 0; if (ntc > NTILE_MAX) ntc = NTILE_MAX;
            bf16* actb = (bf16*)(ws + WS_ACT);
            asm volatile("" : "+s"(actb));
            STAMP(pgu);
            if (IN(pgu)) {
                pg8::MoeOrder<true> S{(const bf16*)(ws + WS_H2Q), (const bf16*)(ws + WS_WGU), tile_exp, slot_tok, tile0, ntc, 8, G, vcu, lds + AUX_OFF + 18432};
                EpiGu E{(unsigned char*)actb, args.in[I_BGU], tile0, lds + AUX_OFF};
                pg8::gemm_phase<EpiGu, pg8::MoeOrder<true>, true>(lds, S, E);
                if (BOTH(pgu)) GRID_BAR();
            }
            STAMP(pdn);
            if (IN(pdn)) {
                pg8::MoeOrder<false> S{actb, (const bf16*)(ws + WS_WDN), tile_exp, slot_tok, tile0, ntc, 4, G, vcu, lds + AUX_OFF + 18432};
                EpiDown E{ws, args.in[I_BDN], slot_w, tile0, lds + AUX_OFF};
                pg8::gemm_phase<EpiDown, pg8::MoeOrder<false>, true>(lds, S, E);
                if (BOTH(pdn)) GRID_BAR();
            }
        }
    }

    STAMP(13);
    if (IN(13)) {
        int tid_l = threadIdx.x; asm volatile("" : "+v"(tid_l)); const int tid = tid_l, lane = tid & 63;
        for (int rb = gw; rb < NTOK / 32; rb += NGW) {
            const int b = (rb * 32) / SEQ;
            f32x4 G4[2][2], F4[2][2];
#pragma unroll
            for (int j = 0; j < 2; ++j)
#pragma unroll
                for (int q = 0; q < 2; ++q) { const int c = 8 * lane + 512 * j + 4 * q; G4[j][q] = *(const f32x4*)(modv + b * DIN + 5120 + c) * (1.0f / SC_Y); F4[j][q] = *(const f32x4*)(args.in[I_FG] + c); }
            const v2u sl = *(const v2u*)(tok_slot + (size_t)rb * 128 + 2 * lane);
            f32x4 v[2][2]; v4u xv[2], xn[2], xm[2]; v2u yv[4][2], yn[4][2], ym[4][2];
#define P13_LOAD(r_, xv_, yy_) do { const size_t m_ = (size_t)rb * 32 + (r_); const GAS v4u* xr_ = (const GAS v4u*)(X1b + m_ * D) + lane; \
                _Pragma("unroll") for (int j = 0; j < 2; ++j) xv_[j] = xr_[64 * j]; \
                _Pragma("unroll") for (int k = 0; k < 4; ++k) { const int slot_ = (int)__builtin_amdgcn_readlane((k & 1) ? sl.y : sl.x, 2 * (r_) + (k >> 1)); \
                    const GAS v2u* y8_ = (const GAS v2u*)(ws + y_tile_off(slot_ >> 8) + (size_t)(slot_ & 255) * D) + lane; \
                    _Pragma("unroll") for (int j = 0; j < 2; ++j) yy_[k][j] = y8_[64 * j]; } } while (0)
            P13_LOAD(0, xv, yv); P13_LOAD(1, xn, yn);
            for (int r = 0; r < 32; ++r) {
                const int rn = (r < 30) ? r + 2 : 31;
                P13_LOAD(rn, xm, ym);
                float ss = 0.f;
#pragma unroll
                for (int j = 0; j < 2; ++j) { typedef float f32x2c __attribute__((ext_vector_type(2)));
                    f32x2c s01 = (f32x2c){0.f, 0.f}, s23 = s01, s45 = s01, s67 = s01;
#pragma unroll
                    for (int k = 0; k < 4; ++k) { const v2u w = yv[k][j];
                        s01 += __builtin_amdgcn_cvt_pk_f32_fp8((int)w.x, false); s23 += __builtin_amdgcn_cvt_pk_f32_fp8((int)w.x, true);
                        s45 += __builtin_amdgcn_cvt_pk_f32_fp8((int)w.y, false); s67 += __builtin_amdgcn_cvt_pk_f32_fp8((int)w.y, true); }
                    v[j][0] = (f32x4){pg8::bf_lo(xv[j].x), pg8::bf_hi(xv[j].x), pg8::bf_lo(xv[j].y), pg8::bf_hi(xv[j].y)} + G4[j][0] * (f32x4){s01.x, s01.y, s23.x, s23.y};
                    v[j][1] = (f32x4){pg8::bf_lo(xv[j].z), pg8::bf_hi(xv[j].z), pg8::bf_lo(xv[j].w), pg8::bf_hi(xv[j].w)} + G4[j][1] * (f32x4){s45.x, s45.y, s67.x, s67.y};
#pragma unroll
                    for (int q = 0; q < 2; ++q) ss += (v[j][q].x * v[j][q].x + v[j][q].y * v[j][q].y) + (v[j][q].z * v[j][q].z + v[j][q].w * v[j][q].w); }
                const float rstd = 1.0f / sqrtf(wave_sum(ss) * (1.f / D) + EPS);
                GAS f32x4* xo = (GAS f32x4*)(args.out + ((size_t)rb * 32 + r) * D) + 2 * lane;
#pragma unroll
                for (int j = 0; j < 2; ++j)
#pragma unroll
                    for (int q = 0; q < 2; ++q) xo[128 * j + q] = v[j][q] * rstd * F4[j][q];
#pragma unroll
                for (int j = 0; j < 2; ++j) { xv[j] = xn[j]; xn[j] = xm[j];
#pragma unroll
                    for (int k = 0; k < 4; ++k) { yv[k][j] = yn[k][j]; yn[k][j] = ym[k][j]; } }
            }
#undef P13_LOAD
        }
    }
#ifdef DIAG_A_LO
    {
        GRID_BAR(); STAMP(14); GRID_BAR();
        const float us_a = (float)(__hip_atomic_load(ctl + 64 + DIAG_A_HI, RLX_AGENT) - __hip_atomic_load(ctl + 64 + DIAG_A_LO, RLX_AGENT)) * 0.01f;
        const float us_b = (float)(__hip_atomic_load(ctl + 64 + DIAG_B_HI, RLX_AGENT) - __hip_atomic_load(ctl + 64 + DIAG_B_LO, RLX_AGENT)) * 0.01f;
        const float sc = 1.0f + 1e-4f * (10.0f * rintf(us_a * 0.1f)); const float us_bq = 10.0f * rintf(us_b * 0.1f);
        for (size_t i = (size_t)bx * 512 + threadIdx.x; i < (size_t)NTOK * D; i += (size_t)G * 512) { float v = args.out[i] * sc; if (i == 0) v += us_bq * 0.25f; args.out[i] = v; }
    }
#endif
#undef IN
#undef BOTH
}

extern "C" void kernel_launch(void* const* d_in, const int* in_sizes, int n_in, void* d_out, int out_size, void* d_ws, size_t ws_size, hipStream_t stream) {
    static int grid = 0;
    if (grid == 0) {
        if (n_in != 28 || out_size != NTOK * D || ws_size < WS_TOTAL) { fprintf(stderr, "kernel_launch: unexpected shapes (n_in %d out %d ws %zu)\n", n_in, out_size, ws_size); grid = -1; return; }
        int dev = 0, cus = 0, per_cu = 0;
        if (hipGetDevice(&dev) != hipSuccess || hipDeviceGetAttribute(&cus, hipDeviceAttributeMultiprocessorCount, dev) != hipSuccess) { grid = -1; return; }
        if (hipFuncSetAttribute((const void*)mega_fwd, hipFuncAttributeMaxDynamicSharedMemorySize, LDS_BYTES) != hipSuccess) { fprintf(stderr, "kernel_launch: hipFuncSetAttribute failed\n"); grid = -1; return; }
        if (hipOccupancyMaxActiveBlocksPerMultiprocessor(&per_cu, (const void*)mega_fwd, NWAVES * 64, LDS_BYTES) != hipSuccess || per_cu < 1)
            fprintf(stderr, "kernel_launch: occupancy query reports %d workgroups per CU\n", per_cu);
        (void)hipGetLastError();
        grid = cus;
        if (grid != NTOK / 256) { fprintf(stderr, "kernel_launch: built for %d CUs, device has %d\n", NTOK / 256, cus); grid = -1; return; }
    }
    if (grid < 0) return;
    (void)hipMemsetAsync((char*)d_ws + WS_CTL, 0, CTL_ZERO_BYTES, stream);
    Args a{};
    for (int i = 0; i < 28; ++i) a.in[i] = (const float*)d_in[i];
    a.out = (float*)d_out; a.ws = (unsigned char*)d_ws;
#if MK_PER_PHASE
    for (int p = 0; p < N_PHASES; ++p) { a.ph_lo = p; a.ph_hi = p + 1; a.li = p; a.pad = 0; hipLaunchKernelGGL(mega_fwd, dim3(grid), dim3(NWAVES * 64), LDS_BYTES, stream, a); }
#else
    a.ph_lo = 0; a.ph_hi = N_PHASES; a.li = 0; a.pad = 0;
    hipLaunchKernelGGL(mega_fwd, dim3(grid), dim3(NWAVES * 64), LDS_BYTES, stream, a);
#endif
}
```
